# Optimizing an MI355X kernel written in HIP

```python
import jax
import jax.numpy as jnp
from jax import lax
import numpy as np

D_MODEL = 1024
BATCH = 16
SEQ = 2048
DEPTH = 2

GRID_W = 64
CTX_LEN = 256

HEAD_DIM = 64
N_Q_HEADS = 8
N_KV_HEADS = 2
Q_PER_KV = N_Q_HEADS // N_KV_HEADS
ATTN_W = N_Q_HEADS * HEAD_DIM
KV_W = N_KV_HEADS * HEAD_DIM
ROT_FREQS = HEAD_DIM // 4
ROPE_THETA = 10000.0
Q_BLOCK = 128
CONV_W = D_MODEL // 4
CONV_K = 3
FFT_W = D_MODEL // 4
FFT_GROUPS = 4
FFT_GROUP_DIM = FFT_W // FFT_GROUPS
MIX_W = ATTN_W + CONV_W + FFT_W
Q_OFF = 0
K_OFF = Q_OFF + ATTN_W
V_OFF = K_OFF + KV_W
CB_OFF = V_OFF + KV_W
CC_OFF = CB_OFF + CONV_W
CV_OFF = CC_OFF + CONV_W
F_OFF = CV_OFF + CONV_W
IN_W = F_OFF + FFT_W
N_EXPERTS = 32
TOP_K = 4
D_FF = D_MODEL
SWIGLU_LIMIT = 7.0
SWIGLU_ALPHA = 1.702
N_MOD = 6
EPS = 1e-6

kernel_name = "hybrid_fourier_conv_gqa_moe_dit_block"


def rms_norm(x, g=None):
    xf = x.astype(jnp.float32)
    y = xf * lax.rsqrt(jnp.mean(xf * xf, axis=-1, keepdims=True) + EPS)
    if g is not None:
        y = y * g.astype(jnp.float32)
    return y.astype(x.dtype)


def modulate(x, g, shift, scale):
    return rms_norm(x, g) * (1 + scale) + shift


def rope_tables(rows):
    row = jnp.repeat(jnp.arange(rows), GRID_W)
    col = jnp.tile(jnp.arange(GRID_W), rows)
    inv_freq = ROPE_THETA ** (-jnp.arange(ROT_FREQS, dtype=jnp.float32) / ROT_FREQS)
    ang = jnp.stack([row, col], axis=-1).astype(jnp.float32)[..., None] * inv_freq
    return jnp.cos(ang), jnp.sin(ang)


def apply_rope(x, cos, sin):
    shp = x.shape
    xr = x.astype(jnp.float32).reshape(shp[:-1] + (2, 2, ROT_FREQS))
    x1, x2 = xr[..., 0, :], xr[..., 1, :]
    bshape = (1, shp[1]) + (1,) * (x.ndim - 3) + (2, ROT_FREQS)
    c = cos.reshape(bshape)
    s = sin.reshape(bshape)
    out = jnp.stack([x1 * c - x2 * s, x2 * c + x1 * s], axis=-2)
    return out.reshape(shp).astype(x.dtype)


def keys_values(p_kv, g_k):
    b, n, _ = p_kv.shape
    k = rms_norm(p_kv[..., :KV_W].reshape(b, n, N_KV_HEADS, HEAD_DIM), g_k)
    v = p_kv[..., KV_W:].reshape(b, n, N_KV_HEADS, HEAD_DIM)
    return k, v


def attend(q, k, v):
    b, nq = q.shape[:2]
    nb = nq // Q_BLOCK
    scale = HEAD_DIM ** -0.5
    qb = q.reshape(b, nb, Q_BLOCK, N_KV_HEADS, Q_PER_KV, HEAD_DIM).transpose(1, 0, 2, 3, 4, 5)

    def one_block(qi):
        s = jnp.einsum('bqhgd,bkhd->bhgqk', qi, k, preferred_element_type=jnp.float32) * scale
        p = jax.nn.softmax(s, axis=-1)
        return jnp.einsum('bhgqk,bkhd->bqhgd', p.astype(v.dtype), v)

    o = lax.map(one_block, qb)
    return o.transpose(1, 0, 2, 3, 4, 5).reshape(b, nq, ATTN_W)


def short_conv(u, w):
    up = jnp.pad(u, ((0, 0), (1, 1), (0, 0)))
    return up[:, :-2] * w[0] + up[:, 1:-1] * w[1] + up[:, 2:] * w[2]


def fourier_mix(f):
    b, n, _ = f.shape
    fg = f.astype(jnp.float32).reshape(b, n, FFT_GROUPS, FFT_GROUP_DIM)
    y = jnp.fft.fft2(fg, axes=(1, 3)).real
    return y.reshape(b, n, FFT_W).astype(f.dtype)


def mixers(p, k, v, g_q, conv_w, g_branch, w_out, rope):
    b, n, _ = p.shape
    q = rms_norm(p[..., Q_OFF:K_OFF].reshape(b, n, N_KV_HEADS, Q_PER_KV, HEAD_DIM), g_q)
    if rope is not None:
        q = apply_rope(q, rope[0], rope[1])
    attn = attend(q, k, v)
    gate_b = p[..., CB_OFF:CC_OFF]
    gate_c = p[..., CC_OFF:CV_OFF]
    conv_in = p[..., CV_OFF:F_OFF]
    conv = gate_b * short_conv(gate_c * conv_in, conv_w)
    fourier = fourier_mix(p[..., F_OFF:IN_W])
    merged = jnp.concatenate([rms_norm(attn), rms_norm(conv), rms_norm(fourier)], axis=-1) * g_branch
    return merged @ w_out


def moe_ffn(h, w_r, b_r, w_gu, b_gu, w_dn, b_dn):
    shp = h.shape
    t = h.reshape(-1, shp[-1])
    logits = t.astype(jnp.float32) @ w_r.astype(jnp.float32) + b_r.astype(jnp.float32)
    top_v, top_i = lax.top_k(logits, TOP_K)
    top_w = jax.nn.softmax(top_v, axis=-1)
    gates = jnp.sum(jax.nn.one_hot(top_i, N_EXPERTS, dtype=jnp.float32) * top_w[..., None], axis=1)
    out = jnp.zeros(t.shape, jnp.float32)
    for e in range(N_EXPERTS):
        gu = t @ w_gu[e] + b_gu[e]
        a = jnp.minimum(gu[..., :D_FF], SWIGLU_LIMIT)
        lin = jnp.clip(gu[..., D_FF:], -SWIGLU_LIMIT, SWIGLU_LIMIT)
        y = (a * jax.nn.sigmoid(SWIGLU_ALPHA * a) * (lin + 1)) @ w_dn[e] + b_dn[e]
        out = out + gates[:, e:e + 1] * y.astype(jnp.float32)
    return out.astype(h.dtype).reshape(shp)


def setup_inputs(seed: int = 0) -> dict:
    key = jax.random.key(seed)
    ks = jax.random.split(key, 24)
    f32 = jnp.float32
    L, D, E = DEPTH, D_MODEL, N_EXPERTS

    def nrm(k, shape, scale):
        return jax.random.normal(k, shape, f32) * scale

    def gain(k, shape):
        return 1.0 + 0.05 * jax.random.normal(k, shape, f32)

    return {
        "x": nrm(ks[0], (BATCH, SEQ, D), 1.0),
        "c": nrm(ks[1], (BATCH, D), 1.0),
        "ctx": nrm(ks[2], (BATCH, CTX_LEN, D), 1.0),
        "c_ctx": nrm(ks[3], (D,), 1.0),
        "w_mod": nrm(ks[4], (L, D, N_MOD * D), 0.5 * D ** -0.5),
        "b_mod": nrm(ks[5], (L, N_MOD * D), 0.02),
        "g_pre_mix": gain(ks[6], (L, D)),
        "g_post_mix": gain(ks[7], (L, D)),
        "g_pre_ffn": gain(ks[8], (L, D)),
        "g_post_ffn": gain(ks[9], (L, D)),
        "w_in": nrm(ks[10], (L, D, IN_W), D ** -0.5),
        "g_q": gain(ks[11], (L, HEAD_DIM)),
        "g_k": gain(ks[12], (L, HEAD_DIM)),
        "conv_w": nrm(ks[13], (L, CONV_K, CONV_W), CONV_K ** -0.5),
        "g_branch": gain(ks[14], (L, MIX_W)),
        "w_out": nrm(ks[15], (L, MIX_W, D), MIX_W ** -0.5),
        "w_router": nrm(ks[16], (L, D, E), D ** -0.5),
        "b_router": nrm(ks[17], (L, E), 0.01),
        "w_gate_up": nrm(ks[18], (L, E, D, 2 * D_FF), D ** -0.5),
        "b_gate_up": nrm(ks[19], (L, E, 2 * D_FF), 0.02),
        "w_down": nrm(ks[20], (L, E, D_FF, D), D_FF ** -0.5),
        "b_down": nrm(ks[21], (L, E, D), 0.02),
    }


def reference(x, c, ctx, c_ctx, w_mod, b_mod, g_pre_mix, g_post_mix, g_pre_ffn, g_post_ffn,
              w_in, g_q, g_k, conv_w, g_branch, w_out, w_router, b_router,
              w_gate_up, b_gate_up, w_down, b_down):
    n_lat = x.shape[1]
    rows = n_lat // GRID_W
    cos, sin = rope_tables(rows)
    silu_c = jax.nn.silu(c)
    silu_cc = jax.nn.silu(c_ctx)
    x_lat, x_ctx = x, ctx
    for layer in range(DEPTH):
        last = layer == DEPTH - 1
        mod_lat = (silu_c @ w_mod[layer] + b_mod[layer])[:, None, :]
        mod_ctx = silu_cc @ w_mod[layer] + b_mod[layer]
        sh_m, sc_m, gt_m, sh_f, sc_f, gt_f = jnp.split(mod_lat, N_MOD, axis=-1)
        csh_m, csc_m, cgt_m, csh_f, csc_f, cgt_f = jnp.split(mod_ctx, N_MOD, axis=-1)

        h_lat = modulate(x_lat, g_pre_mix[layer], sh_m, sc_m)
        h_ctx = modulate(x_ctx, g_pre_mix[layer], csh_m, csc_m)
        w_in_l = w_in[layer]
        p_lat = h_lat @ w_in_l
        if last:
            k_ctx, v_ctx = keys_values(h_ctx @ w_in_l[:, K_OFF:CB_OFF], g_k[layer])
        else:
            p_ctx = h_ctx @ w_in_l
            k_ctx, v_ctx = keys_values(p_ctx[..., K_OFF:CB_OFF], g_k[layer])
        k_lat, v_lat = keys_values(p_lat[..., K_OFF:CB_OFF], g_k[layer])
        k_lat = apply_rope(k_lat, cos, sin)
        k_all = jnp.concatenate([k_lat, k_ctx], axis=1)
        v_all = jnp.concatenate([v_lat, v_ctx], axis=1)
        mix_lat = mixers(p_lat, k_all, v_all, g_q[layer], conv_w[layer], g_branch[layer],
                         w_out[layer], (cos, sin))
        x_lat = x_lat + gt_m * rms_norm(mix_lat, g_post_mix[layer])

        if last:
            f_lat = modulate(x_lat, g_pre_ffn[layer], sh_f, sc_f)
            y_lat = moe_ffn(f_lat, w_router[layer], b_router[layer], w_gate_up[layer],
                            b_gate_up[layer], w_down[layer], b_down[layer])
            x_lat = x_lat + gt_f * rms_norm(y_lat, g_post_ffn[layer])
        else:
            mix_ctx = mixers(p_ctx, k_ctx, v_ctx, g_q[layer], conv_w[layer], g_branch[layer],
                             w_out[layer], None)
            x_ctx = x_ctx + cgt_m * rms_norm(mix_ctx, g_post_mix[layer])
            f_lat = modulate(x_lat, g_pre_ffn[layer], sh_f, sc_f)
            f_ctx = modulate(x_ctx, g_pre_ffn[layer], csh_f, csc_f)
            y_all = moe_ffn(jnp.concatenate([f_lat, f_ctx], axis=1), w_router[layer], b_router[layer],
                            w_gate_up[layer], b_gate_up[layer], w_down[layer], b_down[layer])
            x_lat = x_lat + gt_f * rms_norm(y_all[:, :n_lat], g_post_ffn[layer])
            x_ctx = x_ctx + cgt_f * rms_norm(y_all[:, n_lat:], g_post_ffn[layer])
    return x_lat
```

```cpp
#include <hip/hip_runtime.h>
#include <hip/hip_bf16.h>
#include <cstdio>
#include <cstdint>
#include <cmath>
namespace pg8 {
#define PG8_LAS __attribute__((address_space(3)))
typedef unsigned short bf16_t;
typedef short bf16x8 __attribute__((ext_vector_type(8)));
typedef float f32x4 __attribute__((ext_vector_type(4)));
typedef unsigned u32x4 __attribute__((ext_vector_type(4)));
typedef int i32x4 __attribute__((ext_vector_type(4)));
constexpr int BM = 256, BK = 64, HALF = 128, HTB = HALF * BK * 2  , STAGE_BYTES = 8 * HTB, NXCD = 8;

__host__ __device__ __forceinline__ int lds_byte(int r, int c) { const int st = (r >> 4) * 2 + (c >> 5), rr = r & 15, cc = c & 31, ob = rr * 64 + cc * 2; return st * 1024 + (ob ^ (((ob >> 9) & 1) << 5)); }
__host__ __device__ __forceinline__ void stage_rc(int b, int& R, int& C) { const int st = b / 1024, sb = b % 1024, swz = sb ^ (((sb >> 9) & 1) << 5); R = (st >> 1) * 16 + swz / 64; C = (st & 1) * 32 + (swz % 64) / 2; }
__host__ __device__ __forceinline__ int perm32(int rho) { const int n = rho >> 4, i = rho & 15; return 8 * (i >> 2) + 4 * n + (i & 3); }

struct Unit { int pm, pn, kind; };
__device__ __forceinline__ bool list_index(int i, int G, int c, int nwg, int& w) {
    const long L = (long)i * G + c; if (L >= nwg) return false;
    const int q = nwg / NXCD, r = nwg % NXCD, xcd = (int)(L % NXCD), off = (int)(L / NXCD);
    w = (xcd < r ? xcd * (q + 1) : r * (q + 1) + (xcd - r) * q) + off; return true;
}
__device__ __forceinline__ unsigned cvt_pk_bf16(float lo, float hi) { unsigned r; asm volatile("v_cvt_pk_bf16_f32 %0, %1, %2" : "=v"(r) : "v"(lo), "v"(hi)); return r; }
__device__ __forceinline__ void store_tile_bf16(const f32x4 (&acc)[2][2][4][2], bf16_t* base, size_t ldc, int wr, int wc, int fr, int fq) {
    bf16_t* b0 = base + (size_t)(wr * 64 + fr) * ldc + wc * 32 + 8 * fq;
#pragma unroll
    for (int ai = 0; ai < 2; ++ai)
#pragma unroll
        for (int m = 0; m < 4; ++m) { bf16_t* rowp = b0 + (size_t)(ai * HALF + m * 16) * ldc;
#pragma unroll
            for (int bj = 0; bj < 2; ++bj) { const f32x4 v0 = acc[ai][bj][m][0], v1 = acc[ai][bj][m][1];
                u32x4 w; w.x = cvt_pk_bf16(v0[0], v0[1]); w.y = cvt_pk_bf16(v0[2], v0[3]); w.z = cvt_pk_bf16(v1[0], v1[1]); w.w = cvt_pk_bf16(v1[2], v1[3]);
                *(u32x4*)(rowp + bj * HALF) = w; } }
}
__device__ __forceinline__ void store_tile_bf16_adj_sc(const f32x4 (&acc)[2][2][4][2], bf16_t* base, size_t ldc, int wr, int wc, int fr, int fq, float sc) {
    bf16_t* b0 = base + (size_t)(wr * 64 + fr) * ldc + wc * 64 + 8 * fq;
#pragma unroll
    for (int ai = 0; ai < 2; ++ai)
#pragma unroll
        for (int m = 0; m < 4; ++m) { bf16_t* rowp = b0 + (size_t)(ai * HALF + m * 16) * ldc;
#pragma unroll
            for (int bj = 0; bj < 2; ++bj) { const f32x4 v0 = acc[ai][bj][m][0] * sc, v1 = acc[ai][bj][m][1] * sc;
                u32x4 w; w.x = cvt_pk_bf16(v0[0], v0[1]); w.y = cvt_pk_bf16(v0[2], v0[3]); w.z = cvt_pk_bf16(v1[0], v1[1]); w.w = cvt_pk_bf16(v1[2], v1[3]);
                *(u32x4*)(rowp + bj * 32) = w; } }
}
__device__ __forceinline__ void store_tile_bf16_sc(const f32x4 (&acc)[2][2][4][2], bf16_t* base, size_t ldc, int wr, int wc, int fr, int fq, float sc) {
    bf16_t* b0 = base + (size_t)(wr * 64 + fr) * ldc + wc * 32 + 8 * fq;
#pragma unroll
    for (int ai = 0; ai < 2; ++ai)
#pragma unroll
        for (int m = 0; m < 4; ++m) { bf16_t* rowp = b0 + (size_t)(ai * HALF + m * 16) * ldc;
#pragma unroll
            for (int bj = 0; bj < 2; ++bj) { const f32x4 v0 = acc[ai][bj][m][0] * sc, v1 = acc[ai][bj][m][1] * sc;
                u32x4 w; w.x = cvt_pk_bf16(v0[0], v0[1]); w.y = cvt_pk_bf16(v0[2], v0[3]); w.z = cvt_pk_bf16(v1[0], v1[1]); w.w = cvt_pk_bf16(v1[2], v1[3]);
                *(u32x4*)(rowp + bj * HALF) = w; } }
}
__device__ __forceinline__ void store_tile_bf16_adj(const f32x4 (&acc)[2][2][4][2], bf16_t* base, size_t ldc, int wr, int wc, int fr, int fq) {
    bf16_t* b0 = base + (size_t)(wr * 64 + fr) * ldc + wc * 64 + 8 * fq;
#pragma unroll
    for (int ai = 0; ai < 2; ++ai)
#pragma unroll
        for (int m = 0; m < 4; ++m) { bf16_t* rowp = b0 + (size_t)(ai * HALF + m * 16) * ldc;
#pragma unroll
            for (int bj = 0; bj < 2; ++bj) { const f32x4 v0 = acc[ai][bj][m][0], v1 = acc[ai][bj][m][1];
                u32x4 w; w.x = cvt_pk_bf16(v0[0], v0[1]); w.y = cvt_pk_bf16(v0[2], v0[3]); w.z = cvt_pk_bf16(v1[0], v1[1]); w.w = cvt_pk_bf16(v1[2], v1[3]);
                *(u32x4*)(rowp + bj * 32) = w; } }
}
template <class Epi, class Sched, bool ALIGN_EPI = false, bool SP2 = false, bool F8 = false>
__device__ __forceinline__ void gemm_phase(PG8_LAS unsigned char* lds, const int K_in, const Sched& S, const Epi& E, const int wid_in  , const int pitch_in = 0  ) {
    unsigned zero_ = 0u; asm volatile("" : "+s"(zero_)); const int lane_ = (int)__builtin_amdgcn_mbcnt_hi(~0u, __builtin_amdgcn_mbcnt_lo(~0u, zero_));
    const int wid = wid_in, lane = lane_, tid = wid * 64 + lane, wr = wid >> 2, wc = wid & 3, fr = lane & 15, fq = lane >> 4;
    int K = K_in; asm volatile("" : "+s"(K));
    const int nt = K / BK;
    int LD = pitch_in ? pitch_in : K_in; asm volatile("" : "+s"(LD));
    unsigned voffA[2], voffB[2];
#pragma unroll
    for (int i = 0; i < 2; ++i) { int R, C; stage_rc(tid * 16 + i * 8192, R, C); const int Rb = Epi::BADJ ? ((R >> 5) * 64 + perm32(R & 31)) : Epi::PERM ? ((R & ~31) + perm32(R & 31)) : R;
        voffA[i] = (unsigned)(R * LD + C) * 2u; voffB[i] = (unsigned)(Rb * LD + C) * 2u; }
    const size_t kstep = (size_t)(BK * 2);
    const size_t hstep = (size_t)HALF * LD * 2;
    constexpr bool GA = Sched::GATHER; constexpr unsigned TOK_OFF = 131072u;
    const size_t hstepA = GA ? (size_t)0 : hstep;
    unsigned vA[2][2];
#pragma unroll
    for (int h = 0; h < 2; ++h)
#pragma unroll
        for (int i = 0; i < 2; ++i) vA[h][i] = voffA[i];
    constexpr bool BG = Sched::BGATHER;
    static_assert(!(BG && Epi::BADJ), "computed B rows use the plain half split");
    const size_t hstepB0 = Epi::BADJ ? (size_t)32 * LD * 2 : hstep;
    const size_t hstepBv = BG ? (size_t)0 : hstepB0;
    unsigned vB[2][2];
#pragma unroll
    for (int h = 0; h < 2; ++h)
#pragma unroll
        for (int i = 0; i < 2; ++i) vB[h][i] = voffB[i];
#define PG8_BOFF(dst, unit, h_) do { unsigned zb_ = 0u; asm volatile("" : "+s"(zb_)); const int tb2_ = wid * 64 + (int)__builtin_amdgcn_mbcnt_hi(~0u, __builtin_amdgcn_mbcnt_lo(~0u, zb_)); \
        _Pragma("unroll") for (int i_ = 0; i_ < 2; ++i_) { int R_, C_; stage_rc(tb2_ * 16 + i_ * 8192, R_, C_); const int Rb_ = Epi::PERM ? ((R_ & ~31) + perm32(R_ & 31)) : R_; \
            dst[i_] = S.boff(unit, (h_) * 128 + Rb_) + (unsigned)C_ * 2u; } } while (0)
#define PG8_STAGE_BN(bufoff, gbase, h_) do { if constexpr (BG) { if (last) { unsigned tw_[2]; if (has_next) PG8_BOFF(tw_, nxt, h_); else PG8_BOFF(tw_, cur, h_); PG8_STAGE(bufoff, gbase, tw_); } else PG8_STAGE(bufoff, gbase, vB[h_]); } \
        else PG8_STAGE(bufoff, (gbase) + (h_) * hstepB0, voffB); } while (0)
#define PG8_TOKDMA(unit, bufi) do { if (wid < 4) { unsigned zt_ = 0u; asm volatile("" : "+s"(zt_)); const unsigned lt_ = __builtin_amdgcn_mbcnt_hi(~0u, __builtin_amdgcn_mbcnt_lo(~0u, zt_)) * 4u; \
        const char* tb_ = (const char*)S.tokptr(unit) + wid * 256; \
        asm volatile("s_mov_b32 m0, %2\n\ts_nop 0\n\tglobal_load_lds_dword %0, %1" :: "v"(lt_), "s"(tb_), "s"(ldsu + TOK_OFF + (unsigned)(bufi) * 1024u + (unsigned)wid * 256u) : "memory", "m0"); } } while (0)
#define PG8_TOKREADH(dst, bufi, h_) do { unsigned zr_ = 0u; asm volatile("" : "+s"(zr_)); const int tr_ = wid * 64 + (int)__builtin_amdgcn_mbcnt_hi(~0u, __builtin_amdgcn_mbcnt_lo(~0u, zr_)); \
        const PG8_LAS int* tk_ = (const PG8_LAS int*)(lds + TOK_OFF + (bufi) * 1024); \
        _Pragma("unroll") for (int i_ = 0; i_ < 2; ++i_) { int R_, C_; stage_rc(tr_ * 16 + i_ * 8192, R_, C_); dst[i_] = (unsigned)tk_[(h_) * 128 + R_] * (unsigned)(LD * 2) + (unsigned)C_ * 2u; } } while (0)
#define PG8_TOKREAD(dst, bufi) do { PG8_TOKREADH(dst[0], bufi, 0); PG8_TOKREADH(dst[1], bufi, 1); } while (0)
#define PG8_STAGE_AN(bufoff, gbase, h_) do { if constexpr (GA) { if (last) { unsigned tv_[2]; PG8_TOKREADH(tv_, has_next ? ((ui + 1) & 1) : (ui & 1), h_); PG8_STAGE(bufoff, gbase, tv_); } else PG8_STAGE(bufoff, gbase, vA[h_]); } \
        else PG8_STAGE(bufoff, (gbase) + (h_) * hstep, voffA); } while (0)
    const unsigned ldsu = (unsigned)(uintptr_t)lds;
    const unsigned ldsw = (unsigned)wid * 1024u;
    const int aoff = lds_byte(wr * 64 + fr, fq * 8), boff = lds_byte(wc * 32 + fr, fq * 8);
#define PG8_SA(b, h) (((b) * 2 + (h)) * HTB)
#define PG8_SB(b, h) ((4 + (b) * 2 + (h)) * HTB)
#define PG8_STAGE(bufoff, gbase, voff) do { const char* gb_ = (const char*)(gbase);     \
        _Pragma("unroll") for (int _i = 0; _i < 2; ++_i) \
        asm volatile("s_mov_b32 m0, %2\n\ts_nop 0\n\tglobal_load_lds_dwordx4 %0, %1" :: "v"((voff)[_i]), "s"(gb_), "s"(ldsu + (unsigned)((bufoff) + _i * 8192) + ldsw) : "memory", "m0"); } while (0)
#define PG8_LDA(dst, b, h) do { _Pragma("unroll") for (int m = 0; m < 4; ++m) _Pragma("unroll") for (int k = 0; k < 2; ++k) dst[m][k] = *(const PG8_LAS bf16x8*)(lds + PG8_SA(b, h) + aoff + m * 2048 + k * 1024); } while (0)
#define PG8_LDB(dst, b, h) do { _Pragma("unroll") for (int n = 0; n < 2; ++n) _Pragma("unroll") for (int k = 0; k < 2; ++k) dst[n][k] = *(const PG8_LAS bf16x8*)(lds + PG8_SB(b, h) + boff + n * 2048 + k * 1024); } while (0)
#define PG8_CAT8(X) __builtin_shufflevector(__builtin_bit_cast(i32x4, X[0]), __builtin_bit_cast(i32x4, X[1]), 0, 1, 2, 3, 4, 5, 6, 7)
#define PG8_MMA(ai, bj, At, Bt) do { __builtin_amdgcn_s_setprio(1); _Pragma("unroll") for (int m = 0; m < 4; ++m) _Pragma("unroll") for (int n = 0; n < 2; ++n) { \
        if constexpr (F8) acc[ai][bj][m][n] = __builtin_amdgcn_mfma_scale_f32_16x16x128_f8f6f4(PG8_CAT8(Bt[n]), PG8_CAT8(At[m]), acc[ai][bj][m][n], 0, 0, 0, 0, 0, 0); \
        else { _Pragma("unroll") for (int k = 0; k < 2; ++k) acc[ai][bj][m][n] = __builtin_amdgcn_mfma_f32_16x16x32_bf16(Bt[n][k], At[m][k], acc[ai][bj][m][n], 0, 0, 0); } } __builtin_amdgcn_s_setprio(0); } while (0)
#define PG8_MMA0(ai, bj, At, Bt) do { __builtin_amdgcn_s_setprio(1); _Pragma("unroll") for (int m = 0; m < 4; ++m) _Pragma("unroll") for (int n = 0; n < 2; ++n) { const f32x4 z4_ = (f32x4){0.f, 0.f, 0.f, 0.f}; \
        if constexpr (F8) acc[ai][bj][m][n] = __builtin_amdgcn_mfma_scale_f32_16x16x128_f8f6f4(PG8_CAT8(Bt[n]), PG8_CAT8(At[m]), z4_, 0, 0, 0, 0, 0, 0); \
        else { acc[ai][bj][m][n] = __builtin_amdgcn_mfma_f32_16x16x32_bf16(Bt[n][0], At[m][0], z4_, 0, 0, 0); acc[ai][bj][m][n] = __builtin_amdgcn_mfma_f32_16x16x32_bf16(Bt[n][1], At[m][1], acc[ai][bj][m][n], 0, 0, 0); } } __builtin_amdgcn_s_setprio(0); } while (0)
#define PG8_WAIT_V(n) asm volatile("s_waitcnt vmcnt(" #n ")" ::: "memory")
#define PG8_WAIT_L(n) asm volatile("s_waitcnt lgkmcnt(" #n ")" ::: "memory")
#define PG8_BAR __builtin_amdgcn_s_barrier()
#define PG8_SCHED __builtin_amdgcn_sched_barrier(0)
    Unit cur, nxt; int ui = 0;
    if (!S.next(0, cur)) return;
    static_assert(SP2, "the accumulators are only started from C = 0 in the two-super-phase loop");
    f32x4 acc[2][2][4][2];
    bf16x8 At[4][2], B0[2][2], B1[2][2];
    const char* cA = S.aptr(cur); const char* cB = S.bptr(cur);
    if constexpr (BG) { PG8_BOFF(vB[0], cur, 0); PG8_BOFF(vB[1], cur, 1); }
    if constexpr (GA) { PG8_TOKDMA(cur, 0); asm volatile("s_waitcnt vmcnt(0)" ::: "memory"); __builtin_amdgcn_s_barrier(); PG8_TOKREAD(vA, 0); }
    if constexpr (SP2) {
        PG8_STAGE(PG8_SB(0, 0), cB, vB[0]); PG8_STAGE(PG8_SB(0, 1), cB + hstepBv, vB[1]); PG8_STAGE(PG8_SA(0, 0), cA, vA[0]); PG8_STAGE(PG8_SA(0, 1), cA + hstepA, vA[1]);
        if (wr == 1) PG8_BAR;
        PG8_WAIT_V(2); PG8_BAR;
        PG8_STAGE(PG8_SB(1, 0), cB + kstep, vB[0]); PG8_STAGE(PG8_SA(1, 0), cA + kstep, vA[0]); PG8_STAGE(PG8_SB(1, 1), cB + hstepBv + kstep, vB[1]);
        PG8_WAIT_V(6); PG8_BAR;
    } else {
        PG8_STAGE(PG8_SB(0, 0), cB, voffB); PG8_STAGE(PG8_SA(0, 0), cA, voffA); PG8_STAGE(PG8_SB(0, 1), cB + hstep, voffB); PG8_STAGE(PG8_SA(0, 1), cA + hstep, voffA);
        if (wr == 1) PG8_BAR;
        PG8_WAIT_V(4); PG8_BAR;
        PG8_STAGE(PG8_SB(1, 0), cB + kstep, voffB); PG8_STAGE(PG8_SA(1, 0), cA + kstep, voffA); PG8_STAGE(PG8_SB(1, 1), cB + hstep + kstep, voffB);
        PG8_WAIT_V(6); PG8_BAR;
    }
    for (;;) {
        const bool has_next = S.next(ui + 1, nxt);
        const char* nA = has_next ? S.aptr(nxt) : cA; const char* nB = has_next ? S.bptr(nxt) : cB;
        if constexpr (GA) { if (has_next) PG8_TOKDMA(nxt, (ui + 1) & 1); }
#pragma clang loop unroll(disable)
        for (int t = 0; t < nt; t += 2) {
            const bool last = (t == nt - 2);
            const char* a1 = cA + (size_t)(t + 1) * kstep;
            const char* a2 = last ? nA : cA + (size_t)(t + 2) * kstep; const char* b2 = last ? nB : cB + (size_t)(t + 2) * kstep;
            const char* a3 = a2 + kstep; const char* b3 = b2 + kstep;
            if constexpr (SP2) {
            PG8_LDB(B0, 0, 0); PG8_LDB(B1, 0, 1); PG8_SCHED; PG8_LDA(At, 0, 0); PG8_STAGE(PG8_SA(1, 1), a1 + hstepA, vA[1]);
            PG8_WAIT_V(8); PG8_WAIT_L(0); PG8_BAR; if (t == 0) { PG8_MMA0(0, 0, At, B0); PG8_MMA0(0, 1, At, B1); } else { PG8_MMA(0, 0, At, B0); PG8_MMA(0, 1, At, B1); } PG8_BAR; PG8_SCHED;
            PG8_LDA(At, 0, 1); PG8_STAGE_BN(PG8_SB(0, 0), b2, 0); PG8_STAGE_BN(PG8_SB(0, 1), b2, 1); PG8_STAGE_AN(PG8_SA(0, 0), a2, 0);
            PG8_WAIT_V(8); PG8_WAIT_L(0); PG8_BAR; if (t == 0) { PG8_MMA0(1, 0, At, B0); PG8_MMA0(1, 1, At, B1); } else { PG8_MMA(1, 0, At, B0); PG8_MMA(1, 1, At, B1); } PG8_BAR; PG8_SCHED;
            PG8_LDB(B0, 1, 0); PG8_LDB(B1, 1, 1); PG8_SCHED; PG8_LDA(At, 1, 0); PG8_STAGE_AN(PG8_SA(0, 1), a2, 1);
            PG8_WAIT_V(8); PG8_WAIT_L(0); PG8_BAR; PG8_MMA(0, 0, At, B0); PG8_MMA(0, 1, At, B1); PG8_BAR; PG8_SCHED;
            PG8_LDA(At, 1, 1); PG8_STAGE_BN(PG8_SB(1, 0), b3, 0); PG8_STAGE_BN(PG8_SB(1, 1), b3, 1); PG8_STAGE_AN(PG8_SA(1, 0), a3, 0);
            PG8_WAIT_V(8); PG8_WAIT_L(0); PG8_BAR; PG8_MMA(1, 0, At, B0); PG8_MMA(1, 1, At, B1); PG8_BAR; PG8_SCHED;
            } else {
            PG8_LDB(B0, 0, 0); PG8_SCHED; PG8_LDA(At, 0, 0); PG8_STAGE(PG8_SA(1, 1), a1 + hstep, voffA);
            PG8_WAIT_L(8); PG8_BAR; PG8_WAIT_L(0); PG8_MMA(0, 0, At, B0); PG8_BAR; PG8_SCHED;
            PG8_LDB(B1, 0, 1); PG8_STAGE(PG8_SB(0, 0), b2, voffB);
            PG8_BAR; PG8_WAIT_L(0); PG8_MMA(0, 1, At, B1); PG8_BAR;
            PG8_LDA(At, 0, 1); PG8_STAGE(PG8_SA(0, 0), a2, voffA);
            PG8_BAR; PG8_WAIT_L(0); PG8_MMA(1, 0, At, B0); PG8_BAR; PG8_SCHED;
            PG8_STAGE(PG8_SB(0, 1), b2 + hstep, voffB);
            PG8_WAIT_V(6); PG8_BAR; PG8_MMA(1, 1, At, B1); PG8_BAR;
            PG8_LDB(B0, 1, 0); PG8_SCHED; PG8_LDA(At, 1, 0); PG8_STAGE(PG8_SA(0, 1), a2 + hstep, voffA);
            PG8_WAIT_L(8); PG8_BAR; PG8_WAIT_L(0); PG8_MMA(0, 0, At, B0); PG8_BAR; PG8_SCHED;
            PG8_LDB(B1, 1, 1); PG8_STAGE(PG8_SB(1, 0), b3, voffB);
            PG8_BAR; PG8_WAIT_L(0); PG8_MMA(0, 1, At, B1); PG8_BAR;
            PG8_LDA(At, 1, 1); PG8_STAGE(PG8_SA(1, 0), a3, voffA);
            PG8_BAR; PG8_WAIT_L(0); PG8_MMA(1, 0, At, B0); PG8_BAR; PG8_SCHED;
            PG8_STAGE(PG8_SB(1, 1), b3 + hstep, voffB);
            PG8_WAIT_V(6); PG8_BAR; PG8_MMA(1, 1, At, B1); PG8_BAR;
            }
        }
        if constexpr (ALIGN_EPI) { if (wr == 0) PG8_BAR; }
        if constexpr (!Epi::AFTER_DRAIN) { unsigned z2_ = 0u; asm volatile("" : "+s"(z2_)); const int l2_ = (int)__builtin_amdgcn_mbcnt_hi(~0u, __builtin_amdgcn_mbcnt_lo(~0u, z2_)); const int fr_ = l2_ & 15, fq_ = l2_ >> 4;     E(acc, cur, wr, wc, fr_, fq_); }
        if (!has_next) break;
        cur = nxt; cA = nA; cB = nB; ++ui;
        if constexpr (GA) PG8_TOKREAD(vA, ui & 1);
        if constexpr (BG) { PG8_BOFF(vB[0], cur, 0); PG8_BOFF(vB[1], cur, 1); }
        if constexpr (ALIGN_EPI) { if (wr == 1) PG8_BAR; }
    }
    PG8_WAIT_V(0);
    if constexpr (!ALIGN_EPI) { if (wr == 0) PG8_BAR; }
    PG8_BAR;
    if constexpr (Epi::AFTER_DRAIN) { E.fused(acc, cur, wr, wc, fr, fq, lds, wid, lane); }
#undef PG8_SA
#undef PG8_SB
#undef PG8_STAGE
#undef PG8_TOKDMA
#undef PG8_TOKREAD
#undef PG8_BOFF
#undef PG8_STAGE_BN
#undef PG8_TOKREADH
#undef PG8_STAGE_AN
#undef PG8_LDA
#undef PG8_LDB
#undef PG8_MMA
#undef PG8_MMA0
#undef PG8_CAT8
#undef PG8_WAIT_V
#undef PG8_WAIT_L
#undef PG8_BAR
#undef PG8_SCHED
}
}

#include <hip/hip_bf16.h>
#include <cmath>
namespace attn_body {
using bf16=__hip_bfloat16;
using bf16x8=__attribute__((ext_vector_type(8)))short;
using s16x4=__attribute__((ext_vector_type(4)))short;
using f32x16=__attribute__((ext_vector_type(16)))float;
using u32x4=__attribute__((ext_vector_type(4)))unsigned;
constexpr int D=64,QP=512,KP=128;
constexpr int NW=8,QBLK=32,QB=QBLK*NW,KVBLK=64;
__device__ __forceinline__ int crow(int r,int hi){return (r&3)+8*(r>>2)+4*hi;}
#define SBAR() __builtin_amdgcn_sched_barrier(0)
__device__ __forceinline__ void cmask(f32x16&p0,f32x16&p1,int jb,int qrel,int hi){
  const float NEG=-INFINITY; int kb=64*jb+4*hi;
  #pragma unroll
  for(int r=0;r<16;++r){int kv=kb+(r&3)+8*(r>>2); if(kv>qrel)p0[r]=NEG; if(kv+32>qrel)p1[r]=NEG;}
}

constexpr int NSLOT=3, SLOTB=8192;
constexpr int LDS_K=0, LDS_V=NSLOT*SLOTB, LDS_WS=2*NSLOT*SLOTB, LDS_OST=LDS_WS+NW*64*4, LDS_BYTES=LDS_OST+NW*4096;
constexpr float C2=0.125f*1.4426950408889634f;
__device__ __forceinline__ void glds16(const void*gsrc,unsigned lds_dst){unsigned keep;
  asm volatile("s_mov_b32 %0, m0\n\ts_mov_b32 m0, %2\n\ts_nop 0\n\tglobal_load_lds_dwordx4 %1, off\n\ts_mov_b32 m0, %0":"=&s"(keep):"v"(gsrc),"s"(lds_dst):"memory");}
__device__ __forceinline__ float max3f(float a,float b,float c){float r;asm("v_max3_f32 %0, %1, %2, %3":"=v"(r):"v"(a),"v"(b),"v"(c));return r;}
__device__ __forceinline__ float max2f(float a,float b){float r;asm("v_max_f32_e32 %0, %1, %2":"=v"(r):"v"(a),"v"(b));return r;}
__device__ __forceinline__ float fadd_s(float a,float b){float r;asm("v_add_f32_e32 %0, %1, %2":"=v"(r):"v"(a),"v"(b));return r;}
__device__ __forceinline__ float fsub_s(float a,float b){float r;asm("v_sub_f32_e32 %0, %1, %2":"=v"(r):"v"(a),"v"(b));return r;}
typedef float f32x2_t __attribute__((ext_vector_type(2))); typedef __bf16 bf16x2_t __attribute__((ext_vector_type(2)));
__device__ __forceinline__ unsigned cvtpk_s(float lo,float hi){f32x2_t v={lo,hi};bf16x2_t b=__builtin_convertvector(v,bf16x2_t);return __builtin_bit_cast(unsigned,b);}
#define WAIT_BAR(N) asm volatile("s_waitcnt vmcnt(" #N ") lgkmcnt(0)\n\ts_barrier":::"memory")

__device__ __forceinline__ void qkt(f32x16&p0,f32x16&p1,const char*Kslot,const bf16x8*qr,const f32x16&negm,int r32,int hi){
  const char*kb=Kslot+hi*1024+r32*16;
  #pragma unroll
  for(int d0=0;d0<4;++d0){
    const bf16x8 b0=*reinterpret_cast<const bf16x8*>(kb+d0*2048);
    const bf16x8 b1=*reinterpret_cast<const bf16x8*>(kb+d0*2048+512);
    if(d0==0){p0=__builtin_amdgcn_mfma_f32_32x32x16_bf16(b0,qr[0],negm,0,0,0);p1=__builtin_amdgcn_mfma_f32_32x32x16_bf16(b1,qr[0],negm,0,0,0);}
    else{p0=__builtin_amdgcn_mfma_f32_32x32x16_bf16(b0,qr[d0],p0,0,0,0);p1=__builtin_amdgcn_mfma_f32_32x32x16_bf16(b1,qr[d0],p1,0,0,0);}}
}
typedef __attribute__((address_space(3))) const char* lds_cptr;
typedef short v4i16_t __attribute__((ext_vector_type(4)));
__device__ __forceinline__ void kload8(bf16x8*kf,lds_cptr kp){
  kf[0]=*(const __attribute__((address_space(3))) bf16x8*)(kp);      kf[1]=*(const __attribute__((address_space(3))) bf16x8*)(kp+512);
  kf[2]=*(const __attribute__((address_space(3))) bf16x8*)(kp+2048); kf[3]=*(const __attribute__((address_space(3))) bf16x8*)(kp+2560);
  kf[4]=*(const __attribute__((address_space(3))) bf16x8*)(kp+4096); kf[5]=*(const __attribute__((address_space(3))) bf16x8*)(kp+4608);
  kf[6]=*(const __attribute__((address_space(3))) bf16x8*)(kp+6144); kf[7]=*(const __attribute__((address_space(3))) bf16x8*)(kp+6656);
}
__device__ __forceinline__ void kload2(bf16x8*kf,lds_cptr kp,int j){ kf[2*j]=*(const __attribute__((address_space(3))) bf16x8*)(kp+j*2048); kf[2*j+1]=*(const __attribute__((address_space(3))) bf16x8*)(kp+j*2048+512); }
__device__ __forceinline__ s16x4 vtr(lds_cptr p){ return __builtin_bit_cast(s16x4,__builtin_amdgcn_ds_read_tr16_b64_v4i16((__attribute__((address_space(3))) v4i16_t*)p)); }
__device__ __forceinline__ float rowmax(const f32x16&p0,const f32x16&p1){
  float a=max3f(p0[0],p0[1],p1[0]),b=max3f(p0[2],p0[3],p1[1]);a=max3f(a,p1[2],p1[3]);
  #pragma unroll
  for(int r=4;r<16;r+=4){a=max3f(a,p0[r],p0[r+1]);b=max3f(b,p0[r+2],p0[r+3]);a=max3f(a,p1[r],p1[r+1]);b=max3f(b,p1[r+2],p1[r+3]);}
  const float m=max2f(a,b);
  auto rr=__builtin_amdgcn_permlane32_swap(__float_as_uint(m),__float_as_uint(m),false,false);
  return max2f(__uint_as_float(rr[0]),__uint_as_float(rr[1]));
}
__device__ __forceinline__ void pv(f32x16*o,int vb,bf16x8 pa0,bf16x8 pa1,bf16x8 pa2,bf16x8 pa3){
  #pragma unroll
  for(int d0=0;d0<2;++d0){s16x4 lo[4],hi[4];
    #pragma unroll
    for(int ks=0;ks<4;++ks){
      asm volatile("ds_read_b64_tr_b16 %0,%1 offset:%c2":"=&v"(lo[ks]):"v"(vb),"i"(d0*4096+ks*1024):"memory");
      asm volatile("ds_read_b64_tr_b16 %0,%1 offset:%c2":"=&v"(hi[ks]):"v"(vb),"i"(d0*4096+ks*1024+512):"memory");}
    asm volatile("s_waitcnt lgkmcnt(0)":::"memory");SBAR();
    #define PK(k) (bf16x8){lo[k][0],lo[k][1],lo[k][2],lo[k][3],hi[k][0],hi[k][1],hi[k][2],hi[k][3]}
    o[d0]=__builtin_amdgcn_mfma_f32_32x32x16_bf16(pa0,PK(0),o[d0],0,0,0);
    o[d0]=__builtin_amdgcn_mfma_f32_32x32x16_bf16(pa1,PK(1),o[d0],0,0,0);
    o[d0]=__builtin_amdgcn_mfma_f32_32x32x16_bf16(pa2,PK(2),o[d0],0,0,0);
    o[d0]=__builtin_amdgcn_mfma_f32_32x32x16_bf16(pa3,PK(3),o[d0],0,0,0);
    #undef PK
  }
}

#ifndef ATTN_STORE16
#define ATTN_STORE16(p,v) (*(u32x4*)(p)=(v))
#endif
template<int THRL> __device__ __forceinline__ void attn_unit(long qrow0,long kvrow0,int h,int NT,const bf16*Q,const bf16*__restrict__ K,const bf16*__restrict__ V,bf16*O,char*shm,const int wid_in){
  unsigned zero_=0u; asm volatile("":"+s"(zero_)); const int lane_=(int)__builtin_amdgcn_mbcnt_hi(~0u,__builtin_amdgcn_mbcnt_lo(~0u,zero_));
  const int lane=lane_,r32=lane&31,hi=lane>>5; const int wid=wid_in;
  const bf16*Qw=Q+(qrow0+wid*QBLK)*QP+h*D;
  const bf16*Kh=K+kvrow0*KP+(h>>2)*D,*Vh=V+kvrow0*KP+(h>>2)*D;
  const unsigned lds0=(unsigned)(uintptr_t)shm;
  float*wsf=(float*)(shm+LDS_WS)+wid*64;
  const bf16*ksrc=Kh+(long)lane*KP+wid*8;
  const bf16*vsrc=Vh+(long)(16*(wid&3)+(lane>>2))*KP+(wid>>2)*32+(lane&3)*8;
  const unsigned kdst=lds0+LDS_K+wid*1024, vdst=lds0+LDS_V+wid*1024;
  #define DMA_K(t,slot) glds16(ksrc+(long)(t)*KVBLK*KP,(unsigned)__builtin_amdgcn_readfirstlane(kdst+(slot)))
  #define DMA_V(t,slot) glds16(vsrc+(long)(t)*KVBLK*KP,(unsigned)__builtin_amdgcn_readfirstlane(vdst+(slot)))
  const int vb0=(int)(lds0+LDS_V)+((lane>>4)&1)*32+(lane&3)*8+(4*hi+((lane&15)>>2))*64;
  const char*Kbase=shm+LDS_K; bf16x8 kf[8];
  const lds_cptr shm3=(lds_cptr)shm; const lds_cptr kp0=shm3+LDS_K+hi*1024+r32*16; const lds_cptr vp0=shm3+LDS_V+((lane>>4)&1)*32+(lane&3)*8+(4*hi+((lane&15)>>2))*64;
  DMA_K(0,0);DMA_V(0,0);DMA_K(1,SLOTB);
  bf16x8 qr[4];
  #pragma unroll
  for(int d0=0;d0<4;++d0)qr[d0]=*reinterpret_cast<const bf16x8*>(&Qw[(long)r32*QP+d0*16+hi*8]);
  float mhat=0.f,l_reg=0.f;f32x16 o[2];o[0]=f32x16{};o[1]=f32x16{};f32x16 negm=f32x16{};asm volatile("":"+v"(negm));
  #define CMASK(P0,P1,t) do{}while(0)
  bool resc=false;
  #define START(P0,P1) do{ const float rm=rowmax(P0,P1); resc=false; \
    { const float dl=rm; mhat=fadd_s(mhat,dl); \
      _Pragma("unroll") for(int r=0;r<16;++r){P0[r]=fsub_s(P0[r],dl);P1[r]=fsub_s(P1[r],dl);} \
      _Pragma("unroll") for(int r=0;r<16;++r)negm[r]=-mhat; asm volatile("":"+v"(negm)); } \
    _Pragma("unroll") for(int r=0;r<16;++r)P0[r]=__builtin_amdgcn_exp2f(P0[r]); }while(0)
  #define RESC() do{ if(resc){ asm volatile("s_waitcnt lgkmcnt(0)":::"memory"); \
      _Pragma("unroll") for(int d_=0;d_<2;++d_) _Pragma("unroll") for(int r=0;r<16;++r)o[d_][r]*=wsf[crow(r,hi)]; } }while(0)
  f32x16 pA0,pA1,pB0,pB1;
  int sl_prev=0,sl_cur=0,sl_next=SLOTB;
  #define ROT() do{sl_prev=sl_cur;sl_cur=sl_next;sl_next=(sl_next==(NSLOT-1)*SLOTB)?0:sl_next+SLOTB;}while(0)
  DMA_K(2,2*SLOTB);
  WAIT_BAR(3);
  qkt(pA0,pA1,Kbase,qr,negm,r32,hi);asm volatile("s_nop 15\n\ts_nop 7":"+v"(pA0),"+v"(pA1));CMASK(pA0,pA1,0);
  START(pA0,pA1);
  _Pragma("unroll") for(int r=0;r<16;++r)pA1[r]=__builtin_amdgcn_exp2f(pA1[r]);
  WAIT_BAR(0);
  DMA_K(3,0);DMA_V(1,SLOTB);
  ROT();
  kload8(kf,kp0+sl_cur);
  WAIT_BAR(2);
  s16x4 vlo[8],vhi[8]; u32x4 pw0,pw1,pw2,pw3;
  #define PKW(P,B) cvtpk_s(P[B],P[B+1])
  #define PAF(k) __builtin_bit_cast(bf16x8,pw##k)
  #define VFR(i) (bf16x8){vlo[i][0],vlo[i][1],vlo[i][2],vlo[i][3],vhi[i][0],vhi[i][1],vhi[i][2],vhi[i][3]}
  #define PIN(x) asm volatile("":"+v"(x))
  #define MX3(a,b,c) __builtin_fmaxf(__builtin_fmaxf((a),(b)),(c))
  #define GAPA(MF,A0,A1,A2,A3,W0,W1,PW) do{ MF; sacc+=A0; sacc+=A1; sacc+=A2; sacc+=A3; PIN(sacc); W0; W1; PIN(PW); SBAR(); }while(0)
  #define EX(v) __builtin_amdgcn_exp2f(v)
  #define GAPB(MF,X,B) do{ MF; X[B]=EX(X[B]); X[B+1]=EX(X[B+1]); X[B+2]=EX(X[B+2]); X[B+3]=EX(X[B+3]); PIN(X); SBAR(); }while(0)
  #define VRD(i) do{ vlo[i]=vtr(vp_+(((i)>>2)*4096+((i)&3)*1024)); vhi[i]=vtr(vp_+(((i)>>2)*4096+((i)&3)*1024+512)); }while(0)
  #define KRD(G,j) do{ if(G){ kload2(kf,kp0+sl_next,j); SBAR(); } }while(0)
  #define STEP(C0,C1,P0,P1,t,GK,GV,GL) do{ SBAR(); \
    const lds_cptr vp_=vp0+sl_prev; \
    VRD(0); SBAR(); float sacc=(P0[0]+P0[1]); \
    GAPA(C0=__builtin_amdgcn_mfma_f32_32x32x16_bf16(kf[0],qr[0],negm,0,0,0), P0[2],P0[3],P0[4],P0[5],     pw0[0]=PKW(P0,0), pw0[1]=PKW(P0,2), pw0); \
    VRD(4); SBAR(); GAPA(C1=__builtin_amdgcn_mfma_f32_32x32x16_bf16(kf[1],qr[0],negm,0,0,0), P0[6],P0[7],P0[8],P0[9],     pw0[2]=PKW(P0,4), pw0[3]=PKW(P0,6), pw0); \
    VRD(1); SBAR(); GAPA(C0=__builtin_amdgcn_mfma_f32_32x32x16_bf16(kf[2],qr[1],C0,0,0,0),   P0[10],P0[11],P0[12],P0[13], pw1[0]=PKW(P0,8), pw1[1]=PKW(P0,10), pw1); \
    VRD(5); SBAR(); GAPA(C1=__builtin_amdgcn_mfma_f32_32x32x16_bf16(kf[3],qr[1],C1,0,0,0),   P0[14],P0[15],P1[0],P1[1],   pw1[2]=PKW(P0,12),pw1[3]=PKW(P0,14), pw1); \
    VRD(2); SBAR(); GAPA(C0=__builtin_amdgcn_mfma_f32_32x32x16_bf16(kf[4],qr[2],C0,0,0,0),   P1[2],P1[3],P1[4],P1[5],     pw2[0]=PKW(P1,0), pw2[1]=PKW(P1,2), pw2); \
    VRD(6); SBAR(); GAPA(C1=__builtin_amdgcn_mfma_f32_32x32x16_bf16(kf[5],qr[2],C1,0,0,0),   P1[6],P1[7],P1[8],P1[9],     pw2[2]=PKW(P1,4), pw2[3]=PKW(P1,6), pw2); \
    VRD(3); SBAR(); GAPA(C0=__builtin_amdgcn_mfma_f32_32x32x16_bf16(kf[6],qr[3],C0,0,0,0),   P1[10],P1[11],P1[12],P1[13], pw3[0]=PKW(P1,8), pw3[1]=PKW(P1,10), pw3); \
    VRD(7); SBAR(); GAPA(C1=__builtin_amdgcn_mfma_f32_32x32x16_bf16(kf[7],qr[3],C1,0,0,0),   P1[14],P1[15],0.f,0.f,       pw3[2]=PKW(P1,12),pw3[3]=PKW(P1,14), pw3); \
    l_reg+=sacc; \
    if(GK){DMA_K((t)+3,sl_cur);} if(GV){DMA_V((t)+1,sl_next);} \
    CMASK(C0,C1,t); \
    { float a=MX3(C0[0],C0[1],C1[0]),b=MX3(C0[2],C0[3],C1[1]); a=MX3(a,C1[2],C1[3]); \
      _Pragma("unroll") for(int r=4;r<16;r+=4){a=MX3(a,C0[r],C0[r+1]);b=MX3(b,C0[r+2],C0[r+3]);a=MX3(a,C1[r],C1[r+1]);b=MX3(b,C1[r+2],C1[r+3]);} \
      float rm=__builtin_fmaxf(a,b); { auto rr=__builtin_amdgcn_permlane32_swap(__float_as_uint(rm),__float_as_uint(rm),false,false); rm=__builtin_fmaxf(__uint_as_float(rr[0]),__uint_as_float(rr[1])); } \
      resc=false; \
      if(__builtin_expect(__any(rm>(float)THRL),0)){ const float dl=__builtin_fmaxf(rm,0.f); mhat+=dl; \
        _Pragma("unroll") for(int r=0;r<16;++r){C0[r]-=dl;C1[r]-=dl;} \
        _Pragma("unroll") for(int r=0;r<16;++r)negm[r]=-mhat; asm volatile("":"+v"(negm)); \
        const float f=__builtin_amdgcn_exp2f(-dl); l_reg*=f; if(hi==0)wsf[r32]=f; resc=true; } } \
    SBAR(); \
    GAPB(o[0]=__builtin_amdgcn_mfma_f32_32x32x16_bf16(PAF(0),VFR(0),o[0],0,0,0), C0,0); \
    GAPB(o[1]=__builtin_amdgcn_mfma_f32_32x32x16_bf16(PAF(0),VFR(4),o[1],0,0,0), C0,4); \
    KRD(GL,0); GAPB(o[0]=__builtin_amdgcn_mfma_f32_32x32x16_bf16(PAF(1),VFR(1),o[0],0,0,0), C0,8); \
    KRD(GL,1); GAPB(o[1]=__builtin_amdgcn_mfma_f32_32x32x16_bf16(PAF(1),VFR(5),o[1],0,0,0), C0,12); \
    KRD(GL,2); GAPB(o[0]=__builtin_amdgcn_mfma_f32_32x32x16_bf16(PAF(2),VFR(2),o[0],0,0,0), C1,0); \
    KRD(GL,3); GAPB(o[1]=__builtin_amdgcn_mfma_f32_32x32x16_bf16(PAF(2),VFR(6),o[1],0,0,0), C1,4); \
    GAPB(o[0]=__builtin_amdgcn_mfma_f32_32x32x16_bf16(PAF(3),VFR(3),o[0],0,0,0), C1,8); \
    GAPB(o[1]=__builtin_amdgcn_mfma_f32_32x32x16_bf16(PAF(3),VFR(7),o[1],0,0,0), C1,12); \
    }while(0)
  int t=1;
  for(;t+5<NT;t+=2){
    STEP(pB0,pB1,pA0,pA1,t,true,true,true);     WAIT_BAR(2); RESC(); ROT();
    STEP(pA0,pA1,pB0,pB1,t+1,true,true,true);   WAIT_BAR(2); RESC(); ROT();
  }
  #define ENDW(tt) do{ if((tt)+3<NT){WAIT_BAR(2);} else if((tt)+2<NT){WAIT_BAR(1);} else {WAIT_BAR(0);} }while(0)
  for(;t+1<NT;t+=2){
    STEP(pB0,pB1,pA0,pA1,t,(t+3<NT),(t+1<NT),(t+1<NT));       ENDW(t);   RESC(); ROT();
    STEP(pA0,pA1,pB0,pB1,t+1,(t+4<NT),(t+2<NT),(t+2<NT));     ENDW(t+1); RESC(); ROT();
  }
  STEP(pB0,pB1,pA0,pA1,NT-1,false,false,false); RESC();
  { float sacc=pB0[0]+pB0[1]; _Pragma("unroll") for(int r=2;r<16;++r)sacc+=pB0[r]; _Pragma("unroll") for(int r=0;r<16;++r)sacc+=pB1[r]; l_reg+=sacc;
    pw0=(u32x4){PKW(pB0,0),PKW(pB0,2),PKW(pB0,4),PKW(pB0,6)};pw1=(u32x4){PKW(pB0,8),PKW(pB0,10),PKW(pB0,12),PKW(pB0,14)};pw2=(u32x4){PKW(pB1,0),PKW(pB1,2),PKW(pB1,4),PKW(pB1,6)};pw3=(u32x4){PKW(pB1,8),PKW(pB1,10),PKW(pB1,12),PKW(pB1,14)};
    SBAR(); pv(o,vb0+sl_cur,PAF(0),PAF(1),PAF(2),PAF(3)); }
  #undef PKW
  #undef PAF
  #undef VFR
  #undef PIN
  #undef MX3
  #undef GAPA
  #undef GAPB
  #undef EX
  #undef VRD
  #undef KRD
  #undef STEP
  #undef ENDW
  {auto rr=__builtin_amdgcn_permlane32_swap(__float_as_uint(l_reg),__float_as_uint(l_reg),false,false);l_reg=__uint_as_float(rr[0])+__uint_as_float(rr[1]);}
  if(hi==0)wsf[32+r32]=l_reg;asm volatile("s_waitcnt lgkmcnt(0)":::"memory");
  float rli[16];
  #pragma unroll
  for(int r=0;r<16;++r)rli[r]=__builtin_amdgcn_rcpf(wsf[32+crow(r,hi)]);
  bf16*Ow=O+(qrow0+wid*QBLK)*QP+h*D;
  { bf16*stg=(bf16*)(shm+LDS_OST)+wid*2048;
    #pragma unroll
    for(int r=0;r<16;++r){const int orow=crow(r,hi);
      #pragma unroll
      for(int d0=0;d0<2;++d0)stg[orow*64+d0*32+r32]=__float2bfloat16(o[d0][r]*rli[r]);}
    asm volatile("s_waitcnt lgkmcnt(0)":::"memory");
    #pragma unroll
    for(int i=0;i<4;++i){const int row=i*8+(lane>>3),ch=lane&7; const u32x4 v=*(const u32x4*)(stg+row*64+ch*8); ATTN_STORE16(Ow+(long)row*QP+ch*8,v);} }
  asm volatile("s_waitcnt lgkmcnt(0)\n\ts_barrier":::"memory");
  #undef DMA_K
  #undef DMA_V
  #undef CMASK
  #undef START
  #undef RESC
  #undef ROT
}
constexpr int ATTN_LDS_BYTES=LDS_BYTES;
#undef SBAR
#undef WAIT_BAR
}

constexpr int DM = 1024, NB = 16, SEQ = 2048, CTXL = 256, NLAT = NB * SEQ, NCTX = NB * CTXL, NTOK = NLAT + NCTX, NKV = SEQ + CTXL;
constexpr int INW = 1792, PAW = 1536, WINR = 2048, NMOD = 6;
constexpr int NE = 32, DFF = 1024, MAXT = 608, RBLK = 512, MAXRB = NTOK / RBLK;
constexpr float EPS = 1e-6f;
constexpr int NWAVES = 8;
#define PROBE_MASK 0ull
#ifndef MK_PER_PHASE
#define MK_PER_PHASE 0
#endif
constexpr int NPHASE = 2 + 13 * 2;

constexpr size_t MiB = 1u << 20;
constexpr size_t WS_CTL = 0, CTL_ZERO_BYTES = 1 * MiB;
constexpr size_t WS_WIN = 1 * MiB;
constexpr size_t WS_WOUT = WS_WIN + 8 * MiB;
constexpr size_t WS_WR = WS_WOUT + 4 * MiB;
constexpr size_t WS_WGU = WS_WR + 1 * MiB;
constexpr size_t WS_WDN = WS_WGU + 256 * MiB;
constexpr size_t WS_WF = WS_WDN + 128 * MiB;
constexpr size_t WS_DFT = WS_WF + 4 * MiB;
constexpr size_t WS_DFTC = WS_DFT + 16 * MiB;
constexpr size_t WS_MOD = WS_DFTC + 1 * MiB;
constexpr size_t WS_ROPE = WS_MOD + 1 * MiB;
constexpr size_t WS_XCTX = WS_ROPE + 1 * MiB;
constexpr size_t WS_H = WS_XCTX + 16 * MiB;
constexpr size_t WS_F = WS_H + 72 * MiB;
constexpr size_t WS_PA = WS_F + 72 * MiB;
constexpr size_t WS_FT = WS_PA + 108 * MiB;
constexpr size_t WS_FTC = WS_FT + 32 * MiB;
constexpr size_t WS_Q = WS_FTC + 4 * MiB;
constexpr size_t WS_K = WS_Q + 36 * MiB;
constexpr size_t WS_V = WS_K + 9 * MiB;
constexpr size_t WS_CONV = WS_V + 9 * MiB;
constexpr size_t WS_O = WS_CONV + 18 * MiB;
constexpr size_t WS_YF = WS_O + 36 * MiB;
constexpr size_t WS_MERGED = WS_YF + 36 * MiB;
constexpr size_t WS_MIX = WS_MERGED + 72 * MiB;
constexpr size_t WS_LOG = WS_MIX + 72 * MiB;
constexpr size_t WS_EID = WS_LOG + 9 * MiB;
constexpr size_t WS_WT = WS_EID + 1 * MiB;
constexpr size_t WS_POS = WS_WT + 1 * MiB;
constexpr size_t WS_SLOT = WS_POS + 1 * MiB;
constexpr size_t WS_BCNT = WS_SLOT + 1 * MiB;
constexpr size_t WS_XS = WS_BCNT + 1 * MiB;
constexpr size_t WS_G = WS_XS + 304 * MiB;
constexpr size_t WS_Y = WS_G + 304 * MiB;
constexpr size_t WS_XB = WS_Y + 304 * MiB;
constexpr size_t WS_FTU = WS_XB + 72 * MiB;
constexpr size_t WS_FTUC = WS_FTU + 16 * MiB;
constexpr size_t WS_END = WS_FTUC + 2 * MiB;
constexpr int CW_BAR = 4096;

constexpr int RING_OFF = 0, RING_BYTES = 131072;
constexpr int SCR_BYTES = 8 * 16640;
constexpr int TAB_OFF = 135168;
constexpr int MISC_OFF = 147456;
constexpr int LDS_BYTES = 151552;
static_assert(SCR_BYTES <= TAB_OFF && TAB_OFF + 4096 <= MISC_OFF && MISC_OFF + 256 <= LDS_BYTES, "LDS map");

#define GAS __attribute__((address_space(1)))
#define LAS __attribute__((address_space(3)))
typedef unsigned short bf16;
typedef unsigned v4u __attribute__((ext_vector_type(4)));
typedef unsigned v2u __attribute__((ext_vector_type(2)));
typedef float f32x4 __attribute__((ext_vector_type(4)));
#define LDS_WAIT() asm volatile("s_waitcnt lgkmcnt(0)" ::: "memory")
#define VM_WAIT() asm volatile("s_waitcnt vmcnt(0)" ::: "memory")
__device__ __forceinline__ unsigned pk2(float lo, float hi) { return pg8::cvt_pk_bf16(lo, hi); }
__device__ __forceinline__ unsigned pk4_fp8(float a, float b, float c, float d) { int w = __builtin_amdgcn_cvt_pk_fp8_f32(a, b, __float_as_int(a), false); w = __builtin_amdgcn_cvt_pk_fp8_f32(c, d, w, true); return (unsigned)w; }
constexpr float S_W = 256.0f, S_G = 4.0f, S_Y = 4.0f;
__device__ __forceinline__ float bflo(unsigned u) { return __uint_as_float(u << 16); }
__device__ __forceinline__ float bfhi(unsigned u) { return __uint_as_float(u & 0xffff0000u); }
__device__ __forceinline__ float shx(float v, int m, int lane) { return __int_as_float(__builtin_amdgcn_ds_bpermute((lane ^ m) << 2, __float_as_int(v))); }
__device__ __forceinline__ float wave_sum(float v, int lane) {
#pragma unroll
    for (int o = 1; o < 64; o <<= 1) v += shx(v, o, lane);
    return v;
}
__device__ __forceinline__ float rsq(float x) { return __builtin_amdgcn_rsqf(x); }
__device__ __forceinline__ float sin_rev(float x) { return __builtin_amdgcn_sinf(__builtin_amdgcn_fractf(x)); }
__device__ __forceinline__ float cos_rev(float x) { return __builtin_amdgcn_cosf(__builtin_amdgcn_fractf(x)); }

#define XB_TMO      128
#define XB_XCNT(j)  (256  + 64 * (j))
#define XB_XSUB(j)  (1280 + 64 * (j))
#define XB_XGEN(j)  (2304 + 64 * (j))
#define XB_TOP      3328
#define XB_TOPGEN   3392
#define XCD_BAR_WORDS 3456
#define XB_SPIN_CAP (1u << 18)

__device__ __forceinline__ unsigned xb_ld(unsigned* p)              { return __hip_atomic_load(p, __ATOMIC_RELAXED, __HIP_MEMORY_SCOPE_AGENT); }
__device__ __forceinline__ unsigned xb_add(unsigned* p, unsigned v) { return __hip_atomic_fetch_add(p, v, __ATOMIC_RELAXED, __HIP_MEMORY_SCOPE_AGENT); }
__device__ __forceinline__ unsigned xb_xcc_id() { return (unsigned)__builtin_amdgcn_s_getreg((3 << 11) | 20) & 0xFu; }
#define XB_SPIN(cond, bar) do { unsigned _sp = 0; while (cond) { __builtin_amdgcn_s_sleep(1); \
    if ((++_sp & 255u) == 0u) { if (xb_ld(&(bar)[XB_TMO])) break; if (_sp > XB_SPIN_CAP) { atomicAdd(&(bar)[XB_TMO], 1u); break; } } } } while (0)

struct XcdBarrier {
    unsigned* bar; unsigned x;
    volatile LAS unsigned* st;
};

__device__ __forceinline__ XcdBarrier xcd_barrier_post(unsigned* bar, volatile LAS unsigned* st) {
    XcdBarrier b; b.bar = bar; b.x = xb_xcc_id(); b.st = st;
    if (threadIdx.x == 0) (void)xb_add(&bar[XB_XCNT(b.x)], 1u);
    return b;
}
__device__ __forceinline__ void xcd_barrier_complete(unsigned* bar, unsigned x, unsigned& nloc, unsigned& nx) {
    const unsigned G = gridDim.x * gridDim.y * gridDim.z;
    unsigned sum, cnt, mine, sp = 0u;
    for (;;) {
        sum = 0u; cnt = 0u; mine = 0u;
#pragma unroll
        for (unsigned j = 0; j < 16; ++j) { const unsigned c = xb_ld(&bar[XB_XCNT(j)]); sum += c; cnt += (c > 0u) ? 1u : 0u; mine = (j == x) ? c : mine; }
        if (sum == G) break;
        __builtin_amdgcn_s_sleep(1);
        if ((++sp & 255u) == 0u) { if (xb_ld(&bar[XB_TMO])) break; if (sp > XB_SPIN_CAP) { atomicAdd(&bar[XB_TMO], 1u); break; } }
    }
    nloc = mine > 0u ? mine : 1u; nx = cnt > 0u ? cnt : 1u;
}

__device__ __forceinline__ void xcd_barrier(const XcdBarrier& b) {
    asm volatile("s_waitcnt vmcnt(0)" ::: "memory");
    __syncthreads();
    if (threadIdx.x == 0) {
        unsigned* bar = b.bar;
        __builtin_amdgcn_s_waitcnt(0);
        unsigned nloc = b.st[0], nx = b.st[1];
        if (nloc == 0u) { xcd_barrier_complete(bar, b.x, nloc, nx); b.st[0] = nloc; b.st[1] = nx; }
        const unsigned old = xb_add(&bar[XB_XSUB(b.x)], 1u);
        const unsigned gen = old / nloc;
        if (old + 1u == (gen + 1u) * nloc) {
            __builtin_amdgcn_fence(__ATOMIC_RELEASE, "agent");
            asm volatile("s_waitcnt vmcnt(0)" ::: "memory");
            const unsigned og = xb_add(&bar[XB_TOP], 1u);
            const unsigned tg = og / nx;
            if (og + 1u == (tg + 1u) * nx) xb_add(&bar[XB_TOPGEN], 1u);
            else XB_SPIN(xb_ld(&bar[XB_TOPGEN]) == tg, bar);
            __builtin_amdgcn_fence(__ATOMIC_ACQUIRE, "agent");
            xb_add(&bar[XB_XGEN(b.x)], 1u);
            asm volatile("s_waitcnt vmcnt(0)" ::: "memory");
        } else {
            XB_SPIN(xb_ld(&bar[XB_XGEN(b.x)]) == gen, bar);
            __builtin_amdgcn_fence(__ATOMIC_ACQUIRE, "agent");
            asm volatile("s_waitcnt vmcnt(0)" ::: "memory");
        }
    }
    __syncthreads();
}


struct RowF { f32x4 v[4]; };
__device__ __forceinline__ void ld_row_f32(RowF& r, const float* p, int lane) { const f32x4* q = (const f32x4*)p + lane;
#pragma unroll
    for (int j = 0; j < 4; ++j) r.v[j] = q[64 * j]; }
__device__ __forceinline__ void st_row_f32(float* p, int lane, const RowF& r) { f32x4* q = (f32x4*)p + lane;
#pragma unroll
    for (int j = 0; j < 4; ++j) q[64 * j] = r.v[j]; }
__device__ __forceinline__ void ld_row_bf16(RowF& r, const bf16* p, int lane) { const v2u* q = (const v2u*)p + lane;
#pragma unroll
    for (int j = 0; j < 4; ++j) { const v2u w = q[64 * j]; r.v[j] = (f32x4){bflo(w.x), bfhi(w.x), bflo(w.y), bfhi(w.y)}; } }
__device__ __forceinline__ void st_row_bf16(bf16* p, int lane, const RowF& r) { v2u* q = (v2u*)p + lane;
#pragma unroll
    for (int j = 0; j < 4; ++j) { v2u w; w.x = pk2(r.v[j][0], r.v[j][1]); w.y = pk2(r.v[j][2], r.v[j][3]); q[64 * j] = w; } }
__device__ __forceinline__ float row_ss(const RowF& r, int lane) { float s = 0.f;
#pragma unroll
    for (int j = 0; j < 4; ++j) s += (r.v[j][0] * r.v[j][0] + r.v[j][1] * r.v[j][1]) + (r.v[j][2] * r.v[j][2] + r.v[j][3] * r.v[j][3]);
    return wave_sum(s, lane); }
__device__ __forceinline__ void modulate_store8(const RowF& x, const float* g, const float* sh, const float* sc, unsigned char* dst, int lane) {
    const float rstd = rsq(row_ss(x, lane) * (1.0f / DM) + EPS);
    RowF gg, s1, s2; ld_row_f32(gg, g, lane); ld_row_f32(s1, sc, lane); ld_row_f32(s2, sh, lane);
    unsigned* q = (unsigned*)dst + lane;
#pragma unroll
    for (int j = 0; j < 4; ++j) { const f32x4 o = x.v[j] * rstd * gg.v[j] * (s1.v[j] + 1.0f) + s2.v[j]; q[64 * j] = pk4_fp8(o[0], o[1], o[2], o[3]); }
}
__device__ __forceinline__ void modulate_store(const RowF& x, const float* g, const float* sh, const float* sc, bf16* dst, int lane) {
    const float rstd = rsq(row_ss(x, lane) * (1.0f / DM) + EPS);
    RowF gg, s1, s2; ld_row_f32(gg, g, lane); ld_row_f32(s1, sc, lane); ld_row_f32(s2, sh, lane);
    RowF o;
#pragma unroll
    for (int j = 0; j < 4; ++j) o.v[j] = x.v[j] * rstd * gg.v[j] * (s1.v[j] + 1.0f) + s2.v[j];
    st_row_bf16(dst, lane, o);
}

struct Params {
    const float *x, *c, *ctx, *c_ctx, *w_mod, *b_mod, *g_pre_mix, *g_post_mix, *g_pre_ffn, *g_post_ffn, *w_in, *g_q, *g_k, *conv_w, *g_branch, *w_out,
                *w_router, *b_router, *w_gu, *b_gu, *w_dn, *b_dn;
    float* out; unsigned char* ws; int ph_lo, ph_hi, li, pad;
};

__device__ __forceinline__ void tr_item(const float* W, size_t ldw, int k0, int n0, bf16* WT, size_t ldt, int drow0, LAS float* scr, int lane) {
    const int lr = lane >> 4, lc = (lane & 15) * 4;
    f32x4 v[16];
#pragma unroll
    for (int i = 0; i < 16; ++i) v[i] = *(const f32x4*)(W + (size_t)(k0 + 4 * i + lr) * ldw + n0 + lc);
#pragma unroll
    for (int i = 0; i < 16; ++i) { LAS float* s = scr + (4 * i + lr) * 65 + lc; s[0] = v[i][0]; s[1] = v[i][1]; s[2] = v[i][2]; s[3] = v[i][3]; }
    LDS_WAIT(); asm volatile("" ::: "memory");
    const int c = lane & 7;
    const LAS float* s0 = scr + (8 * c) * 65 + (lane >> 3);
    float t[8][8];
#pragma unroll
    for (int j = 0; j < 8; ++j)
#pragma unroll
        for (int q = 0; q < 8; ++q) t[j][q] = s0[q * 65 + 8 * j];
    LDS_WAIT(); asm volatile("" ::: "memory");
#pragma unroll
    for (int j = 0; j < 8; ++j) { const int n = (lane >> 3) + 8 * j;
        v4u o; o.x = pk2(t[j][0], t[j][1]); o.y = pk2(t[j][2], t[j][3]); o.z = pk2(t[j][4], t[j][5]); o.w = pk2(t[j][6], t[j][7]);
        *(v4u*)(WT + (size_t)(drow0 + n) * ldt + k0 + 8 * c) = o; }
}

__device__ __forceinline__ void tr_item2(const float* W, size_t ldw, int k0, int n0, bf16* WT, size_t ldt, int drowA, int drowB, LAS float* scr, int lane) {
    const int lr = lane >> 4, lc = (lane & 15) * 4;
    f32x4 v[16];
#pragma unroll
    for (int i = 0; i < 16; ++i) v[i] = *(const f32x4*)(W + (size_t)(k0 + 4 * i + lr) * ldw + n0 + lc);
#pragma unroll
    for (int i = 0; i < 16; ++i) { LAS float* s = scr + (4 * i + lr) * 65 + lc; s[0] = v[i][0]; s[1] = v[i][1]; s[2] = v[i][2]; s[3] = v[i][3]; }
    LDS_WAIT(); asm volatile("" ::: "memory");
    const int c = lane & 7;
    const LAS float* s0 = scr + (8 * c) * 65 + (lane >> 3);
    float t[8][8];
#pragma unroll
    for (int j = 0; j < 8; ++j)
#pragma unroll
        for (int q = 0; q < 8; ++q) t[j][q] = s0[q * 65 + 8 * j];
    LDS_WAIT(); asm volatile("" ::: "memory");
#pragma unroll
    for (int j = 0; j < 8; ++j) { const int n = (lane >> 3) + 8 * j; const int row = (j < 4) ? drowA + n : drowB + n - 32;
        v4u o; o.x = pk2(t[j][0], t[j][1]); o.y = pk2(t[j][2], t[j][3]); o.z = pk2(t[j][4], t[j][5]); o.w = pk2(t[j][6], t[j][7]);
        *(v4u*)(WT + (size_t)row * ldt + k0 + 8 * c) = o; }
}

__device__ __forceinline__ void tr_item2_8(const float* W, size_t ldw, int k0, int n0, unsigned char* WT8, size_t ldt, int drowA, int drowB, float sc, LAS float* scr, int lane) {
    const int lr = lane >> 4, lc = (lane & 15) * 4;
    f32x4 v[16];
#pragma unroll
    for (int i = 0; i < 16; ++i) v[i] = *(const f32x4*)(W + (size_t)(k0 + 4 * i + lr) * ldw + n0 + lc);
#pragma unroll
    for (int i = 0; i < 16; ++i) { LAS float* s = scr + (4 * i + lr) * 65 + lc; s[0] = v[i][0] * sc; s[1] = v[i][1] * sc; s[2] = v[i][2] * sc; s[3] = v[i][3] * sc; }
    LDS_WAIT(); asm volatile("" ::: "memory");
    const int c = lane & 7;
    const LAS float* s0 = scr + (8 * c) * 65 + (lane >> 3);
    float t[8][8];
#pragma unroll
    for (int j = 0; j < 8; ++j)
#pragma unroll
        for (int q = 0; q < 8; ++q) t[j][q] = s0[q * 65 + 8 * j];
    LDS_WAIT(); asm volatile("" ::: "memory");
#pragma unroll
    for (int j = 0; j < 8; ++j) { const int n = (lane >> 3) + 8 * j; const int row = (j < 4) ? drowA + n : drowB + n - 32;
        v2u o; o.x = pk4_fp8(t[j][0], t[j][1], t[j][2], t[j][3]); o.y = pk4_fp8(t[j][4], t[j][5], t[j][6], t[j][7]);
        *(v2u*)(WT8 + (size_t)row * ldt + k0 + 8 * c) = o; }
}

__device__ __forceinline__ void tr_item8(const float* W, size_t ldw, int k0, int n0, unsigned char* WT8, size_t ldt, int drow0, float sc, LAS float* scr, int lane) {
    const int lr = lane >> 4, lc = (lane & 15) * 4;
    f32x4 v[16];
#pragma unroll
    for (int i = 0; i < 16; ++i) v[i] = *(const f32x4*)(W + (size_t)(k0 + 4 * i + lr) * ldw + n0 + lc);
#pragma unroll
    for (int i = 0; i < 16; ++i) { LAS float* s = scr + (4 * i + lr) * 65 + lc; s[0] = v[i][0] * sc; s[1] = v[i][1] * sc; s[2] = v[i][2] * sc; s[3] = v[i][3] * sc; }
    LDS_WAIT(); asm volatile("" ::: "memory");
    const int c = lane & 7;
    const LAS float* s0 = scr + (8 * c) * 65 + (lane >> 3);
    float t[8][8];
#pragma unroll
    for (int j = 0; j < 8; ++j)
#pragma unroll
        for (int q = 0; q < 8; ++q) t[j][q] = s0[q * 65 + 8 * j];
    LDS_WAIT(); asm volatile("" ::: "memory");
#pragma unroll
    for (int j = 0; j < 8; ++j) { const int n = (lane >> 3) + 8 * j;
        v2u o; o.x = pk4_fp8(t[j][0], t[j][1], t[j][2], t[j][3]); o.y = pk4_fp8(t[j][4], t[j][5], t[j][6], t[j][7]);
        *(v2u*)(WT8 + (size_t)(drow0 + n) * ldt + k0 + 8 * c) = o; }
}

using pg8::Unit; using pg8::bf16_t;
typedef const pg8::f32x4 (&AccRef)[2][2][4][2];
constexpr size_t TILE1K = (size_t)256 * 1024 * 2;
constexpr size_t TILE8 = (size_t)256 * 1024;

struct InprojSched {
    static constexpr bool GATHER = false, BGATHER = false;
    int G, c, layer, n0, n1, nwg; const char* H; const char* W; size_t tb;
    __device__ __forceinline__ void init(int G_, int c_, int layer_, const void* H_, const void* W_) { G = G_; c = c_; layer = layer_; H = (const char*)H_; W = (const char*)W_; tb = (layer_ == 0) ? TILE1K : TILE8;
        n0 = (layer == 0) ? 144 * 6 : 128 * 6; n1 = (layer == 0) ? 0 : 16; nwg = n0 + n1 + ((layer == 0) ? 144 : 128); }
    __device__ __forceinline__ bool next(int i, Unit& u) const { int w; if (!pg8::list_index(i, G, c, nwg, w)) return false;
        if (w < n0) { u.pm = w / 6; u.pn = w % 6; u.kind = 0; } else if (w < n0 + n1) { u.pm = 128 + (w - n0); u.pn = 2; u.kind = 0; } else { u.pm = 0; u.pn = w - n0 - n1; u.kind = 1; }
        return true; }
    __device__ __forceinline__ const char* aptr(const Unit& u) const { return u.kind == 0 ? H + (size_t)u.pm * tb : W + (size_t)(6 + u.pm) * tb; }
    __device__ __forceinline__ const char* bptr(const Unit& u) const { return u.kind == 0 ? W + (size_t)u.pn * tb : H + (size_t)u.pn * tb; }
};
struct InprojEpi {
    static constexpr bool PERM = true, AFTER_DRAIN = false, BADJ = true;
    bf16_t *PA, *FT, *FTC, *QB, *KB, *VB; const LAS float* tab; float sc;
    __device__ __forceinline__ void heads(AccRef acc, const Unit& u, int wr, int wc, int fr, int fq) const {
        const int lane = fq * 16 + fr; const bool isq = u.pn < 2, isv = (!isq) && wc >= 2, isc = u.pm >= NLAT / 256;
        const LAS float* gp = tab + 2048 + (isq ? 0 : 64) + fq * 8;
        const int tb = (fq & 1) * 8; const bool hi = (fq >> 1) != 0;
        const f32x4 gA0 = *(const LAS f32x4*)(gp), gA1 = *(const LAS f32x4*)(gp + 4), gB0 = *(const LAS f32x4*)(gp + 32), gB1 = *(const LAS f32x4*)(gp + 36);
#pragma unroll
        for (int ai = 0; ai < 2; ++ai)
#pragma unroll
            for (int m = 0; m < 4; ++m) { const int row = u.pm * 256 + ai * 128 + wr * 64 + m * 16 + fr;
                int bb, t; if (!isc) { bb = row >> 11; t = row & 2047; } else { const int r2 = row - NLAT; bb = r2 >> 8; t = r2 & 255; }
                const size_t kvrow = (size_t)bb * NKV + (isc ? SEQ + t : t);
                float x[2][8];
#pragma unroll
                for (int bj = 0; bj < 2; ++bj)
#pragma unroll
                    for (int n = 0; n < 2; ++n)
#pragma unroll
                        for (int i = 0; i < 4; ++i) x[bj][n * 4 + i] = acc[ai][bj][m][n][i] * sc;
                if (isv) {
#pragma unroll
                    for (int bj = 0; bj < 2; ++bj) { v4u ow; ow.x = pk2(x[bj][0], x[bj][1]); ow.y = pk2(x[bj][2], x[bj][3]); ow.z = pk2(x[bj][4], x[bj][5]); ow.w = pk2(x[bj][6], x[bj][7]);
                        *(v4u*)(VB + kvrow * 128 + (wc - 2) * 64 + bj * 32 + fq * 8) = ow; }
                } else {
                    float ss = 0.f;
#pragma unroll
                    for (int bj = 0; bj < 2; ++bj)
#pragma unroll
                        for (int c = 0; c < 8; ++c) ss += x[bj][c] * x[bj][c];
                    ss += shx(ss, 16, lane); ss += shx(ss, 32, lane);
                    const float rstd = rsq(ss * (1.0f / 64.0f) + EPS) * (isq ? attn_body::C2 : 1.0f);
#pragma unroll
                    for (int bj = 0; bj < 2; ++bj) { const int pos = bj ? (t & 63) : (t >> 6);
                        f32x4 c0 = *(const LAS f32x4*)(tab + pos * 16 + tb), c1 = *(const LAS f32x4*)(tab + pos * 16 + tb + 4), s0 = *(const LAS f32x4*)(tab + 1024 + pos * 16 + tb), s1 = *(const LAS f32x4*)(tab + 1024 + pos * 16 + tb + 4);
                        if (isc) { c0 = (f32x4){1.f, 1.f, 1.f, 1.f}; c1 = c0; s0 = (f32x4){0.f, 0.f, 0.f, 0.f}; s1 = s0; }
                        const f32x4 g0 = bj ? gB0 : gA0, g1 = bj ? gB1 : gA1;
                        float o[8];
#pragma unroll
                        for (int c = 0; c < 8; ++c) { const float xn = x[bj][c] * rstd * (c < 4 ? g0[c & 3] : g1[c & 3]); const float xp = shx(xn, 32, lane);
                            const float cs = c < 4 ? c0[c & 3] : c1[c & 3], sn = c < 4 ? s0[c & 3] : s1[c & 3]; o[c] = hi ? xn * cs + xp * sn : xn * cs - xp * sn; }
                        v4u ow; ow.x = pk2(o[0], o[1]); ow.y = pk2(o[2], o[3]); ow.z = pk2(o[4], o[5]); ow.w = pk2(o[6], o[7]);
                        if (isq) *(v4u*)(QB + (size_t)row * 512 + (u.pn * 4 + wc) * 64 + bj * 32 + fq * 8) = ow;
                        else *(v4u*)(KB + kvrow * 128 + wc * 64 + bj * 32 + fq * 8) = ow; }
                } }
    }
    __device__ __forceinline__ void operator()(AccRef acc, const Unit& u, int wr, int wc, int fr, int fq) const {
        if (u.kind == 0 && u.pn <= 2) { heads(acc, u, wr, wc, fr, fq); return; }
        if (u.kind == 0 && u.pn >= 4) {
            bf16_t* b0 = PA + (size_t)(u.pm * 256 + wr * 64 + fr) * PAW + 1024 + (u.pn - 4) * 128 + wc * 32 + 8 * fq;
#pragma unroll
            for (int ai = 0; ai < 2; ++ai)
#pragma unroll
                for (int m = 0; m < 4; ++m) { const pg8::f32x4 p0 = (acc[ai][0][m][0] * sc) * (acc[ai][1][m][0] * sc), p1 = (acc[ai][0][m][1] * sc) * (acc[ai][1][m][1] * sc);
                    v4u w; w.x = pk2(p0[0], p0[1]); w.y = pk2(p0[2], p0[3]); w.z = pk2(p1[0], p1[1]); w.w = pk2(p1[2], p1[3]);
                    *(v4u*)(b0 + (size_t)(ai * 128 + m * 16) * PAW) = w; }
            return; }
        bf16_t* base; size_t ldc;
        if (u.kind == 0) { base = PA + (size_t)u.pm * 256 * PAW + u.pn * 256; ldc = PAW; }
        else if (u.pn < 128) { const int b = u.pn >> 3, nn = (u.pn & 7) * 256; base = FT + (size_t)b * 256 * 2048 + nn; ldc = 2048; }
        else { const int b = u.pn - 128; base = FTC + (size_t)b * 256 * 256; ldc = 256; }
        pg8::store_tile_bf16_adj_sc(acc, base, ldc, wr, wc, fr, fq, sc);
    }
};
constexpr size_t YF_CTX = (size_t)4 * NB * 1024 * 256;
template <bool CTX> struct FourierSchedT {
    static constexpr bool GATHER = false, BGATHER = !CTX;
    int G, c, nwg; const char* A; const char* B; size_t tileb;
    __device__ __forceinline__ bool next(int i, Unit& u) const { int w; if (!pg8::list_index(i, G, c, nwg, w)) return false;
        if (CTX) { u.pm = 0; u.pn = w; u.kind = 4; } else { u.kind = w & 3; u.pm = (w >> 2) & 3; u.pn = w >> 4; } return true; }
    __device__ __forceinline__ const char* aptr(const Unit& u) const { return CTX ? A : A + ((size_t)(1 + 256 * u.pm) * 4096 + (size_t)u.kind * 1024) * 2; }
    __device__ __forceinline__ const char* bptr(const Unit& u) const { return CTX ? B + (size_t)u.pn * tileb : B + (size_t)u.pn * tileb + (size_t)(u.kind & 1) * 1024 * 2; }
    __device__ __forceinline__ unsigned boff(const Unit& u, int ch) const { const int g = ch >> 6, k2 = ch & 63;
        const int uu = (u.kind & 2) ? (((k2 & 31) == 0) ? g * 64 : g * 64 + 32 + (k2 < 32 ? k2 : 64 - k2)) : g * 64 + (k2 <= 32 ? k2 : 64 - k2);
        return (unsigned)uu * 4096u; }
};
struct FourierEpi {
    static constexpr bool PERM = true, AFTER_DRAIN = false, BADJ = false;
    bf16_t* YF;
    __device__ __forceinline__ void operator()(AccRef acc, const Unit& u, int wr, int wc, int fr, int fq) const {
        bf16_t* base = (u.kind == 4) ? YF + YF_CTX + (size_t)u.pn * 256 * 256 : YF + (((size_t)u.kind * NB + u.pn) * 1024 + u.pm * 256) * 256;
        pg8::store_tile_bf16(acc, base, 256, wr, wc, fr, fq);
    }
};
struct PlainSched {
    static constexpr bool GATHER = false, BGATHER = false;
    int G, c, nN, nwg; const char* A; const char* B;
    __device__ __forceinline__ bool next(int i, Unit& u) const { int w; if (!pg8::list_index(i, G, c, nwg, w)) return false; u.pm = w >> 2; u.pn = w & 3; u.kind = 0; return true; }
    __device__ __forceinline__ const char* aptr(const Unit& u) const { return A + (size_t)u.pm * TILE1K; }
    __device__ __forceinline__ const char* bptr(const Unit& u) const { return B + (size_t)u.pn * TILE1K; }
};
struct OutEpi {
    static constexpr bool PERM = true, AFTER_DRAIN = false, BADJ = false;
    bf16_t* MIX;
    __device__ __forceinline__ void operator()(AccRef acc, const Unit& u, int wr, int wc, int fr, int fq) const { pg8::store_tile_bf16(acc, MIX + (size_t)u.pm * 256 * DM + u.pn * 256, DM, wr, wc, fr, fq); }
};
struct CtxKSched {
    static constexpr bool GATHER = false, BGATHER = false;
    int G, c, nwg; const char* A; const char* B;
    __device__ __forceinline__ bool next(int i, Unit& u) const { int w; if (!pg8::list_index(i, G, c, nwg, w)) return false; u.kind = w & 3; u.pn = (w >> 2) & 3; u.pm = w >> 4; return true; }
    __device__ __forceinline__ const char* aptr(const Unit& u) const { return A + (size_t)u.pm * TILE1K + (size_t)u.kind * 256 * 2; }
    __device__ __forceinline__ const char* bptr(const Unit& u) const { return B + (size_t)u.pn * TILE1K + (size_t)u.kind * 256 * 2; }
};
struct CtxKEpi {
    static constexpr bool PERM = true, AFTER_DRAIN = false, BADJ = false;
    bf16_t* MIXC;
    __device__ __forceinline__ void operator()(AccRef acc, const Unit& u, int wr, int wc, int fr, int fq) const { pg8::store_tile_bf16(acc, MIXC + ((size_t)u.kind * NCTX + (size_t)u.pm * 256) * DM + u.pn * 256, DM, wr, wc, fr, fq); }
};
struct RouterEpi {
    static constexpr bool PERM = false, AFTER_DRAIN = false, BADJ = false;
    float* LOG;
    __device__ __forceinline__ void operator()(AccRef acc, const Unit& u, int wr, int wc, int fr, int fq) const {
        if (wc >= 2) return;
#pragma unroll
        for (int ai = 0; ai < 2; ++ai)
#pragma unroll
            for (int m = 0; m < 4; ++m) { float* rowp = LOG + (size_t)(u.pm * 256 + ai * 128 + wr * 64 + m * 16 + fr) * 64 + wc * 32 + 4 * fq;
#pragma unroll
                for (int n = 0; n < 2; ++n) *(pg8::f32x4*)(rowp + 16 * n) = acc[ai][0][m][n]; }
    }
};
template <bool GATHER_> struct MoeSchedT {
    static constexpr bool GATHER = GATHER_, BGATHER = false;
    int G, c, ncol, nwg; const LAS int* tile_e; const char* A; const char* W; size_t wstride; const int* rowtok;
    __device__ __forceinline__ bool next(int i, Unit& u) const { int w; if (!pg8::list_index(i, G, c, nwg, w)) return false; u.pm = (ncol == 8) ? (w >> 3) : (w >> 2); u.pn = w & (ncol - 1); u.kind = __builtin_amdgcn_readfirstlane(tile_e[u.pm]); return true; }
    __device__ __forceinline__ const char* aptr(const Unit& u) const { return GATHER_ ? A : A + (size_t)u.pm * TILE8; }
    __device__ __forceinline__ const char* bptr(const Unit& u) const { return W + (size_t)u.kind * wstride + (size_t)u.pn * TILE8; }
    __device__ __forceinline__ const int* tokptr(const Unit& u) const { return rowtok + (size_t)u.pm * 256; }
};
__device__ __forceinline__ pg8::u32x4 widen16(unsigned m0d0, unsigned m0d1, unsigned m1d0, unsigned m1d1) {
    const auto r0 = __builtin_amdgcn_permlane16_swap(m0d0, m1d0, false, false); const auto r1 = __builtin_amdgcn_permlane16_swap(m0d1, m1d1, false, false);
    return (pg8::u32x4){r0[0], r1[0], r0[1], r1[1]};
}
struct PlainSched8 {
    static constexpr bool GATHER = false, BGATHER = false;
    int G, c, nN, nwg; const char* A; const char* B;
    __device__ __forceinline__ bool next(int i, Unit& u) const { int w; if (!pg8::list_index(i, G, c, nwg, w)) return false; u.pm = w >> 2; u.pn = w & 3; u.kind = 0; return true; }
    __device__ __forceinline__ const char* aptr(const Unit& u) const { return A + (size_t)u.pm * TILE8; }
    __device__ __forceinline__ const char* bptr(const Unit& u) const { return B + (size_t)u.pn * TILE8; }
};
constexpr float S_M = 4.0f;
struct OutEpi8 {
    static constexpr bool PERM = true, AFTER_DRAIN = false, BADJ = false;
    unsigned char* MIX8;
    __device__ __forceinline__ void operator()(AccRef acc, const Unit& u, int wr, int wc, int fr, int fq) const {
        unsigned char* b0 = MIX8 + (size_t)(u.pm * 256 + wr * 64 + (fq & 1) * 16 + fr) * DM + u.pn * 256 + wc * 32 + 16 * (fq >> 1);
#pragma unroll
        for (int bj = 0; bj < 2; ++bj)
#pragma unroll
            for (int ai = 0; ai < 2; ++ai)
#pragma unroll
                for (int mp = 0; mp < 2; ++mp) { unsigned w[2][2];
#pragma unroll
                    for (int mm = 0; mm < 2; ++mm) { const int m = 2 * mp + mm;
                        const pg8::f32x4 v0 = acc[ai][bj][m][0] * (S_M / S_W), v1 = acc[ai][bj][m][1] * (S_M / S_W);
                        w[mm][0] = pk4_fp8(v0[0], v0[1], v0[2], v0[3]); w[mm][1] = pk4_fp8(v1[0], v1[1], v1[2], v1[3]); }
                    *(pg8::u32x4*)(b0 + (size_t)(ai * 128 + mp * 32) * DM + bj * 128) = widen16(w[0][0], w[0][1], w[1][0], w[1][1]); }
    }
};
struct SwigluEpi {
    static constexpr bool PERM = true, AFTER_DRAIN = false, BADJ = false;
    unsigned char* Gb; const float* bgu;
    __device__ __forceinline__ void operator()(AccRef acc, const Unit& u, int wr, int wc, int fr, int fq) const {
        const int cc = u.pn * 128 + wc * 32 + 8 * fq; const float* bp = bgu + (size_t)u.kind * 2048 + cc;
        float cT = -1.702f * 1.4426950408889634f / S_W, cU = S_G / (S_W * S_W); asm volatile("" : "+v"(cT), "+v"(cU));
        const pg8::f32x4 bg0 = *(const pg8::f32x4*)bp * S_W, bg1 = *(const pg8::f32x4*)(bp + 4) * S_W, bu0 = (*(const pg8::f32x4*)(bp + 1024) + 1.0f) * (S_G / S_W), bu1 = (*(const pg8::f32x4*)(bp + 1028) + 1.0f) * (S_G / S_W);
        unsigned char* b0 = Gb + (size_t)(u.pm * 256 + wr * 64 + (fq & 1) * 16 + fr) * DFF + u.pn * 128 + wc * 32 + 16 * (fq >> 1);
#pragma unroll
        for (int ai = 0; ai < 2; ++ai)
#pragma unroll
            for (int mp = 0; mp < 2; ++mp) { unsigned w[2][2];
#pragma unroll
                for (int mm = 0; mm < 2; ++mm) { const int m = 2 * mp + mm; float o[8];
#pragma unroll
                    for (int n = 0; n < 2; ++n) {
                        const pg8::f32x4 g4 = acc[ai][0][m][n] + (n ? bg1 : bg0), u4 = acc[ai][1][m][n] * cU + (n ? bu1 : bu0);
                        pg8::f32x4 a4, l4, e4, r4;
#pragma unroll
                        for (int i = 0; i < 4; ++i) { a4[i] = fminf(g4[i], 7.0f * S_W); l4[i] = __builtin_amdgcn_fmed3f(u4[i], -6.0f * S_G / S_W, 8.0f * S_G / S_W); }
                        const pg8::f32x4 t4 = a4 * cT;
#pragma unroll
                        for (int i = 0; i < 4; ++i) e4[i] = __builtin_amdgcn_exp2f(t4[i]);
                        const pg8::f32x4 d4 = e4 + 1.0f;
#pragma unroll
                        for (int i = 0; i < 4; ++i) r4[i] = __builtin_amdgcn_rcpf(d4[i]);
                        const pg8::f32x4 o4 = (a4 * r4) * l4;
#pragma unroll
                        for (int i = 0; i < 4; ++i) o[n * 4 + i] = o4[i]; }
                    w[mm][0] = pk4_fp8(o[0], o[1], o[2], o[3]); w[mm][1] = pk4_fp8(o[4], o[5], o[6], o[7]); }
                *(pg8::u32x4*)(b0 + (size_t)(ai * 128 + mp * 32) * DFF) = widen16(w[0][0], w[0][1], w[1][0], w[1][1]);
 }
    }
};
struct DownEpi {
    static constexpr bool PERM = true, AFTER_DRAIN = false, BADJ = false;
    unsigned char* Y; const float* bdn;
    __device__ __forceinline__ void operator()(AccRef acc, const Unit& u, int wr, int wc, int fr, int fq) const {
        const int cc = u.pn * 256 + wc * 32 + 8 * fq; const float* bp = bdn + (size_t)u.kind * DM + cc;
        unsigned char* b0 = Y + (size_t)(u.pm * 256 + wr * 64 + (fq & 1) * 16 + fr) * DM + u.pn * 256 + wc * 32 + 16 * (fq >> 1);
#pragma unroll
        for (int bj = 0; bj < 2; ++bj) { const pg8::f32x4 bv0 = *(const pg8::f32x4*)(bp + bj * 128) * S_Y, bv1 = *(const pg8::f32x4*)(bp + bj * 128 + 4) * S_Y;
#pragma unroll
            for (int ai = 0; ai < 2; ++ai)
#pragma unroll
                for (int mp = 0; mp < 2; ++mp) { unsigned w[2][2];
#pragma unroll
                    for (int mm = 0; mm < 2; ++mm) { const int m = 2 * mp + mm;
                        const pg8::f32x4 v0 = acc[ai][bj][m][0] * (S_Y / (S_W * S_G)) + bv0, v1 = acc[ai][bj][m][1] * (S_Y / (S_W * S_G)) + bv1;
                        w[mm][0] = pk4_fp8(v0[0], v0[1], v0[2], v0[3]); w[mm][1] = pk4_fp8(v1[0], v1[1], v1[2], v1[3]); }
                    *(pg8::u32x4*)(b0 + (size_t)(ai * 128 + mp * 32) * DM + bj * 128) = widen16(w[0][0], w[0][1], w[1][0], w[1][1]); } }
    }
};

__device__ __forceinline__ void build_moe_tables(LAS unsigned char* lds, const int* BCNT, int nrb  , bool want_bb, int tid) {
    LAS int* tile_e = (LAS int*)(lds + TAB_OFF); LAS int* misc = tile_e + MAXT;
    LAS int* bb = (LAS int*)(lds + RING_OFF); LAS int* seg = bb + 256 * NE;
    __syncthreads();
    for (int idx = tid; idx < nrb * NE; idx += NWAVES * 64) bb[idx] = BCNT[idx];
    __syncthreads();
    const int s16 = tid >> 5, e = tid & 31, per = nrb >> 4;
    { int run = 0; for (int q = 0; q < per; ++q) { const int bidx = (s16 * per + q) * NE + e; const int cc = bb[bidx]; bb[bidx] = run; run += cc; } seg[s16 * NE + e] = run; }
    __syncthreads();
    if (tid < NE) { int run = 0; for (int q = 0; q < 16; ++q) { const int t = seg[q * NE + tid]; seg[q * NE + tid] = run; run += t; } misc[8 + tid] = run; }
    __syncthreads();
    if (want_bb) { const int add = seg[s16 * NE + e]; for (int q = 0; q < per; ++q) bb[(s16 * per + q) * NE + e] += add; }
    if (tid == 0) { int off = 0; for (int e = 0; e < NE; ++e) { misc[40 + e] = off; off += ((misc[8 + e] + 255) >> 8) * 256; } misc[0] = off >> 8; }
    __syncthreads();
    for (int t = tid; t < MAXT; t += NWAVES * 64) { int ee = 0;
#pragma unroll 8
        for (int q = 1; q < NE; ++q) ee += ((misc[40 + q] >> 8) <= t) ? 1 : 0;
        tile_e[t] = ee; }
    __syncthreads();
}
struct AttnUnit { long qrow, kvrow; int h, nt; };
__device__ __forceinline__ bool attn_next(int i, int G, int vcu, bool l0, AttnUnit& u) {
    const int U = i * G + vcu, NU = 1024 + (l0 ? 128 : 0);
    if (U >= NU) return false;
    if (U < 1024) { const int bk = U >> 5, b = bk >> 1, kvh = bk & 1, hq = (U & 31) >> 3, qb = U & 7; u.h = kvh * 4 + hq; u.qrow = (long)b * SEQ + qb * 256; u.kvrow = (long)b * NKV; u.nt = NKV / 64; }
    else { const int q = U - 1024, b = q >> 3; u.h = q & 7; u.qrow = (long)NLAT + b * 256; u.kvrow = (long)b * NKV + SEQ; u.nt = CTXL / 64; }
    return true;
}

__global__ void __launch_bounds__(NWAVES * 64, 2) mk_fwd(Params Pk) {
    extern __shared__ __attribute__((aligned(16))) unsigned char lds_raw[];
    LAS unsigned char* lds0 = (LAS unsigned char*)lds_raw;
    volatile LAS unsigned* MISC = (volatile LAS unsigned*)(lds0 + MISC_OFF);
    const int tid0 = threadIdx.x; const int wave0 = __builtin_amdgcn_readfirstlane(tid0 >> 6);
    const int G0 = gridDim.x; const int bx0 = blockIdx.x;
    for (int u = tid0; u < 64; u += NWAVES * 64) MISC[u] = 0u;
    __syncthreads();
    XcdBarrier bar; bar.bar = (unsigned*)(Pk.ws + WS_CTL) + CW_BAR + Pk.li * XCD_BAR_WORDS; bar.x = 0; bar.st = nullptr;
    if (!MK_PER_PHASE) bar = xcd_barrier_post((unsigned*)(Pk.ws + WS_CTL) + CW_BAR + Pk.li * XCD_BAR_WORDS, MISC + 8);
    const int lo = Pk.ph_lo, hi = Pk.ph_hi;
#define IN(k) (lo <= (k) && (k) < hi)
#ifndef PROBE_MASK
#define PROBE_MASK 0ull
#endif
#if PROBE_MASK
#define REP(k) for (int rp_ = 0; rp_ < ((((unsigned long long)(PROBE_MASK) >> (k)) & 1ull) ? 2 : 1); ++rp_)
#else
#define REP(k)
#endif
#define SEAM(k) do { if (IN(k) && IN((k) + 1)) { XcdBarrier b2_ = bar; asm volatile("" : "+s"(b2_.bar)); xcd_barrier(b2_); } } while (0)
#define PH_BEGIN \
    const __attribute__((address_space(4))) Params* Pp_ = (const __attribute__((address_space(4))) Params*)__builtin_amdgcn_kernarg_segment_ptr(); asm volatile("" : "+s"(Pp_)); const __attribute__((address_space(4))) Params& P = *Pp_; \
    int wave = wave0; unsigned zero_ = 0u; asm volatile("" : "+s"(wave), "+s"(zero_)); const int lane = (int)__builtin_amdgcn_mbcnt_hi(~0u, __builtin_amdgcn_mbcnt_lo(~0u, zero_)); const int tid = wave * 64 + lane; (void)tid; \
    int G = G0, bx = bx0; asm volatile("" : "+s"(G), "+s"(bx)); const int vcu = (G % 8 == 0) ? (bx % 8) * (G / 8) + bx / 8 : bx; const int gw = vcu * NWAVES + wave, NGW = G * NWAVES; (void)NGW; \
    LAS unsigned char* lds = lds0; asm volatile("" : "+s"(lds)); \
    unsigned char* ws = P.ws; (void)lane; (void)gw; (void)ws; \
    bf16* WIN = (bf16*)(ws + WS_WIN); bf16* WOUT = (bf16*)(ws + WS_WOUT); bf16* WR = (bf16*)(ws + WS_WR); unsigned char* WGU = ws + WS_WGU; unsigned char* WDN = ws + WS_WDN; \
    float* WF = (float*)(ws + WS_WF); bf16* DFT = (bf16*)(ws + WS_DFT); bf16* DFTC = (bf16*)(ws + WS_DFTC); float* MOD = (float*)(ws + WS_MOD); float* ROPE = (float*)(ws + WS_ROPE); \
    float* XCTX = (float*)(ws + WS_XCTX); bf16* H = (bf16*)(ws + WS_H); bf16* F = (bf16*)(ws + WS_F); bf16* PA = (bf16*)(ws + WS_PA); bf16* FT = (bf16*)(ws + WS_FT); bf16* FTC = (bf16*)(ws + WS_FTC); \
    bf16* QB = (bf16*)(ws + WS_Q); bf16* KB = (bf16*)(ws + WS_K); bf16* VB = (bf16*)(ws + WS_V); bf16* CONV = (bf16*)(ws + WS_CONV); bf16* OB = (bf16*)(ws + WS_O); bf16* YF = (bf16*)(ws + WS_YF); \
    bf16* MERGED = (bf16*)(ws + WS_MERGED); bf16* MIX = (bf16*)(ws + WS_MIX); float* LOG = (float*)(ws + WS_LOG); \
    int* EID = (int*)(ws + WS_EID); float* WTS = (float*)(ws + WS_WT); int* POS = (int*)(ws + WS_POS); int* SLOT = (int*)(ws + WS_SLOT); int* BCNT = (int*)(ws + WS_BCNT); \
    bf16* XB = (bf16*)(ws + WS_XB); (void)XB; bf16* FTU = (bf16*)(ws + WS_FTU); bf16* FTUC = (bf16*)(ws + WS_FTUC); (void)FTU; (void)FTUC; int* ROWTOK = (int*)(ws + WS_XS); unsigned char* F8 = (unsigned char*)(ws + WS_F); unsigned char* GB = ws + WS_G; unsigned char* YB = ws + WS_Y; \
    (void)WIN; (void)WOUT; (void)WR; (void)WGU; (void)WDN; (void)WF; (void)DFT; (void)DFTC; (void)MOD; (void)ROPE; (void)XCTX; (void)H; (void)F; (void)PA; (void)FT; (void)FTC; (void)QB; (void)KB; (void)VB; \
    (void)CONV; (void)OB; (void)YF; (void)MERGED; (void)MIX; (void)LOG; (void)EID; (void)WTS; (void)POS; (void)SLOT; (void)BCNT; (void)ROWTOK; (void)F8; (void)F; (void)GB; (void)YB;

    REP(0) if (IN(0)) { PH_BEGIN
        for (int item = bx; item < 2 * 96; item += G) {
            const int l = item / 96, cb = item % 96;
            LAS float* sl = (LAS float*)(lds + RING_OFF); LAS float* part = sl + 17 * 1024;
            __syncthreads();
            for (int idx = tid; idx < 17 * 1024; idx += NWAVES * 64) { const int r = idx >> 10, k = idx & 1023; const float v = r < 16 ? P.c[r * 1024 + k] : P.c_ctx[k]; sl[idx] = v / (1.0f + __expf(-v)); }
            __syncthreads();
            float acc[17];
#pragma unroll
            for (int r = 0; r < 17; ++r) acc[r] = 0.f;
            const float* wp = P.w_mod + ((size_t)l * 1024 + wave * 128) * 6144 + cb * 64 + lane;
#pragma unroll 4
            for (int k = 0; k < 128; ++k) { const float wv = wp[(size_t)k * 6144];
#pragma unroll
                for (int r = 0; r < 17; ++r) acc[r] += sl[r * 1024 + wave * 128 + k] * wv; }
#pragma unroll
            for (int r = 0; r < 17; ++r) part[(wave * 17 + r) * 64 + lane] = acc[r];
            __syncthreads();
            for (int idx = tid; idx < 17 * 64; idx += NWAVES * 64) { const int r = idx >> 6, ln = idx & 63; float s = P.b_mod[l * 6144 + cb * 64 + ln];
#pragma unroll
                for (int w = 0; w < 8; ++w) s += part[(w * 17 + r) * 64 + ln];
                MOD[((size_t)l * 17 + r) * 6144 + cb * 64 + ln] = s; }
            __syncthreads();
        }
        {
            LAS float* tab = (LAS float*)(lds + RING_OFF + 65536);
            __syncthreads();
            if (tid < 64) { tab[tid] = cos_rev((float)tid * (1.0f / 64.0f)); tab[64 + tid] = sin_rev((float)tid * (1.0f / 64.0f)); }
            __syncthreads();
            LAS float* scr = (LAS float*)(lds + RING_OFF) + wave * 256;
            for (int item = gw; item < 2 * 1024; item += NGW) {
                const float* src = P.w_in + (size_t)item * INW + 1536;
                *(LAS f32x4*)(scr + lane * 4) = *(const f32x4*)(src + lane * 4);
                LDS_WAIT(); asm volatile("" ::: "memory");
                const int k2u = lane <= 32 ? lane : lane - 32, tb = lane <= 32 ? 0 : 64;
#pragma unroll
                for (int g = 0; g < 4; ++g) { float s = 0.f;
#pragma unroll 8
                    for (int cidx = 0; cidx < 64; ++cidx) s += scr[g * 64 + cidx] * tab[tb + ((k2u * cidx) & 63)];
                    WF[(size_t)item * 256 + g * 64 + lane] = s; }
                LDS_WAIT(); asm volatile("" ::: "memory");
            }
            __syncthreads();
        }
        {
            LAS float* scr = (LAS float*)(lds + RING_OFF + wave * 16640);
            constexpr int I_IN = 16 * 24, I_OUT = 16 * 16, I_GU = 32 * 16 * 32, I_DN = 32 * 16 * 16, I_L = I_IN + I_OUT + I_GU + I_DN;
            for (int it = gw; it < 2 * I_L; it += NGW) {
                const int l = it / I_L; int r = it % I_L;
                if (r < I_IN) { const int kb = r / 24, nb = r % 24, n0 = nb * 64; unsigned char* WIN8 = (unsigned char*)(WIN + (size_t)WINR * 1024);
                    if (n0 < 1024) { if (l == 0) tr_item(P.w_in, INW, kb * 64, n0, WIN, 1024, n0, scr, lane); else tr_item8(P.w_in + (size_t)1024 * INW, INW, kb * 64, n0, WIN8, 1024, n0, S_W, scr, lane); }
                    else {
                        const bool isc_ = n0 < 1280; const int x0 = n0 - (isc_ ? 1024 : 1280), tl = 4 + (x0 >> 7), w0 = (x0 & 127) >> 5, add = isc_ ? 0 : 32;
                        if (l == 0) tr_item2(P.w_in, INW, kb * 64, n0, WIN, 1024, tl * 256 + w0 * 64 + add, tl * 256 + (w0 + 1) * 64 + add, scr, lane);
                        else tr_item2_8(P.w_in + (size_t)1024 * INW, INW, kb * 64, n0, WIN8, 1024, tl * 256 + w0 * 64 + add, tl * 256 + (w0 + 1) * 64 + add, S_W, scr, lane); }
                    continue; } r -= I_IN;
                if (r < I_OUT) { const int kb = r / 16, nb = r % 16;
                    if (l == 0) tr_item(P.w_out, 1024, kb * 64, nb * 64, WOUT, 1024, nb * 64, scr, lane);
                    else tr_item8(P.w_out + (size_t)1024 * 1024, 1024, kb * 64, nb * 64, (unsigned char*)(WOUT + (size_t)1024 * 1024), 1024, nb * 64, S_W, scr, lane);
                    continue; } r -= I_OUT;
                if (r < I_GU) { const int e = r / 512, q = r % 512, kb = q / 32, nb = q % 32, n0 = nb * 64;
                    const int drow = (n0 < 1024) ? (n0 >> 7) * 256 + (n0 & 127) : ((n0 - 1024) >> 7) * 256 + 128 + ((n0 - 1024) & 127);
                    tr_item8(P.w_gu + ((size_t)l * 32 + e) * 1024 * 2048, 2048, kb * 64, n0, WGU + ((size_t)l * 32 + e) * 2048 * 1024, 1024, drow, S_W, scr, lane); continue; } r -= I_GU;
                { const int e = r / 256, q = r % 256, kb = q / 16, nb = q % 16; tr_item8(P.w_dn + ((size_t)l * 32 + e) * 1024 * 1024, 1024, kb * 64, nb * 64, WDN + ((size_t)l * 32 + e) * 1024 * 1024, 1024, nb * 64, S_W, scr, lane); }
            }
        }
        for (int idx = bx * (NWAVES * 64) + tid; idx < 2 * 256 * 1024; idx += G * NWAVES * 64) {
            const int l = idx >> 18, rr = (idx >> 10) & 255, k = idx & 1023; unsigned short o = 0;
            if (rr < 64) { const float w = P.w_router[((size_t)l * 1024 + k) * 32 + (rr & 31)]; const unsigned h = pk2(w, 0.f) & 0xffffu; o = (unsigned short)h;
                if (rr >= 32) { const float lo_ = w - bflo(h); o = (unsigned short)(pk2(lo_, 0.f) & 0xffffu); } }
            WR[idx] = o;
        }
        {
            LAS float* ct = (LAS float*)(lds + RING_OFF); LAS float* st = ct + 2048;
            __syncthreads();
            for (int j = tid; j < 2048; j += NWAVES * 64) { ct[j] = cos_rev((float)j * (1.0f / 2048.0f)); st[j] = sin_rev((float)j * (1.0f / 2048.0f)); }
            __syncthreads();
            for (int q = bx * (NWAVES * 64) + tid; q < 1025 * 512; q += G * NWAVES * 64) { const int k1 = q >> 9, n8 = (q & 511) * 8; float v[8];
#pragma unroll
                for (int i = 0; i < 8; ++i) { const int n = n8 + i; v[i] = (n < 2048) ? ct[(k1 * n) & 2047] : -st[(k1 * (n - 2048)) & 2047]; }
                v4u o; o.x = pk2(v[0], v[1]); o.y = pk2(v[2], v[3]); o.z = pk2(v[4], v[5]); o.w = pk2(v[6], v[7]); *(v4u*)(DFT + (size_t)q * 8) = o; }
            for (int q = bx * (NWAVES * 64) + tid; q < 256 * 64; q += G * NWAVES * 64) { const int k1 = q >> 6, n8 = (q & 63) * 8; float v[8];
#pragma unroll
                for (int i = 0; i < 8; ++i) { const int n = n8 + i; v[i] = (n < 256) ? ct[((k1 * n) & 255) * 8] : -st[((k1 * (n - 256)) & 255) * 8]; }
                v4u o; o.x = pk2(v[0], v[1]); o.y = pk2(v[2], v[3]); o.z = pk2(v[4], v[5]); o.w = pk2(v[6], v[7]); *(v4u*)(DFTC + (size_t)q * 8) = o; }
            for (int q = bx * (NWAVES * 64) + tid; q < 64 * 16; q += G * NWAVES * 64) { const int pos = q >> 4, f = q & 15;
                const float inv = __builtin_amdgcn_exp2f(-(float)f * (13.287712379549449f / 16.0f)); const float rev = (float)pos * inv * 0.15915494309189535f;
                ROPE[q] = cos_rev(rev); ROPE[1024 + q] = sin_rev(rev); }
            __syncthreads();
        }
    }
    SEAM(0);
    REP(1) if (IN(1)) { PH_BEGIN
        LAS float* scr = (LAS float*)(lds + RING_OFF + wave * 16640);
        for (int it = gw; it < 2 * 64; it += NGW) { const int l = it >> 6, r = it & 63, kb = r >> 2, nb = r & 3;
            if (l == 0) tr_item(WF, 256, kb * 64, nb * 64, WIN, 1024, 1536 + nb * 64, scr, lane);
            else tr_item8(WF + (size_t)1024 * 256, 256, kb * 64, nb * 64, (unsigned char*)(WIN + (size_t)WINR * 1024), 1024, 1536 + nb * 64, S_W, scr, lane); }
        for (int row = gw; row < NTOK; row += NGW) { RowF xr; const int mr = row < NLAT ? (row >> 11) : 16;
            ld_row_f32(xr, row < NLAT ? P.x + (size_t)row * DM : P.ctx + (size_t)(row - NLAT) * DM, lane);
            const float* md = MOD + (size_t)mr * 6144;
            modulate_store(xr, P.g_pre_mix, md + 0 * DM, md + 1 * DM, H + (size_t)row * DM, lane); }
    }
    SEAM(1);

    for (int layer = 0; layer < 2; ++layer) {
        const int pb = 2 + 13 * layer;
        const bool l0 = (layer == 0);
        const int NR = l0 ? NTOK : NLAT;
        REP(pb + 0) if (IN(pb + 0)) { PH_BEGIN
            InprojSched S; S.init(G, bx, layer, H, WIN + (size_t)layer * WINR * 1024);
            LAS float* tab = (LAS float*)(lds + TAB_OFF);
            for (int i = tid; i < 2048; i += NWAVES * 64) tab[i] = ROPE[i];
            if (tid < 64) tab[2048 + tid] = P.g_q[layer * 64 + tid]; else if (tid < 128) tab[2048 + tid] = P.g_k[layer * 64 + tid - 64];
            LDS_WAIT(); __syncthreads();
            InprojEpi E{PA, FTU, FTUC, QB, KB, VB, tab, l0 ? 1.0f : 1.0f / S_W};
            if (l0) pg8::gemm_phase<InprojEpi, InprojSched, true, true>(lds + RING_OFF, 1024, S, E, wave);
            else pg8::gemm_phase<InprojEpi, InprojSched, true, true, true>(lds + RING_OFF, 512, S, E, wave);
        }
        SEAM(pb + 0);
        REP(pb + 2) if (IN(pb + 2)) { PH_BEGIN
            AttnUnit u;
            for (int i = 0; attn_next(i, G, vcu, l0, u); ++i)
                attn_body::attn_unit<8>(u.qrow, u.kvrow, u.h, u.nt, (const attn_body::bf16*)QB, (const attn_body::bf16*)KB, (const attn_body::bf16*)VB, (attn_body::bf16*)OB, (char*)lds_raw + RING_OFF, wave);
        }
        REP(pb + 3) if (IN(pb + 3)) { PH_BEGIN
            { FourierSchedT<false> S{G, bx, 256, (const char*)DFT, (const char*)FTU, (size_t)256 * 2048 * 2}; FourierEpi E{YF};
              pg8::gemm_phase<FourierEpi, FourierSchedT<false>, true, true>(lds + RING_OFF, 1024, S, E, wave, 4096); }
            {
                float* Y0 = (float*)(ws + WS_ROPE + 65536);
                for (int r = gw; r < NB * 256; r += NGW) { const bf16* src = FTU + (size_t)r * 2048; float s = 0.f;
#pragma unroll
                    for (int q = 0; q < 4; ++q) { const v4u w = *(const v4u*)(src + q * 512 + lane * 8); s += (bflo(w.x) + bfhi(w.x)) + (bflo(w.y) + bfhi(w.y)) + (bflo(w.z) + bfhi(w.z)) + (bflo(w.w) + bfhi(w.w)); }
                    s = wave_sum(s, lane); if (lane == 0) Y0[r] = s; } }
            if (l0) { __syncthreads();
              const int cctx = ((bx & 7) >= 4) ? (bx >> 3) * 4 + ((bx & 7) - 4) : G;
              FourierSchedT<true> S{G, cctx, 16, (const char*)DFTC, (const char*)FTC, (size_t)256 * 512 * 2}; FourierEpi E{YF};
              {
                  pg8::Unit u0;
                  for (int i0 = 0; S.next(i0, u0); ++i0) { const int b = u0.pn;
                      for (int it = wave; it < 512; it += NWAVES) { const int part = it & 1, ch = it >> 1, g = ch >> 6, k2 = ch & 63;
                          int u; unsigned flip = 0u; bool zero = false;
                          if (part == 0) u = g * 64 + (k2 <= 32 ? k2 : 64 - k2);
                          else { zero = (k2 == 0) | (k2 == 32); u = g * 64 + 32 + (k2 < 32 ? k2 : 64 - k2); if (k2 > 32) flip = 0x80008000u; if (zero) u = g * 64; }
                          if (lane < 32) { v4u w = *(const v4u*)(FTUC + ((size_t)b * 256 + u) * 256 + lane * 8); { const unsigned keep = zero ? 0u : ~0u; w.x = (w.x ^ flip) & keep; w.y = (w.y ^ flip) & keep; w.z = (w.z ^ flip) & keep; w.w = (w.w ^ flip) & keep; }
                              *(v4u*)(FTC + ((size_t)b * 256 + ch) * 512 + part * 256 + lane * 8) = w; } } }
                  VM_WAIT(); __syncthreads(); }
              pg8::gemm_phase<FourierEpi, FourierSchedT<true>, true, true>(lds + RING_OFF, 512, S, E, wave); }
        }
        SEAM(pb + 3);
        REP(pb + 4) if (IN(pb + 4)) { PH_BEGIN
            const float* gb = P.g_branch + layer * 1024; const float* cw = P.conv_w + layer * 3 * 256;
            struct MR { v4u wa; v2u wb, u0, u1, u2, y0, y1, y2, y3; };
            auto mrow = [](int row, int& t, int& len) { if (row < NLAT) { t = row & 2047; len = SEQ; } else { t = (row - NLAT) & 255; len = CTXL; } };
            auto issue = [=](int row, MR& r) { int t, len; mrow(row, t, len); const int ch = lane * 4;
                r.wa = *(const v4u*)(OB + (size_t)row * 512 + lane * 8);
                const bf16* pa = PA + (size_t)row * PAW; const bf16* pm = (t > 0) ? pa - PAW : pa; const bf16* pp = (t < len - 1) ? pa + PAW : pa;
                r.wb = *(const v2u*)(pa + 768 + ch); r.u1 = *(const v2u*)(pa + 1024 + ch); r.u0 = *(const v2u*)(pm + 1024 + ch); r.u2 = *(const v2u*)(pp + 1024 + ch);
                if (row >= NLAT) { r.y0 = *(const v2u*)(YF + YF_CTX + (size_t)(row - NLAT) * 256 + ch); r.y1 = r.y0; r.y2 = r.y0; r.y3 = r.y0; }
                else { const int bb_ = row >> 11, k1 = row & 2047; const int rr = (k1 == 0) ? 0 : (k1 <= 1024 ? k1 : 2048 - k1) - 1;
                    const bf16* p0 = YF + ((size_t)bb_ * 1024 + rr) * 256 + ch; const size_t pl = (size_t)NB * 1024 * 256;
                    r.y0 = *(const v2u*)p0; r.y1 = *(const v2u*)(p0 + pl); r.y2 = *(const v2u*)(p0 + 2 * pl); r.y3 = *(const v2u*)(p0 + 3 * pl); } };
            int row0 = gw;
            if (row0 < NR) {
                MR A; issue(row0, A);
                for (;;) {
                    const int row1 = row0 + NGW; const bool hB = row1 < NR; MR B = A; if (hB) issue(row1, B);
                    {   const int row = row0; int t, len; mrow(row, t, len); const int ch = lane * 4;
                        const v4u wa = A.wa;
                        float cv[4];
                        { const v2u wb = A.wb, w0 = A.u0, w1 = A.u1, w2 = A.u2;
                          const float m0 = (t > 0) ? 1.f : 0.f, m2 = (t < len - 1) ? 1.f : 0.f;
                          const f32x4 k0 = *(const f32x4*)(cw + ch) * m0, k1c = *(const f32x4*)(cw + 256 + ch), k2c = *(const f32x4*)(cw + 512 + ch) * m2;
                          const float gb2[4] = {bflo(wb.x), bfhi(wb.x), bflo(wb.y), bfhi(wb.y)};
                          const float u0[4] = {bflo(w0.x), bfhi(w0.x), bflo(w0.y), bfhi(w0.y)}, u1[4] = {bflo(w1.x), bfhi(w1.x), bflo(w1.y), bfhi(w1.y)}, u2[4] = {bflo(w2.x), bfhi(w2.x), bflo(w2.y), bfhi(w2.y)};
#pragma unroll
                          for (int i = 0; i < 4; ++i) cv[i] = gb2[i] * (u0[i] * k0[i] + u1[i] * k1c[i] + u2[i] * k2c[i]); }
                        f32x4 fy;
                        if (row >= NLAT) { const v2u w = A.y0; fy = (f32x4){bflo(w.x), bfhi(w.x), bflo(w.y), bfhi(w.y)}; }
                        else { const int bb_ = row >> 11, k1 = row & 2047;
                            if (k1 == 0) { const float* y0 = (const float*)(ws + WS_ROPE + 65536) + bb_ * 256 + (lane >> 4) * 64; const int k2a = (lane & 15) * 4;
#pragma unroll
                                for (int i = 0; i < 4; ++i) { const int kk = k2a + i; fy[i] = y0[kk <= 32 ? kk : 64 - kk]; } }
                            else { const float sg = k1 <= 1024 ? 1.f : -1.f; const v2u w0 = A.y0, w1 = A.y1, w2 = A.y2, w3 = A.y3;
                                const int k2a = (lane & 15) * 4; f32x4 ss;
#pragma unroll
                                for (int i = 0; i < 4; ++i) { const int kk = k2a + i; ss[i] = ((kk & 31) == 0) ? 0.f : (kk > 32 ? -sg : sg); }
                                fy = ((f32x4){bflo(w0.x), bfhi(w0.x), bflo(w0.y), bfhi(w0.y)} + (f32x4){bflo(w1.x), bfhi(w1.x), bflo(w1.y), bfhi(w1.y)}) + ((f32x4){bflo(w2.x), bfhi(w2.x), bflo(w2.y), bfhi(w2.y)} + (f32x4){bflo(w3.x), bfhi(w3.x), bflo(w3.y), bfhi(w3.y)}) * ss; } }
                        float a[8] = {bflo(wa.x), bfhi(wa.x), bflo(wa.y), bfhi(wa.y), bflo(wa.z), bfhi(wa.z), bflo(wa.w), bfhi(wa.w)};
                        float fv[4] = {fy[0], fy[1], fy[2], fy[3]};
                        float sa = 0.f, sc = 0.f, sf = 0.f;
#pragma unroll
                        for (int i = 0; i < 8; ++i) sa += a[i] * a[i];
#pragma unroll
                        for (int i = 0; i < 4; ++i) { sc += cv[i] * cv[i]; sf += fv[i] * fv[i]; }
                        sa = wave_sum(sa, lane); sc = wave_sum(sc, lane); sf = wave_sum(sf, lane);
                        const float ra = rsq(sa * (1.0f / 512.0f) + EPS), rc = rsq(sc * (1.0f / 256.0f) + EPS), rf = rsq(sf * (1.0f / 256.0f) + EPS);
                        const f32x4 g0 = *(const f32x4*)(gb + lane * 8), g1 = *(const f32x4*)(gb + lane * 8 + 4), g2 = *(const f32x4*)(gb + 512 + lane * 4), g3 = *(const f32x4*)(gb + 768 + lane * 4);
                        if (l0) { bf16* mr = MERGED + (size_t)row * DM;
                        v4u oa; oa.x = pk2(a[0] * ra * g0[0], a[1] * ra * g0[1]); oa.y = pk2(a[2] * ra * g0[2], a[3] * ra * g0[3]); oa.z = pk2(a[4] * ra * g1[0], a[5] * ra * g1[1]); oa.w = pk2(a[6] * ra * g1[2], a[7] * ra * g1[3]);
                        *(v4u*)(mr + lane * 8) = oa;
                        v2u oc; oc.x = pk2(cv[0] * rc * g2[0], cv[1] * rc * g2[1]); oc.y = pk2(cv[2] * rc * g2[2], cv[3] * rc * g2[3]); *(v2u*)(mr + 512 + lane * 4) = oc;
                        v2u of; of.x = pk2(fv[0] * rf * g3[0], fv[1] * rf * g3[1]); of.y = pk2(fv[2] * rf * g3[2], fv[3] * rf * g3[3]); *(v2u*)(mr + 768 + lane * 4) = of; }
                        else { unsigned char* mr = (unsigned char*)MERGED + (size_t)row * DM;
                        v2u oa; oa.x = pk4_fp8(a[0] * ra * g0[0], a[1] * ra * g0[1], a[2] * ra * g0[2], a[3] * ra * g0[3]); oa.y = pk4_fp8(a[4] * ra * g1[0], a[5] * ra * g1[1], a[6] * ra * g1[2], a[7] * ra * g1[3]);
                        *(v2u*)(mr + lane * 8) = oa;
                        *(unsigned*)(mr + 512 + lane * 4) = pk4_fp8(cv[0] * rc * g2[0], cv[1] * rc * g2[1], cv[2] * rc * g2[2], cv[3] * rc * g2[3]);
                        *(unsigned*)(mr + 768 + lane * 4) = pk4_fp8(fv[0] * rf * g3[0], fv[1] * rf * g3[1], fv[2] * rf * g3[2], fv[3] * rf * g3[3]); }
                    }
                    if (!hB) break;
                    row0 = row1; A = B;
                }
            }
        }
        SEAM(pb + 4);
        REP(pb + 5) if (IN(pb + 5)) { PH_BEGIN
            if (l0) { CtxKSched S{G, bx, 256, (const char*)(MERGED + (size_t)NLAT * DM), (const char*)(WOUT + (size_t)layer * 1024 * 1024)}; CtxKEpi E{FT};
                pg8::gemm_phase<CtxKEpi, CtxKSched, true, true>(lds + RING_OFF, 256, S, E, wave, 1024); }
            if (l0) { PlainSched S{G, bx, 4, (NLAT / 256) * 4, (const char*)MERGED, (const char*)WOUT}; OutEpi E{MIX};
                pg8::gemm_phase<OutEpi, PlainSched, true, true>(lds + RING_OFF, 1024, S, E, wave); }
            else { PlainSched8 S{G, bx, 4, (NLAT / 256) * 4, (const char*)MERGED, (const char*)(WOUT + (size_t)1024 * 1024)}; OutEpi8 E{(unsigned char*)MIX};
                pg8::gemm_phase<OutEpi8, PlainSched8, true, true, true>(lds + RING_OFF, 512, S, E, wave); }
        }
        SEAM(pb + 5);
        REP(pb + 6) if (IN(pb + 6)) { PH_BEGIN
            typedef short bf16x8v __attribute__((ext_vector_type(8)));
            constexpr int FP = 2064;
            LAS unsigned char* Ft = lds + RING_OFF; LAS float* part = (LAS float*)(lds + RING_OFF + 36864);
            const bf16* wr = WR + (size_t)layer * 256 * 1024;
            bf16x8v Bf[4][4];
#pragma unroll
            for (int s = 0; s < 4; ++s)
#pragma unroll
                for (int nt = 0; nt < 4; ++nt) Bf[s][nt] = *(const bf16x8v*)(wr + (size_t)(16 * nt + (lane & 15)) * 1024 + 128 * wave + 32 * s + 8 * (lane >> 4));
            const float* gpm = P.g_post_mix + layer * DM; const float* gpf = P.g_pre_ffn + layer * DM;
            LAS float* LOGS = (LAS float*)(lds + RING_OFF + 73728);
            int kc = 0;
            for (int ci = bx; ci < NR / 16; ci += G, ++kc) {
#pragma unroll
                for (int rr = 0; rr < 2; ++rr) {
                    const int rl = 2 * wave + rr, row = 16 * ci + rl;
                    const bool isc = row >= NLAT; const float* md = MOD + (size_t)layer * 17 * 6144 + (size_t)(isc ? 16 : (row >> 11)) * 6144;
                    RowF mx, xr, gp, gt;
                    if (l0 && isc) { const bf16* mc = FT + (size_t)(row - NLAT) * DM; RowF t1, t2, t3; ld_row_bf16(mx, mc, lane); ld_row_bf16(t1, mc + (size_t)NCTX * DM, lane); ld_row_bf16(t2, mc + (size_t)2 * NCTX * DM, lane); ld_row_bf16(t3, mc + (size_t)3 * NCTX * DM, lane);
#pragma unroll
                        for (int jj = 0; jj < 4; ++jj) mx.v[jj] = (mx.v[jj] + t1.v[jj]) + (t2.v[jj] + t3.v[jj]); }
                    else if (l0) ld_row_bf16(mx, MIX + (size_t)row * DM, lane);
                    else { const unsigned* qm = (const unsigned*)((const unsigned char*)MIX + (size_t)row * DM) + lane;
#pragma unroll
                        for (int jj = 0; jj < 4; ++jj) { const unsigned w = qm[64 * jj]; const auto lo = __builtin_amdgcn_cvt_pk_f32_fp8((int)w, false), hi = __builtin_amdgcn_cvt_pk_f32_fp8((int)w, true);
                            mx.v[jj] = (f32x4){lo[0], lo[1], hi[0], hi[1]} * (1.0f / S_M); } }
                    if (l0) ld_row_f32(xr, isc ? P.ctx + (size_t)(row - NLAT) * DM : P.x + (size_t)row * DM, lane); else ld_row_bf16(xr, XB + (size_t)row * DM, lane);
                    ld_row_f32(gp, gpm, lane); ld_row_f32(gt, md + 2 * DM, lane);
                    const float rstd = rsq(row_ss(mx, lane) * (1.0f / DM) + EPS);
#pragma unroll
                    for (int jj = 0; jj < 4; ++jj) xr.v[jj] = xr.v[jj] + gt.v[jj] * (mx.v[jj] * rstd * gp.v[jj]);
                    st_row_bf16(XB + (size_t)row * DM, lane, xr);
                    const float rstd2 = rsq(row_ss(xr, lane) * (1.0f / DM) + EPS);
                    RowF gg, s1, s2; ld_row_f32(gg, gpf, lane); ld_row_f32(s1, md + 4 * DM, lane); ld_row_f32(s2, md + 3 * DM, lane);
                    unsigned* qf = (unsigned*)(F8 + (size_t)row * DM) + lane;
#pragma unroll
                    for (int jj = 0; jj < 4; ++jj) { const f32x4 o = xr.v[jj] * rstd2 * gg.v[jj] * (s1.v[jj] + 1.0f) + s2.v[jj];
                        v2u w; w.x = pk2(o[0], o[1]); w.y = pk2(o[2], o[3]); qf[64 * jj] = pk4_fp8(o[0], o[1], o[2], o[3]); *(LAS v2u*)(Ft + rl * FP + 8 * lane + 512 * jj) = w; }
                }
                LDS_WAIT(); __syncthreads();
                f32x4 acc[4];
#pragma unroll
                for (int nt = 0; nt < 4; ++nt) acc[nt] = (f32x4){0.f, 0.f, 0.f, 0.f};
#pragma unroll
                for (int s = 0; s < 4; ++s) { const bf16x8v a = *(const LAS bf16x8v*)(Ft + (lane & 15) * FP + (128 * wave + 32 * s + 8 * (lane >> 4)) * 2);
#pragma unroll
                    for (int nt = 0; nt < 4; ++nt) acc[nt] = __builtin_amdgcn_mfma_f32_16x16x32_bf16(a, Bf[s][nt], acc[nt], 0, 0, 0); }
#pragma unroll
                for (int nt = 0; nt < 4; ++nt)
#pragma unroll
                    for (int r = 0; r < 4; ++r) part[(wave * 16 + 4 * (lane >> 4) + r) * 64 + 16 * nt + (lane & 15)] = acc[nt][r];
                LDS_WAIT(); __syncthreads();
                { const int rowl = tid >> 5, e = tid & 31; float s = 0.f, s2 = 0.f;
#pragma unroll
                    for (int w = 0; w < 8; ++w) { s += part[(w * 16 + rowl) * 64 + e]; s2 += part[(w * 16 + rowl) * 64 + 32 + e]; }
                    LOGS[(kc * 16 + rowl) * 36 + e] = s + s2; }
                __syncthreads();
            }
        }
        REP(pb + 8) if (IN(pb + 8)) { PH_BEGIN
            __syncthreads();
            LAS int* wcnt = (LAS int*)(lds + RING_OFF);
            const float* br = P.b_router + layer * 32;
            {   const int nchunk = NR / 16, nck = (bx < nchunk) ? (nchunk - bx + G - 1) / G : 0;
                const bool valid = (tid >> 4) < nck; const int row = valid ? 16 * (bx + (tid >> 4) * G) + (tid & 15) : 0; const LAS float* Lr = (const LAS float*)(lds + RING_OFF + 73728) + (size_t)tid * 36;
                float lg[32];
#pragma unroll
                for (int q = 0; q < 8; ++q) { const f32x4 a = *(const LAS f32x4*)(Lr + 4 * q), bb = *(const f32x4*)(br + 4 * q);
#pragma unroll
                    for (int i = 0; i < 4; ++i) lg[4 * q + i] = a[i] + bb[i]; }
                int eb = 0; asm volatile("" : "+s"(eb));
                int ev[4]; float tv[4]; unsigned used = 0u;
#pragma unroll
                for (int k = 0; k < 4; ++k) { float best = -INFINITY; int bi = 0;
#pragma unroll
                    for (int e = 0; e < 32; ++e) { const bool free_ = !((used >> (e + eb)) & 1u); if (free_ && (lg[e] > best || (e == 0 && k == 0))) { best = lg[e]; bi = e + eb; } }
                    ev[k] = valid ? bi : -1; tv[k] = best; used |= 1u << bi; }
                float pw[4]; float sum = 0.f;
#pragma unroll
                for (int k = 0; k < 4; ++k) { pw[k] = __expf(tv[k] - tv[0]); sum += pw[k]; }
                const float rs = 1.0f / sum;
                int pos[4] = {0, 0, 0, 0};
                const unsigned long long ltm = (lane == 0) ? 0ull : (~0ull >> (64 - lane));
                __syncthreads();
#pragma clang loop unroll(disable)
                for (int e0_ = 0; e0_ < 32; ++e0_) { const int e = e0_ + eb; const bool sel = (ev[0] == e) | (ev[1] == e) | (ev[2] == e) | (ev[3] == e); const unsigned long long M = __builtin_amdgcn_ballot_w64(sel);
                    const int rk = __popcll(M & ltm);
#pragma unroll
                    for (int k = 0; k < 4; ++k) pos[k] = (ev[k] == e) ? rk : pos[k];
                    if (lane == 0) wcnt[wave * 32 + e] = __popcll(M); }
                __syncthreads();
#pragma unroll
                for (int k = 0; k < 4; ++k) { int add = 0; const int ek = valid ? ev[k] : 0; for (int w = 0; w < wave; ++w) add += wcnt[w * 32 + ek]; pos[k] += add; }
                if (tid < 32) { int s = 0;
#pragma unroll
                    for (int w = 0; w < 8; ++w) s += wcnt[w * 32 + tid];
                    BCNT[bx * 32 + tid] = s; }
                if (valid) { *(int4*)(EID + (size_t)row * 4) = make_int4(ev[0], ev[1], ev[2], ev[3]);
                    *(float4*)(WTS + (size_t)row * 4) = make_float4(pw[0] * rs, pw[1] * rs, pw[2] * rs, pw[3] * rs);
                    *(int4*)(POS + (size_t)row * 4) = make_int4(pos[0], pos[1], pos[2], pos[3]); }
                __syncthreads();
            }
        }
        SEAM(pb + 8);
        REP(pb + 9) if (IN(pb + 9)) { PH_BEGIN const LAS int* tile_e = (const LAS int*)(lds + TAB_OFF); const LAS int* tmisc = tile_e + MAXT;
            build_moe_tables(lds, BCNT, G, true, tid);
            const LAS int* bb = (const LAS int*)(lds + RING_OFF);
            for (int r16 = gw; r16 < NR / 16; r16 += NGW) {
                const int row = r16 * 16 + (lane >> 2); const size_t ix = (size_t)r16 * 64 + lane;
                const int e = EID[ix], pos = POS[ix];
                const int slot = tmisc[40 + e] + bb[(r16 % G) * 32 + e] + pos;
                SLOT[ix] = slot; ROWTOK[slot] = row;
            }
            for (int q = gw * 64 + lane; q < NE * 256; q += NGW * 64) { const int e = q >> 8, i = q & 255, tot = tmisc[8 + e], npad = ((tot + 255) & ~255) - tot;
                if (i < npad) ROWTOK[tmisc[40 + e] + tot + i] = 0; }
            __syncthreads();
        }
        SEAM(pb + 9);
        REP(pb + 10) if (IN(pb + 10)) { PH_BEGIN const LAS int* tile_e = (const LAS int*)(lds + TAB_OFF); const LAS int* tmisc = tile_e + MAXT;
            if (MK_PER_PHASE) build_moe_tables(lds, BCNT, G, false, tid);
            MoeSchedT<true> S{G, bx, 8, tmisc[0] * 8, tile_e, (const char*)F8, (const char*)(WGU + (size_t)layer * 32 * 2048 * 1024), (size_t)2048 * 1024, ROWTOK};
            SwigluEpi E{GB, P.b_gu + (size_t)layer * 32 * 2048};
            pg8::gemm_phase<SwigluEpi, MoeSchedT<true>, true, true, true>(lds + RING_OFF, 512, S, E, wave);
        }
        SEAM(pb + 10);
        REP(pb + 11) if (IN(pb + 11)) { PH_BEGIN const LAS int* tile_e = (const LAS int*)(lds + TAB_OFF); const LAS int* tmisc = tile_e + MAXT;
            if (MK_PER_PHASE) build_moe_tables(lds, BCNT, G, false, tid);
            MoeSchedT<false> S{G, bx, 4, tmisc[0] * 4, tile_e, (const char*)GB, (const char*)(WDN + (size_t)layer * 32 * 1024 * 1024), (size_t)1024 * 1024, ROWTOK};
            DownEpi E{YB, P.b_dn + (size_t)layer * 32 * 1024};
            pg8::gemm_phase<DownEpi, MoeSchedT<false>, true, true, true>(lds + RING_OFF, 512, S, E, wave);
        }
        SEAM(pb + 11);
        REP(pb + 12) if (IN(pb + 12)) { PH_BEGIN
            struct CRaw { unsigned y[4][4]; v2u x[4]; };
            auto issue = [=](int row, int sx, int sy, int sz, int sw, CRaw& r) {
                const unsigned* q0 = (const unsigned*)(YB + (size_t)sx * DM) + lane; const unsigned* q1 = (const unsigned*)(YB + (size_t)sy * DM) + lane;
                const unsigned* q2 = (const unsigned*)(YB + (size_t)sz * DM) + lane; const unsigned* q3 = (const unsigned*)(YB + (size_t)sw * DM) + lane; const v2u* qx = (const v2u*)(XB + (size_t)row * DM) + lane;
#pragma unroll
                for (int jj = 0; jj < 4; ++jj) { r.y[0][jj] = q0[64 * jj]; r.y[1][jj] = q1[64 * jj]; r.y[2][jj] = q2[64 * jj]; r.y[3][jj] = q3[64 * jj]; r.x[jj] = qx[64 * jj]; } };
            int row0 = gw;
            if (row0 < NR) {
                int4 slA = *(const int4*)(SLOT + (size_t)row0 * 4); float4 wtA = *(const float4*)(WTS + (size_t)row0 * 4);
                int row1 = row0 + NGW; int4 slB = slA; float4 wtB = wtA;
                if (row1 < NR) { slB = *(const int4*)(SLOT + (size_t)row1 * 4); wtB = *(const float4*)(WTS + (size_t)row1 * 4); }
                CRaw A; issue(row0, slA.x, slA.y, slA.z, slA.w, A);
                for (;;) {
                    const bool hB = row1 < NR; CRaw B = A; if (hB) issue(row1, slB.x, slB.y, slB.z, slB.w, B);
                    const int row2 = row1 + NGW; int4 slC = slB; float4 wtC = wtB;
                    if (row2 < NR) { slC = *(const int4*)(SLOT + (size_t)row2 * 4); wtC = *(const float4*)(WTS + (size_t)row2 * 4); }
                    {
                        const int row = row0; const bool isc = row >= NLAT; const float* md = MOD + (size_t)layer * 17 * 6144 + (size_t)(isc ? 16 : (row >> 11)) * 6144;
                        RowF y, xr;
#pragma unroll
                        for (int jj = 0; jj < 4; ++jj) { y.v[jj] = (f32x4){0.f, 0.f, 0.f, 0.f};
#pragma unroll
                            for (int kk = 0; kk < 4; ++kk) { const unsigned w = A.y[kk][jj]; const float wk = (kk == 0 ? wtA.x : kk == 1 ? wtA.y : kk == 2 ? wtA.z : wtA.w) * (1.0f / S_Y); const auto lo = __builtin_amdgcn_cvt_pk_f32_fp8((int)w, false), hi = __builtin_amdgcn_cvt_pk_f32_fp8((int)w, true); y.v[jj] += (f32x4){lo[0], lo[1], hi[0], hi[1]} * wk; }
                            const v2u wx = A.x[jj]; xr.v[jj] = (f32x4){bflo(wx.x), bfhi(wx.x), bflo(wx.y), bfhi(wx.y)}; }
                        const float rstd = rsq(row_ss(y, lane) * (1.0f / DM) + EPS);
                        RowF gp, gt; ld_row_f32(gp, P.g_post_ffn + layer * DM, lane); ld_row_f32(gt, md + 5 * DM, lane);
#pragma unroll
                        for (int jj = 0; jj < 4; ++jj) xr.v[jj] = xr.v[jj] + gt.v[jj] * (y.v[jj] * rstd * gp.v[jj]);
                        if (l0) st_row_bf16(XB + (size_t)row * DM, lane, xr); else st_row_f32(P.out + (size_t)row * DM, lane, xr);
                        if (l0) { const float* md1 = MOD + (size_t)(17 + (isc ? 16 : (row >> 11))) * 6144;
                            modulate_store8(xr, P.g_pre_mix + DM, md1 + 0 * DM, md1 + 1 * DM, (unsigned char*)H + (size_t)row * DM, lane); }
                    }
                    if (!hB) break;
                    row0 = row1; A = B; wtA = wtB; row1 = row2; slB = slC; wtB = wtC;
                }
            }
        }
        SEAM(pb + 12);
    }
#undef IN
#undef SEAM
}

extern "C" void kernel_launch(void* const* d_in, const int* in_sizes, int n_in, void* d_out, int out_size, void* d_ws, size_t ws_size, hipStream_t stream) {
    static int grid = 0;
    if (grid == 0) {
        if (n_in != 22 || out_size != NLAT * DM || ws_size < WS_END) { fprintf(stderr, "kernel_launch: unexpected shapes (n_in %d, out %d, ws %zu < %zu)\n", n_in, out_size, ws_size, (size_t)WS_END); grid = -1; return; }
        int dev = 0, cus = 0, per_cu = 0;
        if (hipGetDevice(&dev) != hipSuccess || hipDeviceGetAttribute(&cus, hipDeviceAttributeMultiprocessorCount, dev) != hipSuccess) { grid = -1; return; }
        if (hipFuncSetAttribute((const void*)mk_fwd, hipFuncAttributeMaxDynamicSharedMemorySize, LDS_BYTES) != hipSuccess) { fprintf(stderr, "kernel_launch: hipFuncSetAttribute failed\n"); grid = -1; return; }
        if (hipOccupancyMaxActiveBlocksPerMultiprocessor(&per_cu, (const void*)mk_fwd, NWAVES * 64, LDS_BYTES) != hipSuccess || per_cu < 1)
            fprintf(stderr, "kernel_launch: note: occupancy query reports %d workgroups per CU\n", per_cu);
        (void)hipGetLastError();
        grid = cus >= 256 ? 256 : (cus / 16) * 16;
        if (grid < 128) { fprintf(stderr, "kernel_launch: this kernel wants at least 128 CUs (found %d)\n", cus); grid = -1; return; }
    }
    if (grid < 0) return;
    if (hipMemsetAsync((char*)d_ws + WS_CTL, 0, CTL_ZERO_BYTES, stream) != hipSuccess) return;
    Params p{};
    const float** pp = (const float**)&p;
    for (int i = 0; i < 22; ++i) pp[i] = (const float*)d_in[i];
    p.out = (float*)d_out; p.ws = (unsigned char*)d_ws;
#if MK_PER_PHASE
    for (int ph = 0; ph < NPHASE; ++ph) { p.ph_lo = ph; p.ph_hi = ph + 1; p.li = 0; hipLaunchKernelGGL(mk_fwd, dim3(grid), dim3(NWAVES * 64), LDS_BYTES, stream, p); }
#else
    p.ph_lo = 0; p.ph_hi = NPHASE; p.li = 0;
    hipLaunchKernelGGL(mk_fwd, dim3(grid), dim3(NWAVES * 64), LDS_BYTES, stream, p);
#endif
}
```

```cpp
#include <hip/hip_runtime.h>
#include <hip/hip_bf16.h>
#include <cstdio>
#include <cstdint>
#include <cmath>
namespace pg8 {
#define PG8_LAS __attribute__((address_space(3)))
typedef unsigned short bf16_t;
typedef short bf16x8 __attribute__((ext_vector_type(8)));
typedef float f32x4 __attribute__((ext_vector_type(4)));
typedef unsigned u32x4 __attribute__((ext_vector_type(4)));
typedef int i32x4 __attribute__((ext_vector_type(4)));
constexpr int BM = 256, BK = 64, HALF = 128, HTB = HALF * BK * 2  , STAGE_BYTES = 8 * HTB, NXCD = 8;

__host__ __device__ __forceinline__ int lds_byte(int r, int c) { const int st = (r >> 4) * 2 + (c >> 5), rr = r & 15, cc = c & 31, ob = rr * 64 + cc * 2; return st * 1024 + (ob ^ (((ob >> 9) & 1) << 5)); }
__host__ __device__ __forceinline__ void stage_rc(int b, int& R, int& C) { const int st = b / 1024, sb = b % 1024, swz = sb ^ (((sb >> 9) & 1) << 5); R = (st >> 1) * 16 + swz / 64; C = (st & 1) * 32 + (swz % 64) / 2; }
__host__ __device__ __forceinline__ int perm32(int rho) { const int n = rho >> 4, i = rho & 15; return 8 * (i >> 2) + 4 * n + (i & 3); }

struct Unit { int pm, pn, kind, half; };
__device__ __forceinline__ bool list_index(int i, int G, int c, int nwg, int& w) {
    const long L = (long)i * G + c; if (L >= nwg) return false;
    const int q = nwg / NXCD, r = nwg % NXCD, xcd = (int)(L % NXCD), off = (int)(L / NXCD);
    w = (xcd < r ? xcd * (q + 1) : r * (q + 1) + (xcd - r) * q) + off; return true;
}
__device__ __forceinline__ unsigned cvt_pk_bf16(float lo, float hi) { unsigned r; asm volatile("v_cvt_pk_bf16_f32 %0, %1, %2" : "=v"(r) : "v"(lo), "v"(hi)); return r; }
__device__ __forceinline__ void store_tile_bf16(const f32x4 (&acc)[2][2][4][2], bf16_t* base, size_t ldc, int wr, int wc, int fr, int fq) {
    bf16_t* b0 = base + (size_t)(wr * 64 + fr) * ldc + wc * 32 + 8 * fq;
#pragma unroll
    for (int ai = 0; ai < 2; ++ai)
#pragma unroll
        for (int m = 0; m < 4; ++m) { bf16_t* rowp = b0 + (size_t)(ai * HALF + m * 16) * ldc;
#pragma unroll
            for (int bj = 0; bj < 2; ++bj) { const f32x4 v0 = acc[ai][bj][m][0], v1 = acc[ai][bj][m][1];
                u32x4 w; w.x = cvt_pk_bf16(v0[0], v0[1]); w.y = cvt_pk_bf16(v0[2], v0[3]); w.z = cvt_pk_bf16(v1[0], v1[1]); w.w = cvt_pk_bf16(v1[2], v1[3]);
                *(u32x4*)(rowp + bj * HALF) = w; } }
}
__device__ __forceinline__ void store_tile_bf16_adj_sc(const f32x4 (&acc)[2][2][4][2], bf16_t* base, size_t ldc, int wr, int wc, int fr, int fq, float sc) {
    bf16_t* b0 = base + (size_t)(wr * 64 + fr) * ldc + wc * 64 + 8 * fq;
#pragma unroll
    for (int ai = 0; ai < 2; ++ai)
#pragma unroll
        for (int m = 0; m < 4; ++m) { bf16_t* rowp = b0 + (size_t)(ai * HALF + m * 16) * ldc;
#pragma unroll
            for (int bj = 0; bj < 2; ++bj) { const f32x4 v0 = acc[ai][bj][m][0] * sc, v1 = acc[ai][bj][m][1] * sc;
                u32x4 w; w.x = cvt_pk_bf16(v0[0], v0[1]); w.y = cvt_pk_bf16(v0[2], v0[3]); w.z = cvt_pk_bf16(v1[0], v1[1]); w.w = cvt_pk_bf16(v1[2], v1[3]);
                *(u32x4*)(rowp + bj * 32) = w; } }
}
__device__ __forceinline__ void store_tile_bf16_sc(const f32x4 (&acc)[2][2][4][2], bf16_t* base, size_t ldc, int wr, int wc, int fr, int fq, float sc) {
    bf16_t* b0 = base + (size_t)(wr * 64 + fr) * ldc + wc * 32 + 8 * fq;
#pragma unroll
    for (int ai = 0; ai < 2; ++ai)
#pragma unroll
        for (int m = 0; m < 4; ++m) { bf16_t* rowp = b0 + (size_t)(ai * HALF + m * 16) * ldc;
#pragma unroll
            for (int bj = 0; bj < 2; ++bj) { const f32x4 v0 = acc[ai][bj][m][0] * sc, v1 = acc[ai][bj][m][1] * sc;
                u32x4 w; w.x = cvt_pk_bf16(v0[0], v0[1]); w.y = cvt_pk_bf16(v0[2], v0[3]); w.z = cvt_pk_bf16(v1[0], v1[1]); w.w = cvt_pk_bf16(v1[2], v1[3]);
                *(u32x4*)(rowp + bj * HALF) = w; } }
}
__device__ __forceinline__ void store_tile_bf16_adj(const f32x4 (&acc)[2][2][4][2], bf16_t* base, size_t ldc, int wr, int wc, int fr, int fq) {
    bf16_t* b0 = base + (size_t)(wr * 64 + fr) * ldc + wc * 64 + 8 * fq;
#pragma unroll
    for (int ai = 0; ai < 2; ++ai)
#pragma unroll
        for (int m = 0; m < 4; ++m) { bf16_t* rowp = b0 + (size_t)(ai * HALF + m * 16) * ldc;
#pragma unroll
            for (int bj = 0; bj < 2; ++bj) { const f32x4 v0 = acc[ai][bj][m][0], v1 = acc[ai][bj][m][1];
                u32x4 w; w.x = cvt_pk_bf16(v0[0], v0[1]); w.y = cvt_pk_bf16(v0[2], v0[3]); w.z = cvt_pk_bf16(v1[0], v1[1]); w.w = cvt_pk_bf16(v1[2], v1[3]);
                *(u32x4*)(rowp + bj * 32) = w; } }
}
template <class Epi, class Sched, bool ALIGN_EPI = false, bool SP2 = false, bool F8 = false>
__device__ __forceinline__ void gemm_phase(PG8_LAS unsigned char* lds, const int K_in, const Sched& S, const Epi& E, const int wid_in  , const int pitch_in = 0  ) {
    unsigned zero_ = 0u; asm volatile("" : "+s"(zero_)); const int lane_ = (int)__builtin_amdgcn_mbcnt_hi(~0u, __builtin_amdgcn_mbcnt_lo(~0u, zero_));
    const int wid = wid_in, lane = lane_, tid = wid * 64 + lane, wr = wid >> 2, wc = wid & 3, fr = lane & 15, fq = lane >> 4;
    int K = K_in; asm volatile("" : "+s"(K));
    const int nt = K / BK;
    int LD = pitch_in ? pitch_in : K_in; asm volatile("" : "+s"(LD));
    unsigned voffA[2], voffB[2];
#pragma unroll
    for (int i = 0; i < 2; ++i) { int R, C; stage_rc(tid * 16 + i * 8192, R, C); const int Rb = Epi::BADJ ? ((R >> 5) * 64 + perm32(R & 31)) : Epi::PERM ? ((R & ~31) + perm32(R & 31)) : R;
        voffA[i] = (unsigned)(R * LD + C) * 2u; voffB[i] = (unsigned)(Rb * LD + C) * 2u; }
    const size_t kstep = (size_t)(BK * 2);
    const size_t hstep = (size_t)HALF * LD * 2;
    constexpr bool GA = Sched::GATHER; constexpr unsigned TOK_OFF = 131072u;
    const size_t hstepA = GA ? (size_t)0 : hstep;
    unsigned vA[2][2];
#pragma unroll
    for (int h = 0; h < 2; ++h)
#pragma unroll
        for (int i = 0; i < 2; ++i) vA[h][i] = voffA[i];
    constexpr bool BG = Sched::BGATHER;
    static_assert(!(BG && Epi::BADJ), "computed B rows use the plain half split");
    const size_t hstepB0 = Epi::BADJ ? (size_t)32 * LD * 2 : hstep;
    const size_t hstepBv = BG ? (size_t)0 : hstepB0;
    unsigned vB[2][2];
#pragma unroll
    for (int h = 0; h < 2; ++h)
#pragma unroll
        for (int i = 0; i < 2; ++i) vB[h][i] = voffB[i];
#define PG8_BOFF(dst, unit, h_) do { unsigned zb_ = 0u; asm volatile("" : "+s"(zb_)); const int tb2_ = wid * 64 + (int)__builtin_amdgcn_mbcnt_hi(~0u, __builtin_amdgcn_mbcnt_lo(~0u, zb_)); \
        _Pragma("unroll") for (int i_ = 0; i_ < 2; ++i_) { int R_, C_; stage_rc(tb2_ * 16 + i_ * 8192, R_, C_); const int Rb_ = Epi::PERM ? ((R_ & ~31) + perm32(R_ & 31)) : R_; \
            dst[i_] = S.boff(unit, (h_) * 128 + Rb_) + (unsigned)C_ * 2u; } } while (0)
#define PG8_STAGE_BN(bufoff, gbase, h_) do { if constexpr (BG) { if (last) { unsigned tw_[2]; if (has_next) PG8_BOFF(tw_, nxt, h_); else PG8_BOFF(tw_, cur, h_); PG8_STAGE(bufoff, gbase, tw_); } else PG8_STAGE(bufoff, gbase, vB[h_]); } \
        else PG8_STAGE(bufoff, (gbase) + (h_) * hstepB0, voffB); } while (0)
#define PG8_TOKDMA(unit, bufi) do { if (wid < 4) { unsigned zt_ = 0u; asm volatile("" : "+s"(zt_)); const unsigned lt_ = __builtin_amdgcn_mbcnt_hi(~0u, __builtin_amdgcn_mbcnt_lo(~0u, zt_)) * 4u; \
        const char* tb_ = (const char*)S.tokptr(unit) + wid * 256; \
        asm volatile("s_mov_b32 m0, %2\n\ts_nop 0\n\tglobal_load_lds_dword %0, %1" :: "v"(lt_), "s"(tb_), "s"(ldsu + TOK_OFF + (unsigned)(bufi) * 1024u + (unsigned)wid * 256u) : "memory", "m0"); } } while (0)
    constexpr bool HV = Sched::HALVES;
#define PG8_TOKREADH(dst, bufi, h_) PG8_TOKREADHX(dst, bufi, h_, 0)
#define PG8_TOKREADHX(dst, bufi, h_, hf_) do { unsigned zr_ = 0u; asm volatile("" : "+s"(zr_)); const int tr_ = wid * 64 + (int)__builtin_amdgcn_mbcnt_hi(~0u, __builtin_amdgcn_mbcnt_lo(~0u, zr_)); \
        const PG8_LAS int* tk_ = (const PG8_LAS int*)(lds + TOK_OFF + (bufi) * 1024); \
        _Pragma("unroll") for (int i_ = 0; i_ < 2; ++i_) { int R_, C_; stage_rc(tr_ * 16 + i_ * 8192, R_, C_); dst[i_] = (unsigned)tk_[((hf_) ? (hf_) - 1 : (h_)) * 128 + R_] * (unsigned)(LD * 2) + (unsigned)C_ * 2u; } } while (0)
#define PG8_TOKREAD(dst, bufi, hf_) do { PG8_TOKREADHX(dst[0], bufi, 0, hf_); PG8_TOKREADHX(dst[1], bufi, 1, hf_); } while (0)
#define PG8_STAGE_AN(bufoff, gbase, h_) do { if constexpr (GA) { if (last) { unsigned tv_[2]; PG8_TOKREADHX(tv_, has_next ? ((ui + 1) & 1) : (ui & 1), h_, hfN); PG8_STAGE(bufoff, gbase, tv_); } else PG8_STAGE(bufoff, gbase, vA[h_]); } \
        else PG8_STAGE(bufoff, (gbase) + (h_) * (last ? hsN : hsC), voffA); } while (0)
    const unsigned ldsu = (unsigned)(uintptr_t)lds;
    const unsigned ldsw = (unsigned)wid * 1024u;
    const int aoff = lds_byte(wr * 64 + fr, fq * 8), boff = lds_byte(wc * 32 + fr, fq * 8);
#define PG8_SA(b, h) (((b) * 2 + (h)) * HTB)
#define PG8_SB(b, h) ((4 + (b) * 2 + (h)) * HTB)
#define PG8_STAGE(bufoff, gbase, voff) do { const char* gb_ = (const char*)(gbase);     \
        _Pragma("unroll") for (int _i = 0; _i < 2; ++_i) \
        asm volatile("s_mov_b32 m0, %2\n\ts_nop 0\n\tglobal_load_lds_dwordx4 %0, %1" :: "v"((voff)[_i]), "s"(gb_), "s"(ldsu + (unsigned)((bufoff) + _i * 8192) + ldsw) : "memory", "m0"); } while (0)
#define PG8_LDA(dst, b, h) do { _Pragma("unroll") for (int m = 0; m < 4; ++m) _Pragma("unroll") for (int k = 0; k < 2; ++k) dst[m][k] = *(const PG8_LAS bf16x8*)(lds + PG8_SA(b, h) + aoff + m * 2048 + k * 1024); } while (0)
#define PG8_LDB(dst, b, h) do { _Pragma("unroll") for (int n = 0; n < 2; ++n) _Pragma("unroll") for (int k = 0; k < 2; ++k) dst[n][k] = *(const PG8_LAS bf16x8*)(lds + PG8_SB(b, h) + boff + n * 2048 + k * 1024); } while (0)
#define PG8_CAT8(X) __builtin_shufflevector(__builtin_bit_cast(i32x4, X[0]), __builtin_bit_cast(i32x4, X[1]), 0, 1, 2, 3, 4, 5, 6, 7)
#define PG8_MMA(ai, bj, At, Bt) do { __builtin_amdgcn_s_setprio(1); _Pragma("unroll") for (int m = 0; m < 4; ++m) _Pragma("unroll") for (int n = 0; n < 2; ++n) { \
        if constexpr (F8) acc[ai][bj][m][n] = __builtin_amdgcn_mfma_scale_f32_16x16x128_f8f6f4(PG8_CAT8(Bt[n]), PG8_CAT8(At[m]), acc[ai][bj][m][n], 0, 0, 0, 0, 0, 0); \
        else { _Pragma("unroll") for (int k = 0; k < 2; ++k) acc[ai][bj][m][n] = __builtin_amdgcn_mfma_f32_16x16x32_bf16(Bt[n][k], At[m][k], acc[ai][bj][m][n], 0, 0, 0); } } __builtin_amdgcn_s_setprio(0); } while (0)
#define PG8_MMA0(ai, bj, At, Bt) do { __builtin_amdgcn_s_setprio(1); _Pragma("unroll") for (int m = 0; m < 4; ++m) _Pragma("unroll") for (int n = 0; n < 2; ++n) { const f32x4 z4_ = (f32x4){0.f, 0.f, 0.f, 0.f}; \
        if constexpr (F8) acc[ai][bj][m][n] = __builtin_amdgcn_mfma_scale_f32_16x16x128_f8f6f4(PG8_CAT8(Bt[n]), PG8_CAT8(At[m]), z4_, 0, 0, 0, 0, 0, 0); \
        else { acc[ai][bj][m][n] = __builtin_amdgcn_mfma_f32_16x16x32_bf16(Bt[n][0], At[m][0], z4_, 0, 0, 0); acc[ai][bj][m][n] = __builtin_amdgcn_mfma_f32_16x16x32_bf16(Bt[n][1], At[m][1], acc[ai][bj][m][n], 0, 0, 0); } } __builtin_amdgcn_s_setprio(0); } while (0)
#define PG8_WAIT_V(n) asm volatile("s_waitcnt vmcnt(" #n ")" ::: "memory")
#define PG8_WAIT_L(n) asm volatile("s_waitcnt lgkmcnt(" #n ")" ::: "memory")
#define PG8_BAR __builtin_amdgcn_s_barrier()
#define PG8_SCHED __builtin_amdgcn_sched_barrier(0)
    Unit cur, nxt; int ui = 0;
    if (!S.next(0, cur)) return;
    static_assert(SP2, "the accumulators are only started from C = 0 in the two-super-phase loop");
    f32x4 acc[2][2][4][2];
    bf16x8 At[4][2], B0[2][2], B1[2][2];
    const char* cA = S.aptr(cur); const char* cB = S.bptr(cur);
    if constexpr (BG) { PG8_BOFF(vB[0], cur, 0); PG8_BOFF(vB[1], cur, 1); }
    if constexpr (GA) { PG8_TOKDMA(cur, 0); asm volatile("s_waitcnt vmcnt(0)" ::: "memory"); __builtin_amdgcn_s_barrier(); PG8_TOKREAD(vA, 0, HV ? cur.half : 0); }
    size_t hsC = (HV && cur.half) ? (size_t)0 : hstepA;
    if constexpr (SP2) {
        PG8_STAGE(PG8_SB(0, 0), cB, vB[0]); PG8_STAGE(PG8_SB(0, 1), cB + hstepBv, vB[1]); PG8_STAGE(PG8_SA(0, 0), cA, vA[0]); PG8_STAGE(PG8_SA(0, 1), cA + hsC, vA[1]);
        if (wr == 1) PG8_BAR;
        PG8_WAIT_V(2); PG8_BAR;
        PG8_STAGE(PG8_SB(1, 0), cB + kstep, vB[0]); PG8_STAGE(PG8_SA(1, 0), cA + kstep, vA[0]); PG8_STAGE(PG8_SB(1, 1), cB + hstepBv + kstep, vB[1]);
        PG8_WAIT_V(6); PG8_BAR;
    } else {
        PG8_STAGE(PG8_SB(0, 0), cB, voffB); PG8_STAGE(PG8_SA(0, 0), cA, voffA); PG8_STAGE(PG8_SB(0, 1), cB + hstep, voffB); PG8_STAGE(PG8_SA(0, 1), cA + hstep, voffA);
        if (wr == 1) PG8_BAR;
        PG8_WAIT_V(4); PG8_BAR;
        PG8_STAGE(PG8_SB(1, 0), cB + kstep, voffB); PG8_STAGE(PG8_SA(1, 0), cA + kstep, voffA); PG8_STAGE(PG8_SB(1, 1), cB + hstep + kstep, voffB);
        PG8_WAIT_V(6); PG8_BAR;
    }
    for (;;) {
        const bool has_next = S.next(ui + 1, nxt);
        const char* nA = has_next ? S.aptr(nxt) : cA; const char* nB = has_next ? S.bptr(nxt) : cB;
        if constexpr (GA) { if (has_next) PG8_TOKDMA(nxt, (ui + 1) & 1); }
        const int hfC = HV ? cur.half : 0, hfN = HV ? (has_next ? nxt.half : cur.half) : 0; (void)hfC; (void)hfN;
        const size_t hsN = hfN ? (size_t)0 : hstepA; (void)hsN;
#pragma clang loop unroll(disable)
        for (int t = 0; t < nt; t += 2) {
            const bool last = (t == nt - 2);
            const char* a1 = cA + (size_t)(t + 1) * kstep;
            const char* a2 = last ? nA : cA + (size_t)(t + 2) * kstep; const char* b2 = last ? nB : cB + (size_t)(t + 2) * kstep;
            const char* a3 = a2 + kstep; const char* b3 = b2 + kstep;
            if constexpr (SP2) {
            PG8_LDB(B0, 0, 0); PG8_LDB(B1, 0, 1); PG8_SCHED; PG8_LDA(At, 0, 0); PG8_STAGE(PG8_SA(1, 1), a1 + hsC, vA[1]);
            PG8_WAIT_V(8); PG8_WAIT_L(0); PG8_BAR; if (t == 0) { PG8_MMA0(0, 0, At, B0); PG8_MMA0(0, 1, At, B1); } else { PG8_MMA(0, 0, At, B0); PG8_MMA(0, 1, At, B1); } PG8_BAR; PG8_SCHED;
            PG8_LDA(At, 0, 1); PG8_STAGE_BN(PG8_SB(0, 0), b2, 0); PG8_STAGE_BN(PG8_SB(0, 1), b2, 1); PG8_STAGE_AN(PG8_SA(0, 0), a2, 0);
            PG8_WAIT_V(8); PG8_WAIT_L(0); PG8_BAR; if (!hfC) { if (t == 0) { PG8_MMA0(1, 0, At, B0); PG8_MMA0(1, 1, At, B1); } else { PG8_MMA(1, 0, At, B0); PG8_MMA(1, 1, At, B1); } } PG8_BAR; PG8_SCHED;
            PG8_LDB(B0, 1, 0); PG8_LDB(B1, 1, 1); PG8_SCHED; PG8_LDA(At, 1, 0); PG8_STAGE_AN(PG8_SA(0, 1), a2, 1);
            PG8_WAIT_V(8); PG8_WAIT_L(0); PG8_BAR; PG8_MMA(0, 0, At, B0); PG8_MMA(0, 1, At, B1); PG8_BAR; PG8_SCHED;
            PG8_LDA(At, 1, 1); PG8_STAGE_BN(PG8_SB(1, 0), b3, 0); PG8_STAGE_BN(PG8_SB(1, 1), b3, 1); PG8_STAGE_AN(PG8_SA(1, 0), a3, 0);
            PG8_WAIT_V(8); PG8_WAIT_L(0); PG8_BAR; if (!hfC) { PG8_MMA(1, 0, At, B0); PG8_MMA(1, 1, At, B1); } PG8_BAR; PG8_SCHED;
            } else {
            PG8_LDB(B0, 0, 0); PG8_SCHED; PG8_LDA(At, 0, 0); PG8_STAGE(PG8_SA(1, 1), a1 + hstep, voffA);
            PG8_WAIT_L(8); PG8_BAR; PG8_WAIT_L(0); PG8_MMA(0, 0, At, B0); PG8_BAR; PG8_SCHED;
            PG8_LDB(B1, 0, 1); PG8_STAGE(PG8_SB(0, 0), b2, voffB);
            PG8_BAR; PG8_WAIT_L(0); PG8_MMA(0, 1, At, B1); PG8_BAR;
            PG8_LDA(At, 0, 1); PG8_STAGE(PG8_SA(0, 0), a2, voffA);
            PG8_BAR; PG8_WAIT_L(0); PG8_MMA(1, 0, At, B0); PG8_BAR; PG8_SCHED;
            PG8_STAGE(PG8_SB(0, 1), b2 + hstep, voffB);
            PG8_WAIT_V(6); PG8_BAR; PG8_MMA(1, 1, At, B1); PG8_BAR;
            PG8_LDB(B0, 1, 0); PG8_SCHED; PG8_LDA(At, 1, 0); PG8_STAGE(PG8_SA(0, 1), a2 + hstep, voffA);
            PG8_WAIT_L(8); PG8_BAR; PG8_WAIT_L(0); PG8_MMA(0, 0, At, B0); PG8_BAR; PG8_SCHED;
            PG8_LDB(B1, 1, 1); PG8_STAGE(PG8_SB(1, 0), b3, voffB);
            PG8_BAR; PG8_WAIT_L(0); PG8_MMA(0, 1, At, B1); PG8_BAR;
            PG8_LDA(At, 1, 1); PG8_STAGE(PG8_SA(1, 0), a3, voffA);
            PG8_BAR; PG8_WAIT_L(0); PG8_MMA(1, 0, At, B0); PG8_BAR; PG8_SCHED;
            PG8_STAGE(PG8_SB(1, 1), b3 + hstep, voffB);
            PG8_WAIT_V(6); PG8_BAR; PG8_MMA(1, 1, At, B1); PG8_BAR;
            }
        }
        if constexpr (ALIGN_EPI) { if (wr == 0) PG8_BAR; }
        if constexpr (!Epi::AFTER_DRAIN) { unsigned z2_ = 0u; asm volatile("" : "+s"(z2_)); const int l2_ = (int)__builtin_amdgcn_mbcnt_hi(~0u, __builtin_amdgcn_mbcnt_lo(~0u, z2_)); const int fr_ = l2_ & 15, fq_ = l2_ >> 4;     E(acc, cur, wr, wc, fr_, fq_); }
        if (!has_next) break;
        cur = nxt; cA = nA; cB = nB; ++ui;
        if constexpr (GA) PG8_TOKREAD(vA, ui & 1, HV ? cur.half : 0);
        hsC = (HV && cur.half) ? (size_t)0 : hstepA;
        if constexpr (BG) { PG8_BOFF(vB[0], cur, 0); PG8_BOFF(vB[1], cur, 1); }
        if constexpr (ALIGN_EPI) { if (wr == 1) PG8_BAR; }
    }
    PG8_WAIT_V(0);
    if constexpr (!ALIGN_EPI) { if (wr == 0) PG8_BAR; }
    PG8_BAR;
    if constexpr (Epi::AFTER_DRAIN) { E.fused(acc, cur, wr, wc, fr, fq, lds, wid, lane); }
#undef PG8_SA
#undef PG8_SB
#undef PG8_STAGE
#undef PG8_TOKDMA
#undef PG8_TOKREAD
#undef PG8_BOFF
#undef PG8_STAGE_BN
#undef PG8_TOKREADH
#undef PG8_TOKREADHX
#undef PG8_STAGE_AN
#undef PG8_LDA
#undef PG8_LDB
#undef PG8_MMA
#undef PG8_MMA0
#undef PG8_CAT8
#undef PG8_WAIT_V
#undef PG8_WAIT_L
#undef PG8_BAR
#undef PG8_SCHED
}
}

#include <hip/hip_bf16.h>
#include <cmath>
namespace attn_body {
using bf16=__hip_bfloat16;
using bf16x8=__attribute__((ext_vector_type(8)))short;
using s16x4=__attribute__((ext_vector_type(4)))short;
using f32x16=__attribute__((ext_vector_type(16)))float;
using u32x4=__attribute__((ext_vector_type(4)))unsigned;
constexpr int D=64,QP=512,KP=128;
constexpr int NW=8,QBLK=32,QB=QBLK*NW,KVBLK=64;
__device__ __forceinline__ int crow(int r,int hi){return (r&3)+8*(r>>2)+4*hi;}
#define SBAR() __builtin_amdgcn_sched_barrier(0)
__device__ __forceinline__ void cmask(f32x16&p0,f32x16&p1,int jb,int qrel,int hi){
  const float NEG=-INFINITY; int kb=64*jb+4*hi;
  #pragma unroll
  for(int r=0;r<16;++r){int kv=kb+(r&3)+8*(r>>2); if(kv>qrel)p0[r]=NEG; if(kv+32>qrel)p1[r]=NEG;}
}

constexpr int NSLOT=3, SLOTB=8192;
constexpr int LDS_K=0, LDS_V=NSLOT*SLOTB, LDS_WS=2*NSLOT*SLOTB, LDS_OST=LDS_WS+NW*64*4, LDS_BYTES=LDS_OST+NW*4096;
constexpr float C2=0.125f*1.4426950408889634f;
__device__ __forceinline__ void glds16(const void*gsrc,unsigned lds_dst){unsigned keep;
  asm volatile("s_mov_b32 %0, m0\n\ts_mov_b32 m0, %2\n\ts_nop 0\n\tglobal_load_lds_dwordx4 %1, off\n\ts_mov_b32 m0, %0":"=&s"(keep):"v"(gsrc),"s"(lds_dst):"memory");}
__device__ __forceinline__ float max3f(float a,float b,float c){float r;asm("v_max3_f32 %0, %1, %2, %3":"=v"(r):"v"(a),"v"(b),"v"(c));return r;}
__device__ __forceinline__ float max2f(float a,float b){float r;asm("v_max_f32_e32 %0, %1, %2":"=v"(r):"v"(a),"v"(b));return r;}
__device__ __forceinline__ float fadd_s(float a,float b){float r;asm("v_add_f32_e32 %0, %1, %2":"=v"(r):"v"(a),"v"(b));return r;}
__device__ __forceinline__ float fsub_s(float a,float b){float r;asm("v_sub_f32_e32 %0, %1, %2":"=v"(r):"v"(a),"v"(b));return r;}
typedef float f32x2_t __attribute__((ext_vector_type(2))); typedef __bf16 bf16x2_t __attribute__((ext_vector_type(2)));
__device__ __forceinline__ unsigned cvtpk_s(float lo,float hi){f32x2_t v={lo,hi};bf16x2_t b=__builtin_convertvector(v,bf16x2_t);return __builtin_bit_cast(unsigned,b);}
#define WAIT_BAR(N) asm volatile("s_waitcnt vmcnt(" #N ") lgkmcnt(0)\n\ts_barrier":::"memory")

__device__ __forceinline__ void qkt(f32x16&p0,f32x16&p1,const char*Kslot,const bf16x8*qr,const f32x16&negm,int r32,int hi){
  const char*kb=Kslot+hi*1024+r32*16;
  #pragma unroll
  for(int d0=0;d0<4;++d0){
    const bf16x8 b0=*reinterpret_cast<const bf16x8*>(kb+d0*2048);
    const bf16x8 b1=*reinterpret_cast<const bf16x8*>(kb+d0*2048+512);
    if(d0==0){p0=__builtin_amdgcn_mfma_f32_32x32x16_bf16(b0,qr[0],negm,0,0,0);p1=__builtin_amdgcn_mfma_f32_32x32x16_bf16(b1,qr[0],negm,0,0,0);}
    else{p0=__builtin_amdgcn_mfma_f32_32x32x16_bf16(b0,qr[d0],p0,0,0,0);p1=__builtin_amdgcn_mfma_f32_32x32x16_bf16(b1,qr[d0],p1,0,0,0);}}
}
typedef __attribute__((address_space(3))) const char* lds_cptr;
typedef short v4i16_t __attribute__((ext_vector_type(4)));
__device__ __forceinline__ void kload8(bf16x8*kf,lds_cptr kp){
  kf[0]=*(const __attribute__((address_space(3))) bf16x8*)(kp);      kf[1]=*(const __attribute__((address_space(3))) bf16x8*)(kp+512);
  kf[2]=*(const __attribute__((address_space(3))) bf16x8*)(kp+2048); kf[3]=*(const __attribute__((address_space(3))) bf16x8*)(kp+2560);
  kf[4]=*(const __attribute__((address_space(3))) bf16x8*)(kp+4096); kf[5]=*(const __attribute__((address_space(3))) bf16x8*)(kp+4608);
  kf[6]=*(const __attribute__((address_space(3))) bf16x8*)(kp+6144); kf[7]=*(const __attribute__((address_space(3))) bf16x8*)(kp+6656);
}
__device__ __forceinline__ void kload2(bf16x8*kf,lds_cptr kp,int j){ kf[2*j]=*(const __attribute__((address_space(3))) bf16x8*)(kp+j*2048); kf[2*j+1]=*(const __attribute__((address_space(3))) bf16x8*)(kp+j*2048+512); }
__device__ __forceinline__ s16x4 vtr(lds_cptr p){ return __builtin_bit_cast(s16x4,__builtin_amdgcn_ds_read_tr16_b64_v4i16((__attribute__((address_space(3))) v4i16_t*)p)); }
__device__ __forceinline__ float rowmax(const f32x16&p0,const f32x16&p1){
  float a=max3f(p0[0],p0[1],p1[0]),b=max3f(p0[2],p0[3],p1[1]);a=max3f(a,p1[2],p1[3]);
  #pragma unroll
  for(int r=4;r<16;r+=4){a=max3f(a,p0[r],p0[r+1]);b=max3f(b,p0[r+2],p0[r+3]);a=max3f(a,p1[r],p1[r+1]);b=max3f(b,p1[r+2],p1[r+3]);}
  const float m=max2f(a,b);
  auto rr=__builtin_amdgcn_permlane32_swap(__float_as_uint(m),__float_as_uint(m),false,false);
  return max2f(__uint_as_float(rr[0]),__uint_as_float(rr[1]));
}
__device__ __forceinline__ void pv(f32x16*o,int vb,bf16x8 pa0,bf16x8 pa1,bf16x8 pa2,bf16x8 pa3){
  #pragma unroll
  for(int d0=0;d0<2;++d0){s16x4 lo[4],hi[4];
    #pragma unroll
    for(int ks=0;ks<4;++ks){
      asm volatile("ds_read_b64_tr_b16 %0,%1 offset:%c2":"=&v"(lo[ks]):"v"(vb),"i"(d0*4096+ks*1024):"memory");
      asm volatile("ds_read_b64_tr_b16 %0,%1 offset:%c2":"=&v"(hi[ks]):"v"(vb),"i"(d0*4096+ks*1024+512):"memory");}
    asm volatile("s_waitcnt lgkmcnt(0)":::"memory");SBAR();
    #define PK(k) (bf16x8){lo[k][0],lo[k][1],lo[k][2],lo[k][3],hi[k][0],hi[k][1],hi[k][2],hi[k][3]}
    o[d0]=__builtin_amdgcn_mfma_f32_32x32x16_bf16(pa0,PK(0),o[d0],0,0,0);
    o[d0]=__builtin_amdgcn_mfma_f32_32x32x16_bf16(pa1,PK(1),o[d0],0,0,0);
    o[d0]=__builtin_amdgcn_mfma_f32_32x32x16_bf16(pa2,PK(2),o[d0],0,0,0);
    o[d0]=__builtin_amdgcn_mfma_f32_32x32x16_bf16(pa3,PK(3),o[d0],0,0,0);
    #undef PK
  }
}

#ifndef ATTN_STORE16
#define ATTN_STORE16(p,v) (*(u32x4*)(p)=(v))
#endif
template<int THRL> __device__ __forceinline__ void attn_unit(long qrow0,long kvrow0,int h,int NT,const bf16*Q,const bf16*__restrict__ K,const bf16*__restrict__ V,bf16*O,char*shm,const int wid_in){
  unsigned zero_=0u; asm volatile("":"+s"(zero_)); const int lane_=(int)__builtin_amdgcn_mbcnt_hi(~0u,__builtin_amdgcn_mbcnt_lo(~0u,zero_));
  const int lane=lane_,r32=lane&31,hi=lane>>5; const int wid=wid_in;
  const bf16*Qw=Q+(qrow0+wid*QBLK)*QP+h*D;
  const bf16*Kh=K+kvrow0*KP+(h>>2)*D,*Vh=V+kvrow0*KP+(h>>2)*D;
  const unsigned lds0=(unsigned)(uintptr_t)shm;
  float*wsf=(float*)(shm+LDS_WS)+wid*64;
  const bf16*ksrc=Kh+(long)lane*KP+wid*8;
  const bf16*vsrc=Vh+(long)(16*(wid&3)+(lane>>2))*KP+(wid>>2)*32+(lane&3)*8;
  const unsigned kdst=lds0+LDS_K+wid*1024, vdst=lds0+LDS_V+wid*1024;
  #define DMA_K(t,slot) glds16(ksrc+(long)(t)*KVBLK*KP,(unsigned)__builtin_amdgcn_readfirstlane(kdst+(slot)))
  #define DMA_V(t,slot) glds16(vsrc+(long)(t)*KVBLK*KP,(unsigned)__builtin_amdgcn_readfirstlane(vdst+(slot)))
  const int vb0=(int)(lds0+LDS_V)+((lane>>4)&1)*32+(lane&3)*8+(4*hi+((lane&15)>>2))*64;
  const char*Kbase=shm+LDS_K; bf16x8 kf[8];
  const lds_cptr shm3=(lds_cptr)shm; const lds_cptr kp0=shm3+LDS_K+hi*1024+r32*16; const lds_cptr vp0=shm3+LDS_V+((lane>>4)&1)*32+(lane&3)*8+(4*hi+((lane&15)>>2))*64;
  DMA_K(0,0);DMA_V(0,0);DMA_K(1,SLOTB);
  bf16x8 qr[4];
  #pragma unroll
  for(int d0=0;d0<4;++d0)qr[d0]=*reinterpret_cast<const bf16x8*>(&Qw[(long)r32*QP+d0*16+hi*8]);
  float mhat=0.f,l_reg=0.f;f32x16 o[2];o[0]=f32x16{};o[1]=f32x16{};f32x16 negm=f32x16{};asm volatile("":"+v"(negm));
  #define CMASK(P0,P1,t) do{}while(0)
  bool resc=false;
  #define START(P0,P1) do{ const float rm=rowmax(P0,P1); resc=false; \
    { const float dl=rm; mhat=fadd_s(mhat,dl); \
      _Pragma("unroll") for(int r=0;r<16;++r){P0[r]=fsub_s(P0[r],dl);P1[r]=fsub_s(P1[r],dl);} \
      _Pragma("unroll") for(int r=0;r<16;++r)negm[r]=-mhat; asm volatile("":"+v"(negm)); } \
    _Pragma("unroll") for(int r=0;r<16;++r)P0[r]=__builtin_amdgcn_exp2f(P0[r]); }while(0)
  #define RESC() do{ if(resc){ asm volatile("s_waitcnt lgkmcnt(0)":::"memory"); \
      _Pragma("unroll") for(int d_=0;d_<2;++d_) _Pragma("unroll") for(int r=0;r<16;++r)o[d_][r]*=wsf[crow(r,hi)]; } }while(0)
  f32x16 pA0,pA1,pB0,pB1;
  int sl_prev=0,sl_cur=0,sl_next=SLOTB;
  #define ROT() do{sl_prev=sl_cur;sl_cur=sl_next;sl_next=(sl_next==(NSLOT-1)*SLOTB)?0:sl_next+SLOTB;}while(0)
  DMA_K(2,2*SLOTB);
  WAIT_BAR(3);
  qkt(pA0,pA1,Kbase,qr,negm,r32,hi);asm volatile("s_nop 15\n\ts_nop 7":"+v"(pA0),"+v"(pA1));CMASK(pA0,pA1,0);
  START(pA0,pA1);
  _Pragma("unroll") for(int r=0;r<16;++r)pA1[r]=__builtin_amdgcn_exp2f(pA1[r]);
  WAIT_BAR(0);
  DMA_K(3,0);DMA_V(1,SLOTB);
  ROT();
  kload8(kf,kp0+sl_cur);
  WAIT_BAR(2);
  s16x4 vlo[8],vhi[8]; u32x4 pw0,pw1,pw2,pw3;
  #define PKW(P,B) cvtpk_s(P[B],P[B+1])
  #define PAF(k) __builtin_bit_cast(bf16x8,pw##k)
  #define VFR(i) (bf16x8){vlo[i][0],vlo[i][1],vlo[i][2],vlo[i][3],vhi[i][0],vhi[i][1],vhi[i][2],vhi[i][3]}
  #define PIN(x) asm volatile("":"+v"(x))
  #define MX3(a,b,c) __builtin_fmaxf(__builtin_fmaxf((a),(b)),(c))
  #define GAPA(MF,A0,A1,A2,A3,W0,W1,PW) do{ MF; sacc+=A0; sacc+=A1; sacc+=A2; sacc+=A3; PIN(sacc); W0; W1; PIN(PW); SBAR(); }while(0)
  #define EX(v) __builtin_amdgcn_exp2f(v)
  #define GAPB(MF,X,B) do{ MF; X[B]=EX(X[B]); X[B+1]=EX(X[B+1]); X[B+2]=EX(X[B+2]); X[B+3]=EX(X[B+3]); PIN(X); SBAR(); }while(0)
  #define VRD(i) do{ vlo[i]=vtr(vp_+(((i)>>2)*4096+((i)&3)*1024)); vhi[i]=vtr(vp_+(((i)>>2)*4096+((i)&3)*1024+512)); }while(0)
  #define KRD(G,j) do{ if(G){ kload2(kf,kp0+sl_next,j); SBAR(); } }while(0)
  #define STEP(C0,C1,P0,P1,t,GK,GV,GL) do{ SBAR(); \
    const lds_cptr vp_=vp0+sl_prev; \
    VRD(0); SBAR(); float sacc=(P0[0]+P0[1]); \
    GAPA(C0=__builtin_amdgcn_mfma_f32_32x32x16_bf16(kf[0],qr[0],negm,0,0,0), P0[2],P0[3],P0[4],P0[5],     pw0[0]=PKW(P0,0), pw0[1]=PKW(P0,2), pw0); \
    VRD(4); SBAR(); GAPA(C1=__builtin_amdgcn_mfma_f32_32x32x16_bf16(kf[1],qr[0],negm,0,0,0), P0[6],P0[7],P0[8],P0[9],     pw0[2]=PKW(P0,4), pw0[3]=PKW(P0,6), pw0); \
    VRD(1); SBAR(); GAPA(C0=__builtin_amdgcn_mfma_f32_32x32x16_bf16(kf[2],qr[1],C0,0,0,0),   P0[10],P0[11],P0[12],P0[13], pw1[0]=PKW(P0,8), pw1[1]=PKW(P0,10), pw1); \
    VRD(5); SBAR(); GAPA(C1=__builtin_amdgcn_mfma_f32_32x32x16_bf16(kf[3],qr[1],C1,0,0,0),   P0[14],P0[15],P1[0],P1[1],   pw1[2]=PKW(P0,12),pw1[3]=PKW(P0,14), pw1); \
    VRD(2); SBAR(); GAPA(C0=__builtin_amdgcn_mfma_f32_32x32x16_bf16(kf[4],qr[2],C0,0,0,0),   P1[2],P1[3],P1[4],P1[5],     pw2[0]=PKW(P1,0), pw2[1]=PKW(P1,2), pw2); \
    VRD(6); SBAR(); GAPA(C1=__builtin_amdgcn_mfma_f32_32x32x16_bf16(kf[5],qr[2],C1,0,0,0),   P1[6],P1[7],P1[8],P1[9],     pw2[2]=PKW(P1,4), pw2[3]=PKW(P1,6), pw2); \
    VRD(3); SBAR(); GAPA(C0=__builtin_amdgcn_mfma_f32_32x32x16_bf16(kf[6],qr[3],C0,0,0,0),   P1[10],P1[11],P1[12],P1[13], pw3[0]=PKW(P1,8), pw3[1]=PKW(P1,10), pw3); \
    VRD(7); SBAR(); GAPA(C1=__builtin_amdgcn_mfma_f32_32x32x16_bf16(kf[7],qr[3],C1,0,0,0),   P1[14],P1[15],0.f,0.f,       pw3[2]=PKW(P1,12),pw3[3]=PKW(P1,14), pw3); \
    l_reg+=sacc; \
    if(GK){DMA_K((t)+3,sl_cur);} if(GV){DMA_V((t)+1,sl_next);} \
    CMASK(C0,C1,t); \
    { float a=MX3(C0[0],C0[1],C1[0]),b=MX3(C0[2],C0[3],C1[1]); a=MX3(a,C1[2],C1[3]); \
      _Pragma("unroll") for(int r=4;r<16;r+=4){a=MX3(a,C0[r],C0[r+1]);b=MX3(b,C0[r+2],C0[r+3]);a=MX3(a,C1[r],C1[r+1]);b=MX3(b,C1[r+2],C1[r+3]);} \
      float rm=__builtin_fmaxf(a,b); { auto rr=__builtin_amdgcn_permlane32_swap(__float_as_uint(rm),__float_as_uint(rm),false,false); rm=__builtin_fmaxf(__uint_as_float(rr[0]),__uint_as_float(rr[1])); } \
      resc=false; \
      if(__builtin_expect(__any(rm>(float)THRL),0)){ const float dl=__builtin_fmaxf(rm,0.f); mhat+=dl; \
        _Pragma("unroll") for(int r=0;r<16;++r){C0[r]-=dl;C1[r]-=dl;} \
        _Pragma("unroll") for(int r=0;r<16;++r)negm[r]=-mhat; asm volatile("":"+v"(negm)); \
        const float f=__builtin_amdgcn_exp2f(-dl); l_reg*=f; if(hi==0)wsf[r32]=f; resc=true; } } \
    SBAR(); \
    GAPB(o[0]=__builtin_amdgcn_mfma_f32_32x32x16_bf16(PAF(0),VFR(0),o[0],0,0,0), C0,0); \
    GAPB(o[1]=__builtin_amdgcn_mfma_f32_32x32x16_bf16(PAF(0),VFR(4),o[1],0,0,0), C0,4); \
    KRD(GL,0); GAPB(o[0]=__builtin_amdgcn_mfma_f32_32x32x16_bf16(PAF(1),VFR(1),o[0],0,0,0), C0,8); \
    KRD(GL,1); GAPB(o[1]=__builtin_amdgcn_mfma_f32_32x32x16_bf16(PAF(1),VFR(5),o[1],0,0,0), C0,12); \
    KRD(GL,2); GAPB(o[0]=__builtin_amdgcn_mfma_f32_32x32x16_bf16(PAF(2),VFR(2),o[0],0,0,0), C1,0); \
    KRD(GL,3); GAPB(o[1]=__builtin_amdgcn_mfma_f32_32x32x16_bf16(PAF(2),VFR(6),o[1],0,0,0), C1,4); \
    GAPB(o[0]=__builtin_amdgcn_mfma_f32_32x32x16_bf16(PAF(3),VFR(3),o[0],0,0,0), C1,8); \
    GAPB(o[1]=__builtin_amdgcn_mfma_f32_32x32x16_bf16(PAF(3),VFR(7),o[1],0,0,0), C1,12); \
    }while(0)
  int t=1;
  for(;t+5<NT;t+=2){
    STEP(pB0,pB1,pA0,pA1,t,true,true,true);     WAIT_BAR(2); RESC(); ROT();
    STEP(pA0,pA1,pB0,pB1,t+1,true,true,true);   WAIT_BAR(2); RESC(); ROT();
  }
  #define ENDW(tt) do{ if((tt)+3<NT){WAIT_BAR(2);} else if((tt)+2<NT){WAIT_BAR(1);} else {WAIT_BAR(0);} }while(0)
  for(;t+1<NT;t+=2){
    STEP(pB0,pB1,pA0,pA1,t,(t+3<NT),(t+1<NT),(t+1<NT));       ENDW(t);   RESC(); ROT();
    STEP(pA0,pA1,pB0,pB1,t+1,(t+4<NT),(t+2<NT),(t+2<NT));     ENDW(t+1); RESC(); ROT();
  }
  STEP(pB0,pB1,pA0,pA1,NT-1,false,false,false); RESC();
  { float sacc=pB0[0]+pB0[1]; _Pragma("unroll") for(int r=2;r<16;++r)sacc+=pB0[r]; _Pragma("unroll") for(int r=0;r<16;++r)sacc+=pB1[r]; l_reg+=sacc;
    pw0=(u32x4){PKW(pB0,0),PKW(pB0,2),PKW(pB0,4),PKW(pB0,6)};pw1=(u32x4){PKW(pB0,8),PKW(pB0,10),PKW(pB0,12),PKW(pB0,14)};pw2=(u32x4){PKW(pB1,0),PKW(pB1,2),PKW(pB1,4),PKW(pB1,6)};pw3=(u32x4){PKW(pB1,8),PKW(pB1,10),PKW(pB1,12),PKW(pB1,14)};
    SBAR(); pv(o,vb0+sl_cur,PAF(0),PAF(1),PAF(2),PAF(3)); }
  #undef PKW
  #undef PAF
  #undef VFR
  #undef PIN
  #undef MX3
  #undef GAPA
  #undef GAPB
  #undef EX
  #undef VRD
  #undef KRD
  #undef STEP
  #undef ENDW
  {auto rr=__builtin_amdgcn_permlane32_swap(__float_as_uint(l_reg),__float_as_uint(l_reg),false,false);l_reg=__uint_as_float(rr[0])+__uint_as_float(rr[1]);}
  if(hi==0)wsf[32+r32]=l_reg;asm volatile("s_waitcnt lgkmcnt(0)":::"memory");
  float rli[16];
  #pragma unroll
  for(int r=0;r<16;++r)rli[r]=__builtin_amdgcn_rcpf(wsf[32+crow(r,hi)]);
  bf16*Ow=O+(qrow0+wid*QBLK)*QP+h*D;
  { bf16*stg=(bf16*)(shm+LDS_OST)+wid*2048;
    #pragma unroll
    for(int r=0;r<16;++r){const int orow=crow(r,hi);
      #pragma unroll
      for(int d0=0;d0<2;++d0)stg[orow*64+d0*32+r32]=__float2bfloat16(o[d0][r]*rli[r]);}
    asm volatile("s_waitcnt lgkmcnt(0)":::"memory");
    #pragma unroll
    for(int i=0;i<4;++i){const int row=i*8+(lane>>3),ch=lane&7; const u32x4 v=*(const u32x4*)(stg+row*64+ch*8); ATTN_STORE16(Ow+(long)row*QP+ch*8,v);} }
  asm volatile("s_waitcnt lgkmcnt(0)\n\ts_barrier":::"memory");
  #undef DMA_K
  #undef DMA_V
  #undef CMASK
  #undef START
  #undef RESC
  #undef ROT
}
constexpr int ATTN_LDS_BYTES=LDS_BYTES;
#undef SBAR
#undef WAIT_BAR
}

constexpr int DM = 1024, NB = 16, SEQ = 2048, CTXL = 256, NLAT = NB * SEQ, NCTX = NB * CTXL, NTOK = NLAT + NCTX, NKV = SEQ + CTXL;
constexpr int INW = 1792, PAW = 1536, WINR = 2048, NMOD = 6;
constexpr int NE = 32, DFF = 1024, MAXT = 608, RBLK = 512, MAXRB = NTOK / RBLK;
constexpr float EPS = 1e-6f;
constexpr int NWAVES = 8;
#define PROBE_MASK 0ull
#ifndef MK_PER_PHASE
#define MK_PER_PHASE 0
#endif
constexpr int NPHASE = 2 + 13 * 2;

constexpr size_t MiB = 1u << 20;
constexpr size_t WS_CTL = 0, CTL_ZERO_BYTES = 1 * MiB;
constexpr size_t WS_WIN = 1 * MiB;
constexpr size_t WS_WOUT = WS_WIN + 8 * MiB;
constexpr size_t WS_WR = WS_WOUT + 4 * MiB;
constexpr size_t WS_WGU = WS_WR + 1 * MiB;
constexpr size_t WS_WDN = WS_WGU + 256 * MiB;
constexpr size_t WS_WF = WS_WDN + 128 * MiB;
constexpr size_t WS_DFT = WS_WF + 4 * MiB;
constexpr size_t WS_DFTC = WS_DFT + 16 * MiB;
constexpr size_t WS_MOD = WS_DFTC + 1 * MiB;
constexpr size_t WS_ROPE = WS_MOD + 1 * MiB;
constexpr size_t WS_XCTX = WS_ROPE + 1 * MiB;
constexpr size_t WS_H = WS_XCTX + 16 * MiB;
constexpr size_t WS_F = WS_H + 72 * MiB;
constexpr size_t WS_PA = WS_F + 72 * MiB;
constexpr size_t WS_FT = WS_PA + 108 * MiB;
constexpr size_t WS_FTC = WS_FT + 32 * MiB;
constexpr size_t WS_Q = WS_FTC + 4 * MiB;
constexpr size_t WS_K = WS_Q + 36 * MiB;
constexpr size_t WS_V = WS_K + 9 * MiB;
constexpr size_t WS_CONV = WS_V + 9 * MiB;
constexpr size_t WS_O = WS_CONV + 18 * MiB;
constexpr size_t WS_YF = WS_O + 36 * MiB;
constexpr size_t WS_MERGED = WS_YF + 36 * MiB;
constexpr size_t WS_MIX = WS_MERGED + 72 * MiB;
constexpr size_t WS_LOG = WS_MIX + 72 * MiB;
constexpr size_t WS_EID = WS_LOG + 9 * MiB;
constexpr size_t WS_WT = WS_EID + 1 * MiB;
constexpr size_t WS_POS = WS_WT + 1 * MiB;
constexpr size_t WS_SLOT = WS_POS + 1 * MiB;
constexpr size_t WS_BCNT = WS_SLOT + 1 * MiB;
constexpr size_t WS_XS = WS_BCNT + 1 * MiB;
constexpr size_t WS_G = WS_XS + 304 * MiB;
constexpr size_t WS_Y = WS_G + 304 * MiB;
constexpr size_t WS_XB = WS_Y + 304 * MiB;
constexpr size_t WS_FTU = WS_XB + 72 * MiB;
constexpr size_t WS_FTUC = WS_FTU + 16 * MiB;
constexpr size_t WS_END = WS_FTUC + 2 * MiB;
constexpr int CW_BAR = 4096;

constexpr int RING_OFF = 0, RING_BYTES = 131072;
constexpr int SCR_BYTES = 8 * 16640;
constexpr int TAB_OFF = 135168;
constexpr int MISC_OFF = 147456;
constexpr int LDS_BYTES = 151552;
static_assert(SCR_BYTES <= TAB_OFF && TAB_OFF + 4096 <= MISC_OFF && MISC_OFF + 256 <= LDS_BYTES, "LDS map");

#define GAS __attribute__((address_space(1)))
#define LAS __attribute__((address_space(3)))
typedef unsigned short bf16;
typedef unsigned v4u __attribute__((ext_vector_type(4)));
typedef unsigned v2u __attribute__((ext_vector_type(2)));
typedef float f32x4 __attribute__((ext_vector_type(4)));
#define LDS_WAIT() asm volatile("s_waitcnt lgkmcnt(0)" ::: "memory")
#define VM_WAIT() asm volatile("s_waitcnt vmcnt(0)" ::: "memory")
__device__ __forceinline__ unsigned pk2(float lo, float hi) { return pg8::cvt_pk_bf16(lo, hi); }
__device__ __forceinline__ unsigned pk4_fp8(float a, float b, float c, float d) { int w = __builtin_amdgcn_cvt_pk_fp8_f32(a, b, __float_as_int(a), false); w = __builtin_amdgcn_cvt_pk_fp8_f32(c, d, w, true); return (unsigned)w; }
constexpr float S_W = 256.0f, S_G = 4.0f, S_Y = 4.0f;
__device__ __forceinline__ float bflo(unsigned u) { return __uint_as_float(u << 16); }
__device__ __forceinline__ float bfhi(unsigned u) { return __uint_as_float(u & 0xffff0000u); }
__device__ __forceinline__ float shx(float v, int m, int lane) { return __int_as_float(__builtin_amdgcn_ds_bpermute((lane ^ m) << 2, __float_as_int(v))); }
__device__ __forceinline__ float wave_sum(float v, int lane) {
#pragma unroll
    for (int o = 1; o < 64; o <<= 1) v += shx(v, o, lane);
    return v;
}
__device__ __forceinline__ float rsq(float x) { return __builtin_amdgcn_rsqf(x); }
__device__ __forceinline__ float sin_rev(float x) { return __builtin_amdgcn_sinf(__builtin_amdgcn_fractf(x)); }
__device__ __forceinline__ float cos_rev(float x) { return __builtin_amdgcn_cosf(__builtin_amdgcn_fractf(x)); }

#define XB_TMO      128
#define XB_XCNT(j)  (256  + 64 * (j))
#define XB_XSUB(j)  (1280 + 64 * (j))
#define XB_XGEN(j)  (2304 + 64 * (j))
#define XB_TOP      3328
#define XB_TOPGEN   3392
#define XCD_BAR_WORDS 3456
#define XB_SPIN_CAP (1u << 18)

__device__ __forceinline__ unsigned xb_ld(unsigned* p)              { return __hip_atomic_load(p, __ATOMIC_RELAXED, __HIP_MEMORY_SCOPE_AGENT); }
__device__ __forceinline__ unsigned xb_add(unsigned* p, unsigned v) { return __hip_atomic_fetch_add(p, v, __ATOMIC_RELAXED, __HIP_MEMORY_SCOPE_AGENT); }
__device__ __forceinline__ unsigned xb_xcc_id() { return (unsigned)__builtin_amdgcn_s_getreg((3 << 11) | 20) & 0xFu; }
#define XB_SPIN(cond, bar) do { unsigned _sp = 0; while (cond) { __builtin_amdgcn_s_sleep(1); \
    if ((++_sp & 255u) == 0u) { if (xb_ld(&(bar)[XB_TMO])) break; if (_sp > XB_SPIN_CAP) { atomicAdd(&(bar)[XB_TMO], 1u); break; } } } } while (0)

struct XcdBarrier {
    unsigned* bar; unsigned x;
    volatile LAS unsigned* st;
};

__device__ __forceinline__ XcdBarrier xcd_barrier_post(unsigned* bar, volatile LAS unsigned* st) {
    XcdBarrier b; b.bar = bar; b.x = xb_xcc_id(); b.st = st;
    if (threadIdx.x == 0) (void)xb_add(&bar[XB_XCNT(b.x)], 1u);
    return b;
}
__device__ __forceinline__ void xcd_barrier_complete(unsigned* bar, unsigned x, unsigned& nloc, unsigned& nx) {
    const unsigned G = gridDim.x * gridDim.y * gridDim.z;
    unsigned sum, cnt, mine, sp = 0u;
    for (;;) {
        sum = 0u; cnt = 0u; mine = 0u;
#pragma unroll
        for (unsigned j = 0; j < 16; ++j) { const unsigned c = xb_ld(&bar[XB_XCNT(j)]); sum += c; cnt += (c > 0u) ? 1u : 0u; mine = (j == x) ? c : mine; }
        if (sum == G) break;
        __builtin_amdgcn_s_sleep(1);
        if ((++sp & 255u) == 0u) { if (xb_ld(&bar[XB_TMO])) break; if (sp > XB_SPIN_CAP) { atomicAdd(&bar[XB_TMO], 1u); break; } }
    }
    nloc = mine > 0u ? mine : 1u; nx = cnt > 0u ? cnt : 1u;
}

__device__ __forceinline__ void xcd_barrier(const XcdBarrier& b) {
    asm volatile("s_waitcnt vmcnt(0)" ::: "memory");
    __syncthreads();
    if (threadIdx.x == 0) {
        unsigned* bar = b.bar;
        __builtin_amdgcn_s_waitcnt(0);
        unsigned nloc = b.st[0], nx = b.st[1];
        if (nloc == 0u) { xcd_barrier_complete(bar, b.x, nloc, nx); b.st[0] = nloc; b.st[1] = nx; }
        const unsigned old = xb_add(&bar[XB_XSUB(b.x)], 1u);
        const unsigned gen = old / nloc;
        if (old + 1u == (gen + 1u) * nloc) {
            __builtin_amdgcn_fence(__ATOMIC_RELEASE, "agent");
            asm volatile("s_waitcnt vmcnt(0)" ::: "memory");
            const unsigned og = xb_add(&bar[XB_TOP], 1u);
            const unsigned tg = og / nx;
            if (og + 1u == (tg + 1u) * nx) xb_add(&bar[XB_TOPGEN], 1u);
            else XB_SPIN(xb_ld(&bar[XB_TOPGEN]) == tg, bar);
            __builtin_amdgcn_fence(__ATOMIC_ACQUIRE, "agent");
            xb_add(&bar[XB_XGEN(b.x)], 1u);
            asm volatile("s_waitcnt vmcnt(0)" ::: "memory");
        } else {
            XB_SPIN(xb_ld(&bar[XB_XGEN(b.x)]) == gen, bar);
            __builtin_amdgcn_fence(__ATOMIC_ACQUIRE, "agent");
            asm volatile("s_waitcnt vmcnt(0)" ::: "memory");
        }
    }
    __syncthreads();
}


struct RowF { f32x4 v[4]; };
__device__ __forceinline__ void ld_row_f32(RowF& r, const float* p, int lane) { const f32x4* q = (const f32x4*)p + lane;
#pragma unroll
    for (int j = 0; j < 4; ++j) r.v[j] = q[64 * j]; }
__device__ __forceinline__ void st_row_f32(float* p, int lane, const RowF& r) { f32x4* q = (f32x4*)p + lane;
#pragma unroll
    for (int j = 0; j < 4; ++j) q[64 * j] = r.v[j]; }
__device__ __forceinline__ void ld_row_bf16(RowF& r, const bf16* p, int lane) { const v2u* q = (const v2u*)p + lane;
#pragma unroll
    for (int j = 0; j < 4; ++j) { const v2u w = q[64 * j]; r.v[j] = (f32x4){bflo(w.x), bfhi(w.x), bflo(w.y), bfhi(w.y)}; } }
__device__ __forceinline__ void st_row_bf16(bf16* p, int lane, const RowF& r) { v2u* q = (v2u*)p + lane;
#pragma unroll
    for (int j = 0; j < 4; ++j) { v2u w; w.x = pk2(r.v[j][0], r.v[j][1]); w.y = pk2(r.v[j][2], r.v[j][3]); q[64 * j] = w; } }
__device__ __forceinline__ float row_ss(const RowF& r, int lane) { float s = 0.f;
#pragma unroll
    for (int j = 0; j < 4; ++j) s += (r.v[j][0] * r.v[j][0] + r.v[j][1] * r.v[j][1]) + (r.v[j][2] * r.v[j][2] + r.v[j][3] * r.v[j][3]);
    return wave_sum(s, lane); }
__device__ __forceinline__ void modulate_store8(const RowF& x, const float* g, const float* sh, const float* sc, unsigned char* dst, int lane) {
    const float rstd = rsq(row_ss(x, lane) * (1.0f / DM) + EPS);
    RowF gg, s1, s2; ld_row_f32(gg, g, lane); ld_row_f32(s1, sc, lane); ld_row_f32(s2, sh, lane);
    unsigned* q = (unsigned*)dst + lane;
#pragma unroll
    for (int j = 0; j < 4; ++j) { const f32x4 o = x.v[j] * rstd * gg.v[j] * (s1.v[j] + 1.0f) + s2.v[j]; q[64 * j] = pk4_fp8(o[0], o[1], o[2], o[3]); }
}
__device__ __forceinline__ void modulate_store(const RowF& x, const float* g, const float* sh, const float* sc, bf16* dst, int lane) {
    const float rstd = rsq(row_ss(x, lane) * (1.0f / DM) + EPS);
    RowF gg, s1, s2; ld_row_f32(gg, g, lane); ld_row_f32(s1, sc, lane); ld_row_f32(s2, sh, lane);
    RowF o;
#pragma unroll
    for (int j = 0; j < 4; ++j) o.v[j] = x.v[j] * rstd * gg.v[j] * (s1.v[j] + 1.0f) + s2.v[j];
    st_row_bf16(dst, lane, o);
}

struct Params {
    const float *x, *c, *ctx, *c_ctx, *w_mod, *b_mod, *g_pre_mix, *g_post_mix, *g_pre_ffn, *g_post_ffn, *w_in, *g_q, *g_k, *conv_w, *g_branch, *w_out,
                *w_router, *b_router, *w_gu, *b_gu, *w_dn, *b_dn;
    float* out; unsigned char* ws; int ph_lo, ph_hi, li, pad;
};

__device__ __forceinline__ void tr_item(const float* W, size_t ldw, int k0, int n0, bf16* WT, size_t ldt, int drow0, LAS float* scr, int lane) {
    const int lr = lane >> 4, lc = (lane & 15) * 4;
    f32x4 v[16];
#pragma unroll
    for (int i = 0; i < 16; ++i) v[i] = *(const f32x4*)(W + (size_t)(k0 + 4 * i + lr) * ldw + n0 + lc);
#pragma unroll
    for (int i = 0; i < 16; ++i) { LAS float* s = scr + (4 * i + lr) * 65 + lc; s[0] = v[i][0]; s[1] = v[i][1]; s[2] = v[i][2]; s[3] = v[i][3]; }
    LDS_WAIT(); asm volatile("" ::: "memory");
    const int c = lane & 7;
    const LAS float* s0 = scr + (8 * c) * 65 + (lane >> 3);
    float t[8][8];
#pragma unroll
    for (int j = 0; j < 8; ++j)
#pragma unroll
        for (int q = 0; q < 8; ++q) t[j][q] = s0[q * 65 + 8 * j];
    LDS_WAIT(); asm volatile("" ::: "memory");
#pragma unroll
    for (int j = 0; j < 8; ++j) { const int n = (lane >> 3) + 8 * j;
        v4u o; o.x = pk2(t[j][0], t[j][1]); o.y = pk2(t[j][2], t[j][3]); o.z = pk2(t[j][4], t[j][5]); o.w = pk2(t[j][6], t[j][7]);
        *(v4u*)(WT + (size_t)(drow0 + n) * ldt + k0 + 8 * c) = o; }
}

__device__ __forceinline__ void tr_item2(const float* W, size_t ldw, int k0, int n0, bf16* WT, size_t ldt, int drowA, int drowB, LAS float* scr, int lane) {
    const int lr = lane >> 4, lc = (lane & 15) * 4;
    f32x4 v[16];
#pragma unroll
    for (int i = 0; i < 16; ++i) v[i] = *(const f32x4*)(W + (size_t)(k0 + 4 * i + lr) * ldw + n0 + lc);
#pragma unroll
    for (int i = 0; i < 16; ++i) { LAS float* s = scr + (4 * i + lr) * 65 + lc; s[0] = v[i][0]; s[1] = v[i][1]; s[2] = v[i][2]; s[3] = v[i][3]; }
    LDS_WAIT(); asm volatile("" ::: "memory");
    const int c = lane & 7;
    const LAS float* s0 = scr + (8 * c) * 65 + (lane >> 3);
    float t[8][8];
#pragma unroll
    for (int j = 0; j < 8; ++j)
#pragma unroll
        for (int q = 0; q < 8; ++q) t[j][q] = s0[q * 65 + 8 * j];
    LDS_WAIT(); asm volatile("" ::: "memory");
#pragma unroll
    for (int j = 0; j < 8; ++j) { const int n = (lane >> 3) + 8 * j; const int row = (j < 4) ? drowA + n : drowB + n - 32;
        v4u o; o.x = pk2(t[j][0], t[j][1]); o.y = pk2(t[j][2], t[j][3]); o.z = pk2(t[j][4], t[j][5]); o.w = pk2(t[j][6], t[j][7]);
        *(v4u*)(WT + (size_t)row * ldt + k0 + 8 * c) = o; }
}

__device__ __forceinline__ void tr_item2_8(const float* W, size_t ldw, int k0, int n0, unsigned char* WT8, size_t ldt, int drowA, int drowB, float sc, LAS float* scr, int lane) {
    const int lr = lane >> 4, lc = (lane & 15) * 4;
    f32x4 v[16];
#pragma unroll
    for (int i = 0; i < 16; ++i) v[i] = *(const f32x4*)(W + (size_t)(k0 + 4 * i + lr) * ldw + n0 + lc);
#pragma unroll
    for (int i = 0; i < 16; ++i) { LAS float* s = scr + (4 * i + lr) * 65 + lc; s[0] = v[i][0] * sc; s[1] = v[i][1] * sc; s[2] = v[i][2] * sc; s[3] = v[i][3] * sc; }
    LDS_WAIT(); asm volatile("" ::: "memory");
    const int c = lane & 7;
    const LAS float* s0 = scr + (8 * c) * 65 + (lane >> 3);
    float t[8][8];
#pragma unroll
    for (int j = 0; j < 8; ++j)
#pragma unroll
        for (int q = 0; q < 8; ++q) t[j][q] = s0[q * 65 + 8 * j];
    LDS_WAIT(); asm volatile("" ::: "memory");
#pragma unroll
    for (int j = 0; j < 8; ++j) { const int n = (lane >> 3) + 8 * j; const int row = (j < 4) ? drowA + n : drowB + n - 32;
        v2u o; o.x = pk4_fp8(t[j][0], t[j][1], t[j][2], t[j][3]); o.y = pk4_fp8(t[j][4], t[j][5], t[j][6], t[j][7]);
        *(v2u*)(WT8 + (size_t)row * ldt + k0 + 8 * c) = o; }
}

__device__ __forceinline__ void tr_item8(const float* W, size_t ldw, int k0, int n0, unsigned char* WT8, size_t ldt, int drow0, float sc, LAS float* scr, int lane) {
    const int lr = lane >> 4, lc = (lane & 15) * 4;
    f32x4 v[16];
#pragma unroll
    for (int i = 0; i < 16; ++i) v[i] = *(const f32x4*)(W + (size_t)(k0 + 4 * i + lr) * ldw + n0 + lc);
#pragma unroll
    for (int i = 0; i < 16; ++i) { LAS float* s = scr + (4 * i + lr) * 65 + lc; s[0] = v[i][0] * sc; s[1] = v[i][1] * sc; s[2] = v[i][2] * sc; s[3] = v[i][3] * sc; }
    LDS_WAIT(); asm volatile("" ::: "memory");
    const int c = lane & 7;
    const LAS float* s0 = scr + (8 * c) * 65 + (lane >> 3);
    float t[8][8];
#pragma unroll
    for (int j = 0; j < 8; ++j)
#pragma unroll
        for (int q = 0; q < 8; ++q) t[j][q] = s0[q * 65 + 8 * j];
    LDS_WAIT(); asm volatile("" ::: "memory");
#pragma unroll
    for (int j = 0; j < 8; ++j) { const int n = (lane >> 3) + 8 * j;
        v2u o; o.x = pk4_fp8(t[j][0], t[j][1], t[j][2], t[j][3]); o.y = pk4_fp8(t[j][4], t[j][5], t[j][6], t[j][7]);
        *(v2u*)(WT8 + (size_t)(drow0 + n) * ldt + k0 + 8 * c) = o; }
}

using pg8::Unit; using pg8::bf16_t;
typedef const pg8::f32x4 (&AccRef)[2][2][4][2];
constexpr size_t TILE1K = (size_t)256 * 1024 * 2;
constexpr size_t TILE8 = (size_t)256 * 1024;

struct InprojSched {
    static constexpr bool GATHER = false, BGATHER = false, HALVES = false;
    int G, c, layer, n0, n1, nwg; const char* H; const char* W; size_t tb;
    __device__ __forceinline__ void init(int G_, int c_, int layer_, const void* H_, const void* W_) { G = G_; c = c_; layer = layer_; H = (const char*)H_; W = (const char*)W_; tb = (layer_ == 0) ? TILE1K : TILE8;
        n0 = (layer == 0) ? 144 * 6 : 128 * 6; n1 = (layer == 0) ? 0 : 16; nwg = n0 + n1 + ((layer == 0) ? 144 : 128); }
    __device__ __forceinline__ bool next(int i, Unit& u) const { int w; if (!pg8::list_index(i, G, c, nwg, w)) return false;
        if (w < n0) { u.pm = w / 6; u.pn = w % 6; u.kind = 0; } else if (w < n0 + n1) { u.pm = 128 + (w - n0); u.pn = 2; u.kind = 0; } else { u.pm = 0; u.pn = w - n0 - n1; u.kind = 1; }
        u.half = 0; return true; }
    __device__ __forceinline__ const char* aptr(const Unit& u) const { return u.kind == 0 ? H + (size_t)u.pm * tb : W + (size_t)(6 + u.pm) * tb; }
    __device__ __forceinline__ const char* bptr(const Unit& u) const { return u.kind == 0 ? W + (size_t)u.pn * tb : H + (size_t)u.pn * tb; }
};
struct InprojEpi {
    static constexpr bool PERM = true, AFTER_DRAIN = false, BADJ = true;
    bf16_t *PA, *FT, *FTC, *QB, *KB, *VB; const LAS float* tab; float sc;
    __device__ __forceinline__ void heads(AccRef acc, const Unit& u, int wr, int wc, int fr, int fq) const {
        const int lane = fq * 16 + fr; const bool isq = u.pn < 2, isv = (!isq) && wc >= 2, isc = u.pm >= NLAT / 256;
        const LAS float* gp = tab + 2048 + (isq ? 0 : 64) + fq * 8;
        const int tb = (fq & 1) * 8; const bool hi = (fq >> 1) != 0;
        const f32x4 gA0 = *(const LAS f32x4*)(gp), gA1 = *(const LAS f32x4*)(gp + 4), gB0 = *(const LAS f32x4*)(gp + 32), gB1 = *(const LAS f32x4*)(gp + 36);
#pragma unroll
        for (int ai = 0; ai < 2; ++ai)
#pragma unroll
            for (int m = 0; m < 4; ++m) { const int row = u.pm * 256 + ai * 128 + wr * 64 + m * 16 + fr;
                int bb, t; if (!isc) { bb = row >> 11; t = row & 2047; } else { const int r2 = row - NLAT; bb = r2 >> 8; t = r2 & 255; }
                const size_t kvrow = (size_t)bb * NKV + (isc ? SEQ + t : t);
                float x[2][8];
#pragma unroll
                for (int bj = 0; bj < 2; ++bj)
#pragma unroll
                    for (int n = 0; n < 2; ++n)
#pragma unroll
                        for (int i = 0; i < 4; ++i) x[bj][n * 4 + i] = acc[ai][bj][m][n][i] * sc;
                if (isv) {
#pragma unroll
                    for (int bj = 0; bj < 2; ++bj) { v4u ow; ow.x = pk2(x[bj][0], x[bj][1]); ow.y = pk2(x[bj][2], x[bj][3]); ow.z = pk2(x[bj][4], x[bj][5]); ow.w = pk2(x[bj][6], x[bj][7]);
                        *(v4u*)(VB + kvrow * 128 + (wc - 2) * 64 + bj * 32 + fq * 8) = ow; }
                } else {
                    float ss = 0.f;
#pragma unroll
                    for (int bj = 0; bj < 2; ++bj)
#pragma unroll
                        for (int c = 0; c < 8; ++c) ss += x[bj][c] * x[bj][c];
                    ss += shx(ss, 16, lane); ss += shx(ss, 32, lane);
                    const float rstd = rsq(ss * (1.0f / 64.0f) + EPS) * (isq ? attn_body::C2 : 1.0f);
#pragma unroll
                    for (int bj = 0; bj < 2; ++bj) { const int pos = bj ? (t & 63) : (t >> 6);
                        f32x4 c0 = *(const LAS f32x4*)(tab + pos * 16 + tb), c1 = *(const LAS f32x4*)(tab + pos * 16 + tb + 4), s0 = *(const LAS f32x4*)(tab + 1024 + pos * 16 + tb), s1 = *(const LAS f32x4*)(tab + 1024 + pos * 16 + tb + 4);
                        if (isc) { c0 = (f32x4){1.f, 1.f, 1.f, 1.f}; c1 = c0; s0 = (f32x4){0.f, 0.f, 0.f, 0.f}; s1 = s0; }
                        const f32x4 g0 = bj ? gB0 : gA0, g1 = bj ? gB1 : gA1;
                        float o[8];
#pragma unroll
                        for (int c = 0; c < 8; ++c) { const float xn = x[bj][c] * rstd * (c < 4 ? g0[c & 3] : g1[c & 3]); const float xp = shx(xn, 32, lane);
                            const float cs = c < 4 ? c0[c & 3] : c1[c & 3], sn = c < 4 ? s0[c & 3] : s1[c & 3]; o[c] = hi ? xn * cs + xp * sn : xn * cs - xp * sn; }
                        v4u ow; ow.x = pk2(o[0], o[1]); ow.y = pk2(o[2], o[3]); ow.z = pk2(o[4], o[5]); ow.w = pk2(o[6], o[7]);
                        if (isq) *(v4u*)(QB + (size_t)row * 512 + (u.pn * 4 + wc) * 64 + bj * 32 + fq * 8) = ow;
                        else *(v4u*)(KB + kvrow * 128 + wc * 64 + bj * 32 + fq * 8) = ow; }
                } }
    }
    __device__ __forceinline__ void operator()(AccRef acc, const Unit& u, int wr, int wc, int fr, int fq) const {
        if (u.kind == 0 && u.pn <= 2) { heads(acc, u, wr, wc, fr, fq); return; }
        if (u.kind == 0 && u.pn >= 4) {
            bf16_t* b0 = PA + (size_t)(u.pm * 256 + wr * 64 + fr) * PAW + 1024 + (u.pn - 4) * 128 + wc * 32 + 8 * fq;
#pragma unroll
            for (int ai = 0; ai < 2; ++ai)
#pragma unroll
                for (int m = 0; m < 4; ++m) { const pg8::f32x4 p0 = (acc[ai][0][m][0] * sc) * (acc[ai][1][m][0] * sc), p1 = (acc[ai][0][m][1] * sc) * (acc[ai][1][m][1] * sc);
                    v4u w; w.x = pk2(p0[0], p0[1]); w.y = pk2(p0[2], p0[3]); w.z = pk2(p1[0], p1[1]); w.w = pk2(p1[2], p1[3]);
                    *(v4u*)(b0 + (size_t)(ai * 128 + m * 16) * PAW) = w; }
            return; }
        bf16_t* base; size_t ldc;
        if (u.kind == 0) { base = PA + (size_t)u.pm * 256 * PAW + u.pn * 256; ldc = PAW; }
        else if (u.pn < 128) { const int b = u.pn >> 3, nn = (u.pn & 7) * 256; base = FT + (size_t)b * 256 * 2048 + nn; ldc = 2048; }
        else { const int b = u.pn - 128; base = FTC + (size_t)b * 256 * 256; ldc = 256; }
        pg8::store_tile_bf16_adj_sc(acc, base, ldc, wr, wc, fr, fq, sc);
    }
};
constexpr size_t YF_CTX = (size_t)4 * NB * 1024 * 256;
template <bool CTX> struct FourierSchedT {
    static constexpr bool GATHER = false, BGATHER = !CTX, HALVES = false;
    int G, c, nwg; const char* A; const char* B; size_t tileb;
    __device__ __forceinline__ bool next(int i, Unit& u) const { int w; if (!pg8::list_index(i, G, c, nwg, w)) return false;
        if (CTX) { u.pm = 0; u.pn = w; u.kind = 4; } else { u.kind = w & 3; u.pm = (w >> 2) & 3; u.pn = w >> 4; } u.half = 0; return true; }
    __device__ __forceinline__ const char* aptr(const Unit& u) const { return CTX ? A : A + ((size_t)(1 + 256 * u.pm) * 4096 + (size_t)u.kind * 1024) * 2; }
    __device__ __forceinline__ const char* bptr(const Unit& u) const { return CTX ? B + (size_t)u.pn * tileb : B + (size_t)u.pn * tileb + (size_t)(u.kind & 1) * 1024 * 2; }
    __device__ __forceinline__ unsigned boff(const Unit& u, int ch) const { const int g = ch >> 6, k2 = ch & 63;
        const int uu = (u.kind & 2) ? (((k2 & 31) == 0) ? g * 64 : g * 64 + 32 + (k2 < 32 ? k2 : 64 - k2)) : g * 64 + (k2 <= 32 ? k2 : 64 - k2);
        return (unsigned)uu * 4096u; }
};
struct FourierEpi {
    static constexpr bool PERM = true, AFTER_DRAIN = false, BADJ = false;
    bf16_t* YF;
    __device__ __forceinline__ void operator()(AccRef acc, const Unit& u, int wr, int wc, int fr, int fq) const {
        bf16_t* base = (u.kind == 4) ? YF + YF_CTX + (size_t)u.pn * 256 * 256 : YF + (((size_t)u.kind * NB + u.pn) * 1024 + u.pm * 256) * 256;
        pg8::store_tile_bf16(acc, base, 256, wr, wc, fr, fq);
    }
};
struct PlainSched {
    static constexpr bool GATHER = false, BGATHER = false, HALVES = false;
    int G, c, nN, nwg; const char* A; const char* B;
    __device__ __forceinline__ bool next(int i, Unit& u) const { int w; if (!pg8::list_index(i, G, c, nwg, w)) return false; u.pm = w >> 2; u.pn = w & 3; u.kind = 0; u.half = 0; return true; }
    __device__ __forceinline__ const char* aptr(const Unit& u) const { return A + (size_t)u.pm * TILE1K; }
    __device__ __forceinline__ const char* bptr(const Unit& u) const { return B + (size_t)u.pn * TILE1K; }
};
struct OutEpi {
    static constexpr bool PERM = true, AFTER_DRAIN = false, BADJ = false;
    bf16_t* MIX;
    __device__ __forceinline__ void operator()(AccRef acc, const Unit& u, int wr, int wc, int fr, int fq) const { pg8::store_tile_bf16(acc, MIX + (size_t)u.pm * 256 * DM + u.pn * 256, DM, wr, wc, fr, fq); }
};
struct CtxKSched {
    static constexpr bool GATHER = false, BGATHER = false, HALVES = false;
    int G, c, nwg; const char* A; const char* B;
    __device__ __forceinline__ bool next(int i, Unit& u) const { int w; if (!pg8::list_index(i, G, c, nwg, w)) return false; u.kind = w & 3; u.pn = (w >> 2) & 3; u.pm = w >> 4; u.half = 0; return true; }
    __device__ __forceinline__ const char* aptr(const Unit& u) const { return A + (size_t)u.pm * TILE1K + (size_t)u.kind * 256 * 2; }
    __device__ __forceinline__ const char* bptr(const Unit& u) const { return B + (size_t)u.pn * TILE1K + (size_t)u.kind * 256 * 2; }
};
struct CtxKEpi {
    static constexpr bool PERM = true, AFTER_DRAIN = false, BADJ = false;
    bf16_t* MIXC;
    __device__ __forceinline__ void operator()(AccRef acc, const Unit& u, int wr, int wc, int fr, int fq) const { pg8::store_tile_bf16(acc, MIXC + ((size_t)u.kind * NCTX + (size_t)u.pm * 256) * DM + u.pn * 256, DM, wr, wc, fr, fq); }
};
struct RouterEpi {
    static constexpr bool PERM = false, AFTER_DRAIN = false, BADJ = false;
    float* LOG;
    __device__ __forceinline__ void operator()(AccRef acc, const Unit& u, int wr, int wc, int fr, int fq) const {
        if (wc >= 2) return;
#pragma unroll
        for (int ai = 0; ai < 2; ++ai)
#pragma unroll
            for (int m = 0; m < 4; ++m) { float* rowp = LOG + (size_t)(u.pm * 256 + ai * 128 + wr * 64 + m * 16 + fr) * 64 + wc * 32 + 4 * fq;
#pragma unroll
                for (int n = 0; n < 2; ++n) *(pg8::f32x4*)(rowp + 16 * n) = acc[ai][0][m][n]; }
    }
};
template <bool GATHER_> struct MoeSchedT {
    static constexpr bool GATHER = GATHER_, BGATHER = false, HALVES = true;
    int G, c, ncol, nwg; const LAS int* tile_e; const char* A; const char* W; size_t wstride; const int* rowtok;
    __device__ __forceinline__ bool next(int i, Unit& u) const {
        const int nx = G >> 3, xcd = c & 7, off = i * nx + (c >> 3), q = nwg >> 3, rem = nwg & 7;
        const int qx = q + (xcd < rem ? 1 : 0), base = xcd * q + (xcd < rem ? xcd : rem), rx = qx % nx, fx = qx - rx; const bool split = (rx > 0) && (2 * rx <= nx);
        if (off >= (split ? fx + 2 * rx : qx)) return false;
        int w; if (!split || off < fx) { w = base + off; u.half = 0; } else { const int j = off - fx; w = base + fx + (j >> 1); u.half = 1 + (j & 1); }
        u.pm = (ncol == 8) ? (w >> 3) : (w >> 2); u.pn = w & (ncol - 1); u.kind = __builtin_amdgcn_readfirstlane(tile_e[u.pm]); return true; }
    __device__ __forceinline__ const char* aptr(const Unit& u) const { return GATHER_ ? A : A + (size_t)u.pm * TILE8 + (u.half == 2 ? (size_t)128 * 1024 : (size_t)0); }
    __device__ __forceinline__ const char* bptr(const Unit& u) const { return W + (size_t)u.kind * wstride + (size_t)u.pn * TILE8; }
    __device__ __forceinline__ const int* tokptr(const Unit& u) const { return rowtok + (size_t)u.pm * 256; }
};
__device__ __forceinline__ pg8::u32x4 widen16(unsigned m0d0, unsigned m0d1, unsigned m1d0, unsigned m1d1) {
    const auto r0 = __builtin_amdgcn_permlane16_swap(m0d0, m1d0, false, false); const auto r1 = __builtin_amdgcn_permlane16_swap(m0d1, m1d1, false, false);
    return (pg8::u32x4){r0[0], r1[0], r0[1], r1[1]};
}
struct PlainSched8 {
    static constexpr bool GATHER = false, BGATHER = false, HALVES = false;
    int G, c, nN, nwg; const char* A; const char* B;
    __device__ __forceinline__ bool next(int i, Unit& u) const { int w; if (!pg8::list_index(i, G, c, nwg, w)) return false; u.pm = w >> 2; u.pn = w & 3; u.kind = 0; u.half = 0; return true; }
    __device__ __forceinline__ const char* aptr(const Unit& u) const { return A + (size_t)u.pm * TILE8; }
    __device__ __forceinline__ const char* bptr(const Unit& u) const { return B + (size_t)u.pn * TILE8; }
};
constexpr float S_M = 4.0f;
struct OutEpi8 {
    static constexpr bool PERM = true, AFTER_DRAIN = false, BADJ = false;
    unsigned char* MIX8;
    __device__ __forceinline__ void operator()(AccRef acc, const Unit& u, int wr, int wc, int fr, int fq) const {
        unsigned char* b0 = MIX8 + (size_t)(u.pm * 256 + wr * 64 + (fq & 1) * 16 + fr) * DM + u.pn * 256 + wc * 32 + 16 * (fq >> 1);
#pragma unroll
        for (int bj = 0; bj < 2; ++bj)
#pragma unroll
            for (int ai = 0; ai < 2; ++ai)
#pragma unroll
                for (int mp = 0; mp < 2; ++mp) { unsigned w[2][2];
#pragma unroll
                    for (int mm = 0; mm < 2; ++mm) { const int m = 2 * mp + mm;
                        const pg8::f32x4 v0 = acc[ai][bj][m][0] * (S_M / S_W), v1 = acc[ai][bj][m][1] * (S_M / S_W);
                        w[mm][0] = pk4_fp8(v0[0], v0[1], v0[2], v0[3]); w[mm][1] = pk4_fp8(v1[0], v1[1], v1[2], v1[3]); }
                    *(pg8::u32x4*)(b0 + (size_t)(ai * 128 + mp * 32) * DM + bj * 128) = widen16(w[0][0], w[0][1], w[1][0], w[1][1]); }
    }
};
struct SwigluEpi {
    static constexpr bool PERM = true, AFTER_DRAIN = false, BADJ = false;
    unsigned char* Gb; const float* bgu;
    __device__ __forceinline__ void operator()(AccRef acc, const Unit& u, int wr, int wc, int fr, int fq) const {
        const int cc = u.pn * 128 + wc * 32 + 8 * fq; const float* bp = bgu + (size_t)u.kind * 2048 + cc;
        float cT = -1.702f * 1.4426950408889634f / S_W, cU = S_G / (S_W * S_W); asm volatile("" : "+v"(cT), "+v"(cU));
        const pg8::f32x4 bg0 = *(const pg8::f32x4*)bp * S_W, bg1 = *(const pg8::f32x4*)(bp + 4) * S_W, bu0 = (*(const pg8::f32x4*)(bp + 1024) + 1.0f) * (S_G / S_W), bu1 = (*(const pg8::f32x4*)(bp + 1028) + 1.0f) * (S_G / S_W);
        unsigned char* b0 = Gb + (size_t)(u.pm * 256 + (u.half == 2 ? 128 : 0) + wr * 64 + (fq & 1) * 16 + fr) * DFF + u.pn * 128 + wc * 32 + 16 * (fq >> 1);
#pragma unroll
        for (int ai = 0; ai < 2; ++ai) { if (ai == 1 && u.half) break;
#pragma unroll
            for (int mp = 0; mp < 2; ++mp) { unsigned w[2][2];
#pragma unroll
                for (int mm = 0; mm < 2; ++mm) { const int m = 2 * mp + mm; float o[8];
#pragma unroll
                    for (int n = 0; n < 2; ++n) {
                        const pg8::f32x4 g4 = acc[ai][0][m][n] + (n ? bg1 : bg0), u4 = acc[ai][1][m][n] * cU + (n ? bu1 : bu0);
                        pg8::f32x4 a4, l4, e4, r4;
#pragma unroll
                        for (int i = 0; i < 4; ++i) { a4[i] = fminf(g4[i], 7.0f * S_W); l4[i] = __builtin_amdgcn_fmed3f(u4[i], -6.0f * S_G / S_W, 8.0f * S_G / S_W); }
                        const pg8::f32x4 t4 = a4 * cT;
#pragma unroll
                        for (int i = 0; i < 4; ++i) e4[i] = __builtin_amdgcn_exp2f(t4[i]);
                        const pg8::f32x4 d4 = e4 + 1.0f;
#pragma unroll
                        for (int i = 0; i < 4; ++i) r4[i] = __builtin_amdgcn_rcpf(d4[i]);
                        const pg8::f32x4 o4 = (a4 * r4) * l4;
#pragma unroll
                        for (int i = 0; i < 4; ++i) o[n * 4 + i] = o4[i]; }
                    w[mm][0] = pk4_fp8(o[0], o[1], o[2], o[3]); w[mm][1] = pk4_fp8(o[4], o[5], o[6], o[7]); }
                *(pg8::u32x4*)(b0 + (size_t)(ai * 128 + mp * 32) * DFF) = widen16(w[0][0], w[0][1], w[1][0], w[1][1]);
 } }
    }
};
struct DownEpi {
    static constexpr bool PERM = true, AFTER_DRAIN = false, BADJ = false;
    unsigned char* Y; const float* bdn;
    __device__ __forceinline__ void operator()(AccRef acc, const Unit& u, int wr, int wc, int fr, int fq) const {
        const int cc = u.pn * 256 + wc * 32 + 8 * fq; const float* bp = bdn + (size_t)u.kind * DM + cc;
        unsigned char* b0 = Y + (size_t)(u.pm * 256 + (u.half == 2 ? 128 : 0) + wr * 64 + (fq & 1) * 16 + fr) * DM + u.pn * 256 + wc * 32 + 16 * (fq >> 1);
#pragma unroll
        for (int bj = 0; bj < 2; ++bj) { const pg8::f32x4 bv0 = *(const pg8::f32x4*)(bp + bj * 128) * S_Y, bv1 = *(const pg8::f32x4*)(bp + bj * 128 + 4) * S_Y;
#pragma unroll
            for (int ai = 0; ai < 2; ++ai) { if (ai == 1 && u.half) break;
#pragma unroll
                for (int mp = 0; mp < 2; ++mp) { unsigned w[2][2];
#pragma unroll
                    for (int mm = 0; mm < 2; ++mm) { const int m = 2 * mp + mm;
                        const pg8::f32x4 v0 = acc[ai][bj][m][0] * (S_Y / (S_W * S_G)) + bv0, v1 = acc[ai][bj][m][1] * (S_Y / (S_W * S_G)) + bv1;
                        w[mm][0] = pk4_fp8(v0[0], v0[1], v0[2], v0[3]); w[mm][1] = pk4_fp8(v1[0], v1[1], v1[2], v1[3]); }
                    *(pg8::u32x4*)(b0 + (size_t)(ai * 128 + mp * 32) * DM + bj * 128) = widen16(w[0][0], w[0][1], w[1][0], w[1][1]); } } }
    }
};

__device__ __forceinline__ void build_moe_tables(LAS unsigned char* lds, const int* BCNT, int nrb  , bool want_bb, int tid) {
    LAS int* tile_e = (LAS int*)(lds + TAB_OFF); LAS int* misc = tile_e + MAXT;
    LAS int* bb = (LAS int*)(lds + RING_OFF); LAS int* seg = bb + 256 * NE;
    __syncthreads();
    for (int idx = tid; idx < nrb * NE; idx += NWAVES * 64) bb[idx] = BCNT[idx];
    __syncthreads();
    const int s16 = tid >> 5, e = tid & 31, per = nrb >> 4;
    { int run = 0; for (int q = 0; q < per; ++q) { const int bidx = (s16 * per + q) * NE + e; const int cc = bb[bidx]; bb[bidx] = run; run += cc; } seg[s16 * NE + e] = run; }
    __syncthreads();
    if (tid < NE) { int run = 0; for (int q = 0; q < 16; ++q) { const int t = seg[q * NE + tid]; seg[q * NE + tid] = run; run += t; } misc[8 + tid] = run; }
    __syncthreads();
    if (want_bb) { const int add = seg[s16 * NE + e]; for (int q = 0; q < per; ++q) bb[(s16 * per + q) * NE + e] += add; }
    if (tid == 0) { int off = 0; for (int e = 0; e < NE; ++e) { misc[40 + e] = off; off += ((misc[8 + e] + 255) >> 8) * 256; } misc[0] = off >> 8; }
    __syncthreads();
    for (int t = tid; t < MAXT; t += NWAVES * 64) { int ee = 0;
#pragma unroll 8
        for (int q = 1; q < NE; ++q) ee += ((misc[40 + q] >> 8) <= t) ? 1 : 0;
        tile_e[t] = ee; }
    __syncthreads();
}
struct AttnUnit { long qrow, kvrow; int h, nt; };
__device__ __forceinline__ bool attn_next(int i, int G, int vcu, bool l0, AttnUnit& u) {
    const int U = i * G + vcu, NU = 1024 + (l0 ? 128 : 0);
    if (U >= NU) return false;
    if (U < 1024) { const int bk = U >> 5, b = bk >> 1, kvh = bk & 1, hq = (U & 31) >> 3, qb = U & 7; u.h = kvh * 4 + hq; u.qrow = (long)b * SEQ + qb * 256; u.kvrow = (long)b * NKV; u.nt = NKV / 64; }
    else { const int q = U - 1024, b = q >> 3; u.h = q & 7; u.qrow = (long)NLAT + b * 256; u.kvrow = (long)b * NKV + SEQ; u.nt = CTXL / 64; }
    return true;
}

__global__ void __launch_bounds__(NWAVES * 64, 2) mk_fwd(Params Pk) {
    extern __shared__ __attribute__((aligned(16))) unsigned char lds_raw[];
    LAS unsigned char* lds0 = (LAS unsigned char*)lds_raw;
    volatile LAS unsigned* MISC = (volatile LAS unsigned*)(lds0 + MISC_OFF);
    const int tid0 = threadIdx.x; const int wave0 = __builtin_amdgcn_readfirstlane(tid0 >> 6);
    const int G0 = gridDim.x; const int bx0 = blockIdx.x;
    for (int u = tid0; u < 64; u += NWAVES * 64) MISC[u] = 0u;
    __syncthreads();
    XcdBarrier bar; bar.bar = (unsigned*)(Pk.ws + WS_CTL) + CW_BAR + Pk.li * XCD_BAR_WORDS; bar.x = 0; bar.st = nullptr;
    if (!MK_PER_PHASE) bar = xcd_barrier_post((unsigned*)(Pk.ws + WS_CTL) + CW_BAR + Pk.li * XCD_BAR_WORDS, MISC + 8);
    const int lo = Pk.ph_lo, hi = Pk.ph_hi;
#define IN(k) (lo <= (k) && (k) < hi)
#ifndef PROBE_MASK
#define PROBE_MASK 0ull
#endif
#if PROBE_MASK
#define REP(k) for (int rp_ = 0; rp_ < ((((unsigned long long)(PROBE_MASK) >> (k)) & 1ull) ? 2 : 1); ++rp_)
#else
#define REP(k)
#endif
#define SEAM(k) do { if (IN(k) && IN((k) + 1)) { XcdBarrier b2_ = bar; asm volatile("" : "+s"(b2_.bar)); xcd_barrier(b2_); } } while (0)
#define PH_BEGIN \
    const __attribute__((address_space(4))) Params* Pp_ = (const __attribute__((address_space(4))) Params*)__builtin_amdgcn_kernarg_segment_ptr(); asm volatile("" : "+s"(Pp_)); const __attribute__((address_space(4))) Params& P = *Pp_; \
    int wave = wave0; unsigned zero_ = 0u; asm volatile("" : "+s"(wave), "+s"(zero_)); const int lane = (int)__builtin_amdgcn_mbcnt_hi(~0u, __builtin_amdgcn_mbcnt_lo(~0u, zero_)); const int tid = wave * 64 + lane; (void)tid; \
    int G = G0, bx = bx0; asm volatile("" : "+s"(G), "+s"(bx)); const int vcu = (G % 8 == 0) ? (bx % 8) * (G / 8) + bx / 8 : bx; const int gw = vcu * NWAVES + wave, NGW = G * NWAVES; (void)NGW; \
    LAS unsigned char* lds = lds0; asm volatile("" : "+s"(lds)); \
    unsigned char* ws = P.ws; (void)lane; (void)gw; (void)ws; \
    bf16* WIN = (bf16*)(ws + WS_WIN); bf16* WOUT = (bf16*)(ws + WS_WOUT); bf16* WR = (bf16*)(ws + WS_WR); unsigned char* WGU = ws + WS_WGU; unsigned char* WDN = ws + WS_WDN; \
    float* WF = (float*)(ws + WS_WF); bf16* DFT = (bf16*)(ws + WS_DFT); bf16* DFTC = (bf16*)(ws + WS_DFTC); float* MOD = (float*)(ws + WS_MOD); float* ROPE = (float*)(ws + WS_ROPE); \
    float* XCTX = (float*)(ws + WS_XCTX); bf16* H = (bf16*)(ws + WS_H); bf16* F = (bf16*)(ws + WS_F); bf16* PA = (bf16*)(ws + WS_PA); bf16* FT = (bf16*)(ws + WS_FT); bf16* FTC = (bf16*)(ws + WS_FTC); \
    bf16* QB = (bf16*)(ws + WS_Q); bf16* KB = (bf16*)(ws + WS_K); bf16* VB = (bf16*)(ws + WS_V); bf16* CONV = (bf16*)(ws + WS_CONV); bf16* OB = (bf16*)(ws + WS_O); bf16* YF = (bf16*)(ws + WS_YF); \
    bf16* MERGED = (bf16*)(ws + WS_MERGED); bf16* MIX = (bf16*)(ws + WS_MIX); float* LOG = (float*)(ws + WS_LOG); \
    int* EID = (int*)(ws + WS_EID); float* WTS = (float*)(ws + WS_WT); int* POS = (int*)(ws + WS_POS); int* SLOT = (int*)(ws + WS_SLOT); int* BCNT = (int*)(ws + WS_BCNT); \
    bf16* XB = (bf16*)(ws + WS_XB); (void)XB; bf16* FTU = (bf16*)(ws + WS_FTU); bf16* FTUC = (bf16*)(ws + WS_FTUC); (void)FTU; (void)FTUC; int* ROWTOK = (int*)(ws + WS_XS); unsigned char* F8 = (unsigned char*)(ws + WS_F); unsigned char* GB = ws + WS_G; unsigned char* YB = ws + WS_Y; \
    (void)WIN; (void)WOUT; (void)WR; (void)WGU; (void)WDN; (void)WF; (void)DFT; (void)DFTC; (void)MOD; (void)ROPE; (void)XCTX; (void)H; (void)F; (void)PA; (void)FT; (void)FTC; (void)QB; (void)KB; (void)VB; \
    (void)CONV; (void)OB; (void)YF; (void)MERGED; (void)MIX; (void)LOG; (void)EID; (void)WTS; (void)POS; (void)SLOT; (void)BCNT; (void)ROWTOK; (void)F8; (void)F; (void)GB; (void)YB;

    REP(0) if (IN(0)) { PH_BEGIN
        for (int item = bx; item < 2 * 96; item += G) {
            const int l = item / 96, cb = item % 96;
            LAS float* sl = (LAS float*)(lds + RING_OFF); LAS float* part = sl + 17 * 1024;
            __syncthreads();
            for (int idx = tid; idx < 17 * 1024; idx += NWAVES * 64) { const int r = idx >> 10, k = idx & 1023; const float v = r < 16 ? P.c[r * 1024 + k] : P.c_ctx[k]; sl[idx] = v / (1.0f + __expf(-v)); }
            __syncthreads();
            float acc[17];
#pragma unroll
            for (int r = 0; r < 17; ++r) acc[r] = 0.f;
            const float* wp = P.w_mod + ((size_t)l * 1024 + wave * 128) * 6144 + cb * 64 + lane;
#pragma unroll 4
            for (int k = 0; k < 128; ++k) { const float wv = wp[(size_t)k * 6144];
#pragma unroll
                for (int r = 0; r < 17; ++r) acc[r] += sl[r * 1024 + wave * 128 + k] * wv; }
#pragma unroll
            for (int r = 0; r < 17; ++r) part[(wave * 17 + r) * 64 + lane] = acc[r];
            __syncthreads();
            for (int idx = tid; idx < 17 * 64; idx += NWAVES * 64) { const int r = idx >> 6, ln = idx & 63; float s = P.b_mod[l * 6144 + cb * 64 + ln];
#pragma unroll
                for (int w = 0; w < 8; ++w) s += part[(w * 17 + r) * 64 + ln];
                MOD[((size_t)l * 17 + r) * 6144 + cb * 64 + ln] = s; }
            __syncthreads();
        }
        {
            LAS float* tab = (LAS float*)(lds + RING_OFF + 65536);
            __syncthreads();
            if (tid < 64) { tab[tid] = cos_rev((float)tid * (1.0f / 64.0f)); tab[64 + tid] = sin_rev((float)tid * (1.0f / 64.0f)); }
            __syncthreads();
            LAS float* scr = (LAS float*)(lds + RING_OFF) + wave * 256;
            for (int item = gw; item < 2 * 1024; item += NGW) {
                const float* src = P.w_in + (size_t)item * INW + 1536;
                *(LAS f32x4*)(scr + lane * 4) = *(const f32x4*)(src + lane * 4);
                LDS_WAIT(); asm volatile("" ::: "memory");
                const int k2u = lane <= 32 ? lane : lane - 32, tb = lane <= 32 ? 0 : 64;
#pragma unroll
                for (int g = 0; g < 4; ++g) { float s = 0.f;
#pragma unroll 8
                    for (int cidx = 0; cidx < 64; ++cidx) s += scr[g * 64 + cidx] * tab[tb + ((k2u * cidx) & 63)];
                    WF[(size_t)item * 256 + g * 64 + lane] = s; }
                LDS_WAIT(); asm volatile("" ::: "memory");
            }
            __syncthreads();
        }
        {
            LAS float* scr = (LAS float*)(lds + RING_OFF + wave * 16640);
            constexpr int I_IN = 16 * 24, I_OUT = 16 * 16, I_GU = 32 * 16 * 32, I_DN = 32 * 16 * 16, I_L = I_IN + I_OUT + I_GU + I_DN;
            for (int it = gw; it < 2 * I_L; it += NGW) {
                const int l = it / I_L; int r = it % I_L;
                if (r < I_IN) { const int kb = r / 24, nb = r % 24, n0 = nb * 64; unsigned char* WIN8 = (unsigned char*)(WIN + (size_t)WINR * 1024);
                    if (n0 < 1024) { if (l == 0) tr_item(P.w_in, INW, kb * 64, n0, WIN, 1024, n0, scr, lane); else tr_item8(P.w_in + (size_t)1024 * INW, INW, kb * 64, n0, WIN8, 1024, n0, S_W, scr, lane); }
                    else {
                        const bool isc_ = n0 < 1280; const int x0 = n0 - (isc_ ? 1024 : 1280), tl = 4 + (x0 >> 7), w0 = (x0 & 127) >> 5, add = isc_ ? 0 : 32;
                        if (l == 0) tr_item2(P.w_in, INW, kb * 64, n0, WIN, 1024, tl * 256 + w0 * 64 + add, tl * 256 + (w0 + 1) * 64 + add, scr, lane);
                        else tr_item2_8(P.w_in + (size_t)1024 * INW, INW, kb * 64, n0, WIN8, 1024, tl * 256 + w0 * 64 + add, tl * 256 + (w0 + 1) * 64 + add, S_W, scr, lane); }
                    continue; } r -= I_IN;
                if (r < I_OUT) { const int kb = r / 16, nb = r % 16;
                    if (l == 0) tr_item(P.w_out, 1024, kb * 64, nb * 64, WOUT, 1024, nb * 64, scr, lane);
                    else tr_item8(P.w_out + (size_t)1024 * 1024, 1024, kb * 64, nb * 64, (unsigned char*)(WOUT + (size_t)1024 * 1024), 1024, nb * 64, S_W, scr, lane);
                    continue; } r -= I_OUT;
                if (r < I_GU) { const int e = r / 512, q = r % 512, kb = q / 32, nb = q % 32, n0 = nb * 64;
                    const int drow = (n0 < 1024) ? (n0 >> 7) * 256 + (n0 & 127) : ((n0 - 1024) >> 7) * 256 + 128 + ((n0 - 1024) & 127);
                    tr_item8(P.w_gu + ((size_t)l * 32 + e) * 1024 * 2048, 2048, kb * 64, n0, WGU + ((size_t)l * 32 + e) * 2048 * 1024, 1024, drow, S_W, scr, lane); continue; } r -= I_GU;
                { const int e = r / 256, q = r % 256, kb = q / 16, nb = q % 16; tr_item8(P.w_dn + ((size_t)l * 32 + e) * 1024 * 1024, 1024, kb * 64, nb * 64, WDN + ((size_t)l * 32 + e) * 1024 * 1024, 1024, nb * 64, S_W, scr, lane); }
            }
        }
        for (int idx = bx * (NWAVES * 64) + tid; idx < 2 * 256 * 1024; idx += G * NWAVES * 64) {
            const int l = idx >> 18, rr = (idx >> 10) & 255, k = idx & 1023; unsigned short o = 0;
            if (rr < 64) { const float w = P.w_router[((size_t)l * 1024 + k) * 32 + (rr & 31)]; const unsigned h = pk2(w, 0.f) & 0xffffu; o = (unsigned short)h;
                if (rr >= 32) { const float lo_ = w - bflo(h); o = (unsigned short)(pk2(lo_, 0.f) & 0xffffu); } }
            WR[idx] = o;
        }
        {
            LAS float* ct = (LAS float*)(lds + RING_OFF); LAS float* st = ct + 2048;
            __syncthreads();
            for (int j = tid; j < 2048; j += NWAVES * 64) { ct[j] = cos_rev((float)j * (1.0f / 2048.0f)); st[j] = sin_rev((float)j * (1.0f / 2048.0f)); }
            __syncthreads();
            for (int q = bx * (NWAVES * 64) + tid; q < 1025 * 512; q += G * NWAVES * 64) { const int k1 = q >> 9, n8 = (q & 511) * 8; float v[8];
#pragma unroll
                for (int i = 0; i < 8; ++i) { const int n = n8 + i; v[i] = (n < 2048) ? ct[(k1 * n) & 2047] : -st[(k1 * (n - 2048)) & 2047]; }
                v4u o; o.x = pk2(v[0], v[1]); o.y = pk2(v[2], v[3]); o.z = pk2(v[4], v[5]); o.w = pk2(v[6], v[7]); *(v4u*)(DFT + (size_t)q * 8) = o; }
            for (int q = bx * (NWAVES * 64) + tid; q < 256 * 64; q += G * NWAVES * 64) { const int k1 = q >> 6, n8 = (q & 63) * 8; float v[8];
#pragma unroll
                for (int i = 0; i < 8; ++i) { const int n = n8 + i; v[i] = (n < 256) ? ct[((k1 * n) & 255) * 8] : -st[((k1 * (n - 256)) & 255) * 8]; }
                v4u o; o.x = pk2(v[0], v[1]); o.y = pk2(v[2], v[3]); o.z = pk2(v[4], v[5]); o.w = pk2(v[6], v[7]); *(v4u*)(DFTC + (size_t)q * 8) = o; }
            for (int q = bx * (NWAVES * 64) + tid; q < 64 * 16; q += G * NWAVES * 64) { const int pos = q >> 4, f = q & 15;
                const float inv = __builtin_amdgcn_exp2f(-(float)f * (13.287712379549449f / 16.0f)); const float rev = (float)pos * inv * 0.15915494309189535f;
                ROPE[q] = cos_rev(rev); ROPE[1024 + q] = sin_rev(rev); }
            __syncthreads();
        }
    }
    SEAM(0);
    REP(1) if (IN(1)) { PH_BEGIN
        LAS float* scr = (LAS float*)(lds + RING_OFF + wave * 16640);
        for (int it = gw; it < 2 * 64; it += NGW) { const int l = it >> 6, r = it & 63, kb = r >> 2, nb = r & 3;
            if (l == 0) tr_item(WF, 256, kb * 64, nb * 64, WIN, 1024, 1536 + nb * 64, scr, lane);
            else tr_item8(WF + (size_t)1024 * 256, 256, kb * 64, nb * 64, (unsigned char*)(WIN + (size_t)WINR * 1024), 1024, 1536 + nb * 64, S_W, scr, lane); }
        for (int row = gw; row < NTOK; row += NGW) { RowF xr; const int mr = row < NLAT ? (row >> 11) : 16;
            ld_row_f32(xr, row < NLAT ? P.x + (size_t)row * DM : P.ctx + (size_t)(row - NLAT) * DM, lane);
            const float* md = MOD + (size_t)mr * 6144;
            modulate_store(xr, P.g_pre_mix, md + 0 * DM, md + 1 * DM, H + (size_t)row * DM, lane); }
    }
    SEAM(1);

    for (int layer = 0; layer < 2; ++layer) {
        const int pb = 2 + 13 * layer;
        const bool l0 = (layer == 0);
        const int NR = l0 ? NTOK : NLAT;
        REP(pb + 0) if (IN(pb + 0)) { PH_BEGIN
            InprojSched S; S.init(G, bx, layer, H, WIN + (size_t)layer * WINR * 1024);
            LAS float* tab = (LAS float*)(lds + TAB_OFF);
            for (int i = tid; i < 2048; i += NWAVES * 64) tab[i] = ROPE[i];
            if (tid < 64) tab[2048 + tid] = P.g_q[layer * 64 + tid]; else if (tid < 128) tab[2048 + tid] = P.g_k[layer * 64 + tid - 64];
            LDS_WAIT(); __syncthreads();
            InprojEpi E{PA, FTU, FTUC, QB, KB, VB, tab, l0 ? 1.0f : 1.0f / S_W};
            if (l0) pg8::gemm_phase<InprojEpi, InprojSched, true, true>(lds + RING_OFF, 1024, S, E, wave);
            else pg8::gemm_phase<InprojEpi, InprojSched, true, true, true>(lds + RING_OFF, 512, S, E, wave);
        }
        SEAM(pb + 0);
        REP(pb + 2) if (IN(pb + 2)) { PH_BEGIN
            AttnUnit u;
            for (int i = 0; attn_next(i, G, vcu, l0, u); ++i)
                attn_body::attn_unit<8>(u.qrow, u.kvrow, u.h, u.nt, (const attn_body::bf16*)QB, (const attn_body::bf16*)KB, (const attn_body::bf16*)VB, (attn_body::bf16*)OB, (char*)lds_raw + RING_OFF, wave);
        }
        REP(pb + 3) if (IN(pb + 3)) { PH_BEGIN
            { FourierSchedT<false> S{G, bx, 256, (const char*)DFT, (const char*)FTU, (size_t)256 * 2048 * 2}; FourierEpi E{YF};
              pg8::gemm_phase<FourierEpi, FourierSchedT<false>, true, true>(lds + RING_OFF, 1024, S, E, wave, 4096); }
            {
                float* Y0 = (float*)(ws + WS_ROPE + 65536);
                for (int r = gw; r < NB * 256; r += NGW) { const bf16* src = FTU + (size_t)r * 2048; float s = 0.f;
#pragma unroll
                    for (int q = 0; q < 4; ++q) { const v4u w = *(const v4u*)(src + q * 512 + lane * 8); s += (bflo(w.x) + bfhi(w.x)) + (bflo(w.y) + bfhi(w.y)) + (bflo(w.z) + bfhi(w.z)) + (bflo(w.w) + bfhi(w.w)); }
                    s = wave_sum(s, lane); if (lane == 0) Y0[r] = s; } }
            if (l0) { __syncthreads();
              const int cctx = ((bx & 7) >= 4) ? (bx >> 3) * 4 + ((bx & 7) - 4) : G;
              FourierSchedT<true> S{G, cctx, 16, (const char*)DFTC, (const char*)FTC, (size_t)256 * 512 * 2}; FourierEpi E{YF};
              {
                  pg8::Unit u0;
                  for (int i0 = 0; S.next(i0, u0); ++i0) { const int b = u0.pn;
                      for (int it = wave; it < 512; it += NWAVES) { const int part = it & 1, ch = it >> 1, g = ch >> 6, k2 = ch & 63;
                          int u; unsigned flip = 0u; bool zero = false;
                          if (part == 0) u = g * 64 + (k2 <= 32 ? k2 : 64 - k2);
                          else { zero = (k2 == 0) | (k2 == 32); u = g * 64 + 32 + (k2 < 32 ? k2 : 64 - k2); if (k2 > 32) flip = 0x80008000u; if (zero) u = g * 64; }
                          if (lane < 32) { v4u w = *(const v4u*)(FTUC + ((size_t)b * 256 + u) * 256 + lane * 8); { const unsigned keep = zero ? 0u : ~0u; w.x = (w.x ^ flip) & keep; w.y = (w.y ^ flip) & keep; w.z = (w.z ^ flip) & keep; w.w = (w.w ^ flip) & keep; }
                              *(v4u*)(FTC + ((size_t)b * 256 + ch) * 512 + part * 256 + lane * 8) = w; } } }
                  VM_WAIT(); __syncthreads(); }
              pg8::gemm_phase<FourierEpi, FourierSchedT<true>, true, true>(lds + RING_OFF, 512, S, E, wave); }
        }
        SEAM(pb + 3);
        REP(pb + 4) if (IN(pb + 4)) { PH_BEGIN
            const float* gb = P.g_branch + layer * 1024; const float* cw = P.conv_w + layer * 3 * 256;
            struct MR { v4u wa; v2u wb, u0, u1, u2, y0, y1, y2, y3; };
            auto mrow = [](int row, int& t, int& len) { if (row < NLAT) { t = row & 2047; len = SEQ; } else { t = (row - NLAT) & 255; len = CTXL; } };
            auto issue = [=](int row, MR& r) { int t, len; mrow(row, t, len); const int ch = lane * 4;
                r.wa = *(const v4u*)(OB + (size_t)row * 512 + lane * 8);
                const bf16* pa = PA + (size_t)row * PAW; const bf16* pm = (t > 0) ? pa - PAW : pa; const bf16* pp = (t < len - 1) ? pa + PAW : pa;
                r.wb = *(const v2u*)(pa + 768 + ch); r.u1 = *(const v2u*)(pa + 1024 + ch); r.u0 = *(const v2u*)(pm + 1024 + ch); r.u2 = *(const v2u*)(pp + 1024 + ch);
                if (row >= NLAT) { r.y0 = *(const v2u*)(YF + YF_CTX + (size_t)(row - NLAT) * 256 + ch); r.y1 = r.y0; r.y2 = r.y0; r.y3 = r.y0; }
                else { const int bb_ = row >> 11, k1 = row & 2047; const int rr = (k1 == 0) ? 0 : (k1 <= 1024 ? k1 : 2048 - k1) - 1;
                    const bf16* p0 = YF + ((size_t)bb_ * 1024 + rr) * 256 + ch; const size_t pl = (size_t)NB * 1024 * 256;
                    r.y0 = *(const v2u*)p0; r.y1 = *(const v2u*)(p0 + pl); r.y2 = *(const v2u*)(p0 + 2 * pl); r.y3 = *(const v2u*)(p0 + 3 * pl); } };
            int row0 = gw;
            if (row0 < NR) {
                MR A; issue(row0, A);
                for (;;) {
                    const int row1 = row0 + NGW; const bool hB = row1 < NR; MR B = A; if (hB) issue(row1, B);
                    {   const int row = row0; int t, len; mrow(row, t, len); const int ch = lane * 4;
                        const v4u wa = A.wa;
                        float cv[4];
                        { const v2u wb = A.wb, w0 = A.u0, w1 = A.u1, w2 = A.u2;
                          const float m0 = (t > 0) ? 1.f : 0.f, m2 = (t < len - 1) ? 1.f : 0.f;
                          const f32x4 k0 = *(const f32x4*)(cw + ch) * m0, k1c = *(const f32x4*)(cw + 256 + ch), k2c = *(const f32x4*)(cw + 512 + ch) * m2;
                          const float gb2[4] = {bflo(wb.x), bfhi(wb.x), bflo(wb.y), bfhi(wb.y)};
                          const float u0[4] = {bflo(w0.x), bfhi(w0.x), bflo(w0.y), bfhi(w0.y)}, u1[4] = {bflo(w1.x), bfhi(w1.x), bflo(w1.y), bfhi(w1.y)}, u2[4] = {bflo(w2.x), bfhi(w2.x), bflo(w2.y), bfhi(w2.y)};
#pragma unroll
                          for (int i = 0; i < 4; ++i) cv[i] = gb2[i] * (u0[i] * k0[i] + u1[i] * k1c[i] + u2[i] * k2c[i]); }
                        f32x4 fy;
                        if (row >= NLAT) { const v2u w = A.y0; fy = (f32x4){bflo(w.x), bfhi(w.x), bflo(w.y), bfhi(w.y)}; }
                        else { const int bb_ = row >> 11, k1 = row & 2047;
                            if (k1 == 0) { const float* y0 = (const float*)(ws + WS_ROPE + 65536) + bb_ * 256 + (lane >> 4) * 64; const int k2a = (lane & 15) * 4;
#pragma unroll
                                for (int i = 0; i < 4; ++i) { const int kk = k2a + i; fy[i] = y0[kk <= 32 ? kk : 64 - kk]; } }
                            else { const float sg = k1 <= 1024 ? 1.f : -1.f; const v2u w0 = A.y0, w1 = A.y1, w2 = A.y2, w3 = A.y3;
                                const int k2a = (lane & 15) * 4; f32x4 ss;
#pragma unroll
                                for (int i = 0; i < 4; ++i) { const int kk = k2a + i; ss[i] = ((kk & 31) == 0) ? 0.f : (kk > 32 ? -sg : sg); }
                                fy = ((f32x4){bflo(w0.x), bfhi(w0.x), bflo(w0.y), bfhi(w0.y)} + (f32x4){bflo(w1.x), bfhi(w1.x), bflo(w1.y), bfhi(w1.y)}) + ((f32x4){bflo(w2.x), bfhi(w2.x), bflo(w2.y), bfhi(w2.y)} + (f32x4){bflo(w3.x), bfhi(w3.x), bflo(w3.y), bfhi(w3.y)}) * ss; } }
                        float a[8] = {bflo(wa.x), bfhi(wa.x), bflo(wa.y), bfhi(wa.y), bflo(wa.z), bfhi(wa.z), bflo(wa.w), bfhi(wa.w)};
                        float fv[4] = {fy[0], fy[1], fy[2], fy[3]};
                        float sa = 0.f, sc = 0.f, sf = 0.f;
#pragma unroll
                        for (int i = 0; i < 8; ++i) sa += a[i] * a[i];
#pragma unroll
                        for (int i = 0; i < 4; ++i) { sc += cv[i] * cv[i]; sf += fv[i] * fv[i]; }
                        sa = wave_sum(sa, lane); sc = wave_sum(sc, lane); sf = wave_sum(sf, lane);
                        const float ra = rsq(sa * (1.0f / 512.0f) + EPS), rc = rsq(sc * (1.0f / 256.0f) + EPS), rf = rsq(sf * (1.0f / 256.0f) + EPS);
                        const f32x4 g0 = *(const f32x4*)(gb + lane * 8), g1 = *(const f32x4*)(gb + lane * 8 + 4), g2 = *(const f32x4*)(gb + 512 + lane * 4), g3 = *(const f32x4*)(gb + 768 + lane * 4);
                        if (l0) { bf16* mr = MERGED + (size_t)row * DM;
                        v4u oa; oa.x = pk2(a[0] * ra * g0[0], a[1] * ra * g0[1]); oa.y = pk2(a[2] * ra * g0[2], a[3] * ra * g0[3]); oa.z = pk2(a[4] * ra * g1[0], a[5] * ra * g1[1]); oa.w = pk2(a[6] * ra * g1[2], a[7] * ra * g1[3]);
                        *(v4u*)(mr + lane * 8) = oa;
                        v2u oc; oc.x = pk2(cv[0] * rc * g2[0], cv[1] * rc * g2[1]); oc.y = pk2(cv[2] * rc * g2[2], cv[3] * rc * g2[3]); *(v2u*)(mr + 512 + lane * 4) = oc;
                        v2u of; of.x = pk2(fv[0] * rf * g3[0], fv[1] * rf * g3[1]); of.y = pk2(fv[2] * rf * g3[2], fv[3] * rf * g3[3]); *(v2u*)(mr + 768 + lane * 4) = of; }
                        else { unsigned char* mr = (unsigned char*)MERGED + (size_t)row * DM;
                        v2u oa; oa.x = pk4_fp8(a[0] * ra * g0[0], a[1] * ra * g0[1], a[2] * ra * g0[2], a[3] * ra * g0[3]); oa.y = pk4_fp8(a[4] * ra * g1[0], a[5] * ra * g1[1], a[6] * ra * g1[2], a[7] * ra * g1[3]);
                        *(v2u*)(mr + lane * 8) = oa;
                        *(unsigned*)(mr + 512 + lane * 4) = pk4_fp8(cv[0] * rc * g2[0], cv[1] * rc * g2[1], cv[2] * rc * g2[2], cv[3] * rc * g2[3]);
                        *(unsigned*)(mr + 768 + lane * 4) = pk4_fp8(fv[0] * rf * g3[0], fv[1] * rf * g3[1], fv[2] * rf * g3[2], fv[3] * rf * g3[3]); }
                    }
                    if (!hB) break;
                    row0 = row1; A = B;
                }
            }
        }
        SEAM(pb + 4);
        REP(pb + 5) if (IN(pb + 5)) { PH_BEGIN
            if (l0) { CtxKSched S{G, bx, 256, (const char*)(MERGED + (size_t)NLAT * DM), (const char*)(WOUT + (size_t)layer * 1024 * 1024)}; CtxKEpi E{FT};
                pg8::gemm_phase<CtxKEpi, CtxKSched, true, true>(lds + RING_OFF, 256, S, E, wave, 1024); }
            if (l0) { PlainSched S{G, bx, 4, (NLAT / 256) * 4, (const char*)MERGED, (const char*)WOUT}; OutEpi E{MIX};
                pg8::gemm_phase<OutEpi, PlainSched, true, true>(lds + RING_OFF, 1024, S, E, wave); }
            else { PlainSched8 S{G, bx, 4, (NLAT / 256) * 4, (const char*)MERGED, (const char*)(WOUT + (size_t)1024 * 1024)}; OutEpi8 E{(unsigned char*)MIX};
                pg8::gemm_phase<OutEpi8, PlainSched8, true, true, true>(lds + RING_OFF, 512, S, E, wave); }
        }
        SEAM(pb + 5);
        REP(pb + 6) if (IN(pb + 6)) { PH_BEGIN
            typedef short bf16x8v __attribute__((ext_vector_type(8)));
            constexpr int FP = 2064;
            LAS unsigned char* Ft = lds + RING_OFF; LAS float* part = (LAS float*)(lds + RING_OFF + 36864);
            const bf16* wr = WR + (size_t)layer * 256 * 1024;
            bf16x8v Bf[4][4];
#pragma unroll
            for (int s = 0; s < 4; ++s)
#pragma unroll
                for (int nt = 0; nt < 4; ++nt) Bf[s][nt] = *(const bf16x8v*)(wr + (size_t)(16 * nt + (lane & 15)) * 1024 + 128 * wave + 32 * s + 8 * (lane >> 4));
            const float* gpm = P.g_post_mix + layer * DM; const float* gpf = P.g_pre_ffn + layer * DM;
            LAS float* LOGS = (LAS float*)(lds + RING_OFF + 73728);
            int kc = 0;
            for (int ci = bx; ci < NR / 16; ci += G, ++kc) {
#pragma unroll
                for (int rr = 0; rr < 2; ++rr) {
                    const int rl = 2 * wave + rr, row = 16 * ci + rl;
                    const bool isc = row >= NLAT; const float* md = MOD + (size_t)layer * 17 * 6144 + (size_t)(isc ? 16 : (row >> 11)) * 6144;
                    RowF mx, xr, gp, gt;
                    if (l0 && isc) { const bf16* mc = FT + (size_t)(row - NLAT) * DM; RowF t1, t2, t3; ld_row_bf16(mx, mc, lane); ld_row_bf16(t1, mc + (size_t)NCTX * DM, lane); ld_row_bf16(t2, mc + (size_t)2 * NCTX * DM, lane); ld_row_bf16(t3, mc + (size_t)3 * NCTX * DM, lane);
#pragma unroll
                        for (int jj = 0; jj < 4; ++jj) mx.v[jj] = (mx.v[jj] + t1.v[jj]) + (t2.v[jj] + t3.v[jj]); }
                    else if (l0) ld_row_bf16(mx, MIX + (size_t)row * DM, lane);
                    else { const unsigned* qm = (const unsigned*)((const unsigned char*)MIX + (size_t)row * DM) + lane;
#pragma unroll
                        for (int jj = 0; jj < 4; ++jj) { const unsigned w = qm[64 * jj]; const auto lo = __builtin_amdgcn_cvt_pk_f32_fp8((int)w, false), hi = __builtin_amdgcn_cvt_pk_f32_fp8((int)w, true);
                            mx.v[jj] = (f32x4){lo[0], lo[1], hi[0], hi[1]} * (1.0f / S_M); } }
                    if (l0) ld_row_f32(xr, isc ? P.ctx + (size_t)(row - NLAT) * DM : P.x + (size_t)row * DM, lane); else ld_row_bf16(xr, XB + (size_t)row * DM, lane);
                    ld_row_f32(gp, gpm, lane); ld_row_f32(gt, md + 2 * DM, lane);
                    const float rstd = rsq(row_ss(mx, lane) * (1.0f / DM) + EPS);
#pragma unroll
                    for (int jj = 0; jj < 4; ++jj) xr.v[jj] = xr.v[jj] + gt.v[jj] * (mx.v[jj] * rstd * gp.v[jj]);
                    st_row_bf16(XB + (size_t)row * DM, lane, xr);
                    const float rstd2 = rsq(row_ss(xr, lane) * (1.0f / DM) + EPS);
                    RowF gg, s1, s2; ld_row_f32(gg, gpf, lane); ld_row_f32(s1, md + 4 * DM, lane); ld_row_f32(s2, md + 3 * DM, lane);
                    unsigned* qf = (unsigned*)(F8 + (size_t)row * DM) + lane;
#pragma unroll
                    for (int jj = 0; jj < 4; ++jj) { const f32x4 o = xr.v[jj] * rstd2 * gg.v[jj] * (s1.v[jj] + 1.0f) + s2.v[jj];
                        v2u w; w.x = pk2(o[0], o[1]); w.y = pk2(o[2], o[3]); qf[64 * jj] = pk4_fp8(o[0], o[1], o[2], o[3]); *(LAS v2u*)(Ft + rl * FP + 8 * lane + 512 * jj) = w; }
                }
                LDS_WAIT(); __syncthreads();
                f32x4 acc[4];
#pragma unroll
                for (int nt = 0; nt < 4; ++nt) acc[nt] = (f32x4){0.f, 0.f, 0.f, 0.f};
#pragma unroll
                for (int s = 0; s < 4; ++s) { const bf16x8v a = *(const LAS bf16x8v*)(Ft + (lane & 15) * FP + (128 * wave + 32 * s + 8 * (lane >> 4)) * 2);
#pragma unroll
                    for (int nt = 0; nt < 4; ++nt) acc[nt] = __builtin_amdgcn_mfma_f32_16x16x32_bf16(a, Bf[s][nt], acc[nt], 0, 0, 0); }
#pragma unroll
                for (int nt = 0; nt < 4; ++nt)
#pragma unroll
                    for (int r = 0; r < 4; ++r) part[(wave * 16 + 4 * (lane >> 4) + r) * 64 + 16 * nt + (lane & 15)] = acc[nt][r];
                LDS_WAIT(); __syncthreads();
                { const int rowl = tid >> 5, e = tid & 31; float s = 0.f, s2 = 0.f;
#pragma unroll
                    for (int w = 0; w < 8; ++w) { s += part[(w * 16 + rowl) * 64 + e]; s2 += part[(w * 16 + rowl) * 64 + 32 + e]; }
                    LOGS[(kc * 16 + rowl) * 36 + e] = s + s2; }
                __syncthreads();
            }
        }
        REP(pb + 8) if (IN(pb + 8)) { PH_BEGIN
            __syncthreads();
            LAS int* wcnt = (LAS int*)(lds + RING_OFF);
            const float* br = P.b_router + layer * 32;
            {   const int nchunk = NR / 16, nck = (bx < nchunk) ? (nchunk - bx + G - 1) / G : 0;
                const bool valid = (tid >> 4) < nck; const int row = valid ? 16 * (bx + (tid >> 4) * G) + (tid & 15) : 0; const LAS float* Lr = (const LAS float*)(lds + RING_OFF + 73728) + (size_t)tid * 36;
                float lg[32];
#pragma unroll
                for (int q = 0; q < 8; ++q) { const f32x4 a = *(const LAS f32x4*)(Lr + 4 * q), bb = *(const f32x4*)(br + 4 * q);
#pragma unroll
                    for (int i = 0; i < 4; ++i) lg[4 * q + i] = a[i] + bb[i]; }
                int eb = 0; asm volatile("" : "+s"(eb));
                int ev[4]; float tv[4]; unsigned used = 0u;
#pragma unroll
                for (int k = 0; k < 4; ++k) { float best = -INFINITY; int bi = 0;
#pragma unroll
                    for (int e = 0; e < 32; ++e) { const bool free_ = !((used >> (e + eb)) & 1u); if (free_ && (lg[e] > best || (e == 0 && k == 0))) { best = lg[e]; bi = e + eb; } }
                    ev[k] = valid ? bi : -1; tv[k] = best; used |= 1u << bi; }
                float pw[4]; float sum = 0.f;
#pragma unroll
                for (int k = 0; k < 4; ++k) { pw[k] = __expf(tv[k] - tv[0]); sum += pw[k]; }
                const float rs = 1.0f / sum;
                int pos[4] = {0, 0, 0, 0};
                const unsigned long long ltm = (lane == 0) ? 0ull : (~0ull >> (64 - lane));
                __syncthreads();
#pragma clang loop unroll(disable)
                for (int e0_ = 0; e0_ < 32; ++e0_) { const int e = e0_ + eb; const bool sel = (ev[0] == e) | (ev[1] == e) | (ev[2] == e) | (ev[3] == e); const unsigned long long M = __builtin_amdgcn_ballot_w64(sel);
                    const int rk = __popcll(M & ltm);
#pragma unroll
                    for (int k = 0; k < 4; ++k) pos[k] = (ev[k] == e) ? rk : pos[k];
                    if (lane == 0) wcnt[wave * 32 + e] = __popcll(M); }
                __syncthreads();
#pragma unroll
                for (int k = 0; k < 4; ++k) { int add = 0; const int ek = valid ? ev[k] : 0; for (int w = 0; w < wave; ++w) add += wcnt[w * 32 + ek]; pos[k] += add; }
                if (tid < 32) { int s = 0;
#pragma unroll
                    for (int w = 0; w < 8; ++w) s += wcnt[w * 32 + tid];
                    BCNT[bx * 32 + tid] = s; }
                if (valid) { *(int4*)(EID + (size_t)row * 4) = make_int4(ev[0], ev[1], ev[2], ev[3]);
                    *(float4*)(WTS + (size_t)row * 4) = make_float4(pw[0] * rs, pw[1] * rs, pw[2] * rs, pw[3] * rs);
                    *(int4*)(POS + (size_t)row * 4) = make_int4(pos[0], pos[1], pos[2], pos[3]); }
                __syncthreads();
            }
        }
        SEAM(pb + 8);
        REP(pb + 9) if (IN(pb + 9)) { PH_BEGIN const LAS int* tile_e = (const LAS int*)(lds + TAB_OFF); const LAS int* tmisc = tile_e + MAXT;
            build_moe_tables(lds, BCNT, G, true, tid);
            const LAS int* bb = (const LAS int*)(lds + RING_OFF);
            for (int r16 = gw; r16 < NR / 16; r16 += NGW) {
                const int row = r16 * 16 + (lane >> 2); const size_t ix = (size_t)r16 * 64 + lane;
                const int e = EID[ix], pos = POS[ix];
                const int slot = tmisc[40 + e] + bb[(r16 % G) * 32 + e] + pos;
                SLOT[ix] = slot; ROWTOK[slot] = row;
            }
            for (int q = gw * 64 + lane; q < NE * 256; q += NGW * 64) { const int e = q >> 8, i = q & 255, tot = tmisc[8 + e], npad = ((tot + 255) & ~255) - tot;
                if (i < npad) ROWTOK[tmisc[40 + e] + tot + i] = 0; }
            __syncthreads();
        }
        SEAM(pb + 9);
        REP(pb + 10) if (IN(pb + 10)) { PH_BEGIN const LAS int* tile_e = (const LAS int*)(lds + TAB_OFF); const LAS int* tmisc = tile_e + MAXT;
            if (MK_PER_PHASE) build_moe_tables(lds, BCNT, G, false, tid);
            MoeSchedT<true> S{G, bx, 8, tmisc[0] * 8, tile_e, (const char*)F8, (const char*)(WGU + (size_t)layer * 32 * 2048 * 1024), (size_t)2048 * 1024, ROWTOK};
            SwigluEpi E{GB, P.b_gu + (size_t)layer * 32 * 2048};
            pg8::gemm_phase<SwigluEpi, MoeSchedT<true>, true, true, true>(lds + RING_OFF, 512, S, E, wave);
        }
        SEAM(pb + 10);
        REP(pb + 11) if (IN(pb + 11)) { PH_BEGIN const LAS int* tile_e = (const LAS int*)(lds + TAB_OFF); const LAS int* tmisc = tile_e + MAXT;
            if (MK_PER_PHASE) build_moe_tables(lds, BCNT, G, false, tid);
            MoeSchedT<false> S{G, bx, 4, tmisc[0] * 4, tile_e, (const char*)GB, (const char*)(WDN + (size_t)layer * 32 * 1024 * 1024), (size_t)1024 * 1024, ROWTOK};
            DownEpi E{YB, P.b_dn + (size_t)layer * 32 * 1024};
            pg8::gemm_phase<DownEpi, MoeSchedT<false>, true, true, true>(lds + RING_OFF, 512, S, E, wave);
        }
        SEAM(pb + 11);
        REP(pb + 12) if (IN(pb + 12)) { PH_BEGIN
            struct CRaw { unsigned y[4][4]; v2u x[4]; };
            auto issue = [=](int row, int sx, int sy, int sz, int sw, CRaw& r) {
                const unsigned* q0 = (const unsigned*)(YB + (size_t)sx * DM) + lane; const unsigned* q1 = (const unsigned*)(YB + (size_t)sy * DM) + lane;
                const unsigned* q2 = (const unsigned*)(YB + (size_t)sz * DM) + lane; const unsigned* q3 = (const unsigned*)(YB + (size_t)sw * DM) + lane; const v2u* qx = (const v2u*)(XB + (size_t)row * DM) + lane;
#pragma unroll
                for (int jj = 0; jj < 4; ++jj) { r.y[0][jj] = q0[64 * jj]; r.y[1][jj] = q1[64 * jj]; r.y[2][jj] = q2[64 * jj]; r.y[3][jj] = q3[64 * jj]; r.x[jj] = qx[64 * jj]; } };
            int row0 = gw;
            if (row0 < NR) {
                int4 slA = *(const int4*)(SLOT + (size_t)row0 * 4); float4 wtA = *(const float4*)(WTS + (size_t)row0 * 4);
                int row1 = row0 + NGW; int4 slB = slA; float4 wtB = wtA;
                if (row1 < NR) { slB = *(const int4*)(SLOT + (size_t)row1 * 4); wtB = *(const float4*)(WTS + (size_t)row1 * 4); }
                CRaw A; issue(row0, slA.x, slA.y, slA.z, slA.w, A);
                for (;;) {
                    const bool hB = row1 < NR; CRaw B = A; if (hB) issue(row1, slB.x, slB.y, slB.z, slB.w, B);
                    const int row2 = row1 + NGW; int4 slC = slB; float4 wtC = wtB;
                    if (row2 < NR) { slC = *(const int4*)(SLOT + (size_t)row2 * 4); wtC = *(const float4*)(WTS + (size_t)row2 * 4); }
                    {
                        const int row = row0; const bool isc = row >= NLAT; const float* md = MOD + (size_t)layer * 17 * 6144 + (size_t)(isc ? 16 : (row >> 11)) * 6144;
                        RowF y, xr;
#pragma unroll
                        for (int jj = 0; jj < 4; ++jj) { y.v[jj] = (f32x4){0.f, 0.f, 0.f, 0.f};
#pragma unroll
                            for (int kk = 0; kk < 4; ++kk) { const unsigned w = A.y[kk][jj]; const float wk = (kk == 0 ? wtA.x : kk == 1 ? wtA.y : kk == 2 ? wtA.z : wtA.w) * (1.0f / S_Y); const auto lo = __builtin_amdgcn_cvt_pk_f32_fp8((int)w, false), hi = __builtin_amdgcn_cvt_pk_f32_fp8((int)w, true); y.v[jj] += (f32x4){lo[0], lo[1], hi[0], hi[1]} * wk; }
                            const v2u wx = A.x[jj]; xr.v[jj] = (f32x4){bflo(wx.x), bfhi(wx.x), bflo(wx.y), bfhi(wx.y)}; }
                        const float rstd = rsq(row_ss(y, lane) * (1.0f / DM) + EPS);
                        RowF gp, gt; ld_row_f32(gp, P.g_post_ffn + layer * DM, lane); ld_row_f32(gt, md + 5 * DM, lane);
#pragma unroll
                        for (int jj = 0; jj < 4; ++jj) xr.v[jj] = xr.v[jj] + gt.v[jj] * (y.v[jj] * rstd * gp.v[jj]);
                        if (l0) st_row_bf16(XB + (size_t)row * DM, lane, xr); else st_row_f32(P.out + (size_t)row * DM, lane, xr);
                        if (l0) { const float* md1 = MOD + (size_t)(17 + (isc ? 16 : (row >> 11))) * 6144;
                            modulate_store8(xr, P.g_pre_mix + DM, md1 + 0 * DM, md1 + 1 * DM, (unsigned char*)H + (size_t)row * DM, lane); }
                    }
                    if (!hB) break;
                    row0 = row1; A = B; wtA = wtB; row1 = row2; slB = slC; wtB = wtC;
                }
            }
        }
        SEAM(pb + 12);
    }
#undef IN
#undef SEAM
}

extern "C" void kernel_launch(void* const* d_in, const int* in_sizes, int n_in, void* d_out, int out_size, void* d_ws, size_t ws_size, hipStream_t stream) {
    static int grid = 0;
    if (grid == 0) {
        if (n_in != 22 || out_size != NLAT * DM || ws_size < WS_END) { fprintf(stderr, "kernel_launch: unexpected shapes (n_in %d, out %d, ws %zu < %zu)\n", n_in, out_size, ws_size, (size_t)WS_END); grid = -1; return; }
        int dev = 0, cus = 0, per_cu = 0;
        if (hipGetDevice(&dev) != hipSuccess || hipDeviceGetAttribute(&cus, hipDeviceAttributeMultiprocessorCount, dev) != hipSuccess) { grid = -1; return; }
        if (hipFuncSetAttribute((const void*)mk_fwd, hipFuncAttributeMaxDynamicSharedMemorySize, LDS_BYTES) != hipSuccess) { fprintf(stderr, "kernel_launch: hipFuncSetAttribute failed\n"); grid = -1; return; }
        if (hipOccupancyMaxActiveBlocksPerMultiprocessor(&per_cu, (const void*)mk_fwd, NWAVES * 64, LDS_BYTES) != hipSuccess || per_cu < 1)
            fprintf(stderr, "kernel_launch: note: occupancy query reports %d workgroups per CU\n", per_cu);
        (void)hipGetLastError();
        grid = cus >= 256 ? 256 : (cus / 16) * 16;
        if (grid < 128) { fprintf(stderr, "kernel_launch: this kernel wants at least 128 CUs (found %d)\n", cus); grid = -1; return; }
    }
    if (grid < 0) return;
    if (hipMemsetAsync((char*)d_ws + WS_CTL, 0, CTL_ZERO_BYTES, stream) != hipSuccess) return;
    Params p{};
    const float** pp = (const float**)&p;
    for (int i = 0; i < 22; ++i) pp[i] = (const float*)d_in[i];
    p.out = (float*)d_out; p.ws = (unsigned char*)d_ws;
#if MK_PER_PHASE
    for (int ph = 0; ph < NPHASE; ++ph) { p.ph_lo = ph; p.ph_hi = ph + 1; p.li = 0; hipLaunchKernelGGL(mk_fwd, dim3(grid), dim3(NWAVES * 64), LDS_BYTES, stream, p); }
#else
    p.ph_lo = 0; p.ph_hi = NPHASE; p.li = 0;
    hipLaunchKernelGGL(mk_fwd, dim3(grid), dim3(NWAVES * 64), LDS_BYTES, stream, p);
#endif
}
```

```cpp
#include <hip/hip_runtime.h>
#include <hip/hip_bf16.h>
#include <cstdio>
#include <cstdint>
#include <cmath>
namespace pg8 {
#define PG8_LAS __attribute__((address_space(3)))
typedef unsigned short bf16_t;
typedef short bf16x8 __attribute__((ext_vector_type(8)));
typedef float f32x4 __attribute__((ext_vector_type(4)));
typedef unsigned u32x4 __attribute__((ext_vector_type(4)));
typedef int i32x4 __attribute__((ext_vector_type(4)));
constexpr int BM = 256, BK = 64, HALF = 128, HTB = HALF * BK * 2  , STAGE_BYTES = 8 * HTB, NXCD = 8;

__host__ __device__ __forceinline__ int lds_byte(int r, int c) { const int st = (r >> 4) * 2 + (c >> 5), rr = r & 15, cc = c & 31, ob = rr * 64 + cc * 2; return st * 1024 + (ob ^ (((ob >> 9) & 1) << 5)); }
__host__ __device__ __forceinline__ void stage_rc(int b, int& R, int& C) { const int st = b / 1024, sb = b % 1024, swz = sb ^ (((sb >> 9) & 1) << 5); R = (st >> 1) * 16 + swz / 64; C = (st & 1) * 32 + (swz % 64) / 2; }
__host__ __device__ __forceinline__ int perm32(int rho) { const int n = rho >> 4, i = rho & 15; return 8 * (i >> 2) + 4 * n + (i & 3); }

struct Unit { int pm, pn, kind; };
__device__ __forceinline__ bool list_index(int i, int G, int c, int nwg, int& w) {
    const long L = (long)i * G + c; if (L >= nwg) return false;
    const int q = nwg / NXCD, r = nwg % NXCD, xcd = (int)(L % NXCD), off = (int)(L / NXCD);
    w = (xcd < r ? xcd * (q + 1) : r * (q + 1) + (xcd - r) * q) + off; return true;
}
__device__ __forceinline__ unsigned cvt_pk_bf16(float lo, float hi) { unsigned r; asm volatile("v_cvt_pk_bf16_f32 %0, %1, %2" : "=v"(r) : "v"(lo), "v"(hi)); return r; }
__device__ __forceinline__ void store_tile_bf16(const f32x4 (&acc)[2][2][4][2], bf16_t* base, size_t ldc, int wr, int wc, int fr, int fq) {
    bf16_t* b0 = base + (size_t)(wr * 64 + fr) * ldc + wc * 32 + 8 * fq;
#pragma unroll
    for (int ai = 0; ai < 2; ++ai)
#pragma unroll
        for (int m = 0; m < 4; ++m) { bf16_t* rowp = b0 + (size_t)(ai * HALF + m * 16) * ldc;
#pragma unroll
            for (int bj = 0; bj < 2; ++bj) { const f32x4 v0 = acc[ai][bj][m][0], v1 = acc[ai][bj][m][1];
                u32x4 w; w.x = cvt_pk_bf16(v0[0], v0[1]); w.y = cvt_pk_bf16(v0[2], v0[3]); w.z = cvt_pk_bf16(v1[0], v1[1]); w.w = cvt_pk_bf16(v1[2], v1[3]);
                *(u32x4*)(rowp + bj * HALF) = w; } }
}
__device__ __forceinline__ void store_tile_bf16_adj_sc(const f32x4 (&acc)[2][2][4][2], bf16_t* base, size_t ldc, int wr, int wc, int fr, int fq, float sc) {
    bf16_t* b0 = base + (size_t)(wr * 64 + fr) * ldc + wc * 64 + 8 * fq;
#pragma unroll
    for (int ai = 0; ai < 2; ++ai)
#pragma unroll
        for (int m = 0; m < 4; ++m) { bf16_t* rowp = b0 + (size_t)(ai * HALF + m * 16) * ldc;
#pragma unroll
            for (int bj = 0; bj < 2; ++bj) { const f32x4 v0 = acc[ai][bj][m][0] * sc, v1 = acc[ai][bj][m][1] * sc;
                u32x4 w; w.x = cvt_pk_bf16(v0[0], v0[1]); w.y = cvt_pk_bf16(v0[2], v0[3]); w.z = cvt_pk_bf16(v1[0], v1[1]); w.w = cvt_pk_bf16(v1[2], v1[3]);
                *(u32x4*)(rowp + bj * 32) = w; } }
}
__device__ __forceinline__ void store_tile_bf16_sc(const f32x4 (&acc)[2][2][4][2], bf16_t* base, size_t ldc, int wr, int wc, int fr, int fq, float sc) {
    bf16_t* b0 = base + (size_t)(wr * 64 + fr) * ldc + wc * 32 + 8 * fq;
#pragma unroll
    for (int ai = 0; ai < 2; ++ai)
#pragma unroll
        for (int m = 0; m < 4; ++m) { bf16_t* rowp = b0 + (size_t)(ai * HALF + m * 16) * ldc;
#pragma unroll
            for (int bj = 0; bj < 2; ++bj) { const f32x4 v0 = acc[ai][bj][m][0] * sc, v1 = acc[ai][bj][m][1] * sc;
                u32x4 w; w.x = cvt_pk_bf16(v0[0], v0[1]); w.y = cvt_pk_bf16(v0[2], v0[3]); w.z = cvt_pk_bf16(v1[0], v1[1]); w.w = cvt_pk_bf16(v1[2], v1[3]);
                *(u32x4*)(rowp + bj * HALF) = w; } }
}
__device__ __forceinline__ void store_tile_bf16_adj(const f32x4 (&acc)[2][2][4][2], bf16_t* base, size_t ldc, int wr, int wc, int fr, int fq) {
    bf16_t* b0 = base + (size_t)(wr * 64 + fr) * ldc + wc * 64 + 8 * fq;
#pragma unroll
    for (int ai = 0; ai < 2; ++ai)
#pragma unroll
        for (int m = 0; m < 4; ++m) { bf16_t* rowp = b0 + (size_t)(ai * HALF + m * 16) * ldc;
#pragma unroll
            for (int bj = 0; bj < 2; ++bj) { const f32x4 v0 = acc[ai][bj][m][0], v1 = acc[ai][bj][m][1];
                u32x4 w; w.x = cvt_pk_bf16(v0[0], v0[1]); w.y = cvt_pk_bf16(v0[2], v0[3]); w.z = cvt_pk_bf16(v1[0], v1[1]); w.w = cvt_pk_bf16(v1[2], v1[3]);
                *(u32x4*)(rowp + bj * 32) = w; } }
}
template <class Epi, class Sched, bool ALIGN_EPI = false, bool SP2 = false, bool F8 = false>
__device__ __forceinline__ void gemm_phase(PG8_LAS unsigned char* lds, const int K_in, const Sched& S, const Epi& E, const int wid_in  , const int pitch_in = 0  ) {
    unsigned zero_ = 0u; asm volatile("" : "+s"(zero_)); const int lane_ = (int)__builtin_amdgcn_mbcnt_hi(~0u, __builtin_amdgcn_mbcnt_lo(~0u, zero_));
    const int wid = wid_in, lane = lane_, tid = wid * 64 + lane, wr = wid >> 2, wc = wid & 3, fr = lane & 15, fq = lane >> 4;
    int K = K_in; asm volatile("" : "+s"(K));
    const int nt = K / BK;
    int LD = pitch_in ? pitch_in : K_in; asm volatile("" : "+s"(LD));
    unsigned voffA[2], voffB[2];
#pragma unroll
    for (int i = 0; i < 2; ++i) { int R, C; stage_rc(tid * 16 + i * 8192, R, C); const int Rb = Epi::BADJ ? ((R >> 5) * 64 + perm32(R & 31)) : Epi::PERM ? ((R & ~31) + perm32(R & 31)) : R;
        voffA[i] = (unsigned)(R * LD + C) * 2u; voffB[i] = (unsigned)(Rb * LD + C) * 2u; }
    const size_t kstep = (size_t)(BK * 2);
    const size_t hstep = (size_t)HALF * LD * 2;
    constexpr bool GA = Sched::GATHER; constexpr unsigned TOK_OFF = 131072u;
    const size_t hstepA = GA ? (size_t)0 : hstep;
    unsigned vA[2][2];
#pragma unroll
    for (int h = 0; h < 2; ++h)
#pragma unroll
        for (int i = 0; i < 2; ++i) vA[h][i] = voffA[i];
    constexpr bool BG = Sched::BGATHER;
    static_assert(!(BG && Epi::BADJ), "computed B rows use the plain half split");
    const size_t hstepB0 = Epi::BADJ ? (size_t)32 * LD * 2 : hstep;
    const size_t hstepBv = BG ? (size_t)0 : hstepB0;
    unsigned vB[2][2];
#pragma unroll
    for (int h = 0; h < 2; ++h)
#pragma unroll
        for (int i = 0; i < 2; ++i) vB[h][i] = voffB[i];
#define PG8_BOFF(dst, unit, h_) do { unsigned zb_ = 0u; asm volatile("" : "+s"(zb_)); const int tb2_ = wid * 64 + (int)__builtin_amdgcn_mbcnt_hi(~0u, __builtin_amdgcn_mbcnt_lo(~0u, zb_)); \
        _Pragma("unroll") for (int i_ = 0; i_ < 2; ++i_) { int R_, C_; stage_rc(tb2_ * 16 + i_ * 8192, R_, C_); const int Rb_ = Epi::PERM ? ((R_ & ~31) + perm32(R_ & 31)) : R_; \
            dst[i_] = S.boff(unit, (h_) * 128 + Rb_) + (unsigned)C_ * 2u; } } while (0)
#define PG8_STAGE_BN(bufoff, gbase, h_) do { if constexpr (BG) { if (last) { unsigned tw_[2]; if (has_next) PG8_BOFF(tw_, nxt, h_); else PG8_BOFF(tw_, cur, h_); PG8_STAGE(bufoff, gbase, tw_); } else PG8_STAGE(bufoff, gbase, vB[h_]); } \
        else PG8_STAGE(bufoff, (gbase) + (h_) * hstepB0, voffB); } while (0)
#define PG8_TOKDMA(unit, bufi) do { if (wid < 4) { unsigned zt_ = 0u; asm volatile("" : "+s"(zt_)); const unsigned lt_ = __builtin_amdgcn_mbcnt_hi(~0u, __builtin_amdgcn_mbcnt_lo(~0u, zt_)) * 4u; \
        const char* tb_ = (const char*)S.tokptr(unit) + wid * 256; \
        asm volatile("s_mov_b32 m0, %2\n\ts_nop 0\n\tglobal_load_lds_dword %0, %1" :: "v"(lt_), "s"(tb_), "s"(ldsu + TOK_OFF + (unsigned)(bufi) * 1024u + (unsigned)wid * 256u) : "memory", "m0"); } } while (0)
#define PG8_TOKREADH(dst, bufi, h_) do { unsigned zr_ = 0u; asm volatile("" : "+s"(zr_)); const int tr_ = wid * 64 + (int)__builtin_amdgcn_mbcnt_hi(~0u, __builtin_amdgcn_mbcnt_lo(~0u, zr_)); \
        const PG8_LAS int* tk_ = (const PG8_LAS int*)(lds + TOK_OFF + (bufi) * 1024); \
        _Pragma("unroll") for (int i_ = 0; i_ < 2; ++i_) { int R_, C_; stage_rc(tr_ * 16 + i_ * 8192, R_, C_); dst[i_] = (unsigned)tk_[(h_) * 128 + R_] * (unsigned)(LD * 2) + (unsigned)C_ * 2u; } } while (0)
#define PG8_TOKREAD(dst, bufi) do { PG8_TOKREADH(dst[0], bufi, 0); PG8_TOKREADH(dst[1], bufi, 1); } while (0)
#define PG8_STAGE_AN(bufoff, gbase, h_) do { if constexpr (GA) { if (last) { unsigned tv_[2]; PG8_TOKREADH(tv_, has_next ? ((ui + 1) & 1) : (ui & 1), h_); PG8_STAGE(bufoff, gbase, tv_); } else PG8_STAGE(bufoff, gbase, vA[h_]); } \
        else PG8_STAGE(bufoff, (gbase) + (h_) * hstep, voffA); } while (0)
    const unsigned ldsu = (unsigned)(uintptr_t)lds;
    const unsigned ldsw = (unsigned)wid * 1024u;
    const int aoff = lds_byte(wr * 64 + fr, fq * 8), boff = lds_byte(wc * 32 + fr, fq * 8);
#define PG8_SA(b, h) (((b) * 2 + (h)) * HTB)
#define PG8_SB(b, h) ((4 + (b) * 2 + (h)) * HTB)
#define PG8_STAGE(bufoff, gbase, voff) do { const char* gb_ = (const char*)(gbase);     \
        _Pragma("unroll") for (int _i = 0; _i < 2; ++_i) \
        asm volatile("s_mov_b32 m0, %2\n\ts_nop 0\n\tglobal_load_lds_dwordx4 %0, %1" :: "v"((voff)[_i]), "s"(gb_), "s"(ldsu + (unsigned)((bufoff) + _i * 8192) + ldsw) : "memory", "m0"); } while (0)
#define PG8_LDA(dst, b, h) do { _Pragma("unroll") for (int m = 0; m < 4; ++m) _Pragma("unroll") for (int k = 0; k < 2; ++k) dst[m][k] = *(const PG8_LAS bf16x8*)(lds + PG8_SA(b, h) + aoff + m * 2048 + k * 1024); } while (0)
#define PG8_LDB(dst, b, h) do { _Pragma("unroll") for (int n = 0; n < 2; ++n) _Pragma("unroll") for (int k = 0; k < 2; ++k) dst[n][k] = *(const PG8_LAS bf16x8*)(lds + PG8_SB(b, h) + boff + n * 2048 + k * 1024); } while (0)
#define PG8_CAT8(X) __builtin_shufflevector(__builtin_bit_cast(i32x4, X[0]), __builtin_bit_cast(i32x4, X[1]), 0, 1, 2, 3, 4, 5, 6, 7)
#define PG8_MMA(ai, bj, At, Bt) do { __builtin_amdgcn_s_setprio(1); _Pragma("unroll") for (int m = 0; m < 4; ++m) _Pragma("unroll") for (int n = 0; n < 2; ++n) { \
        if constexpr (F8) acc[ai][bj][m][n] = __builtin_amdgcn_mfma_scale_f32_16x16x128_f8f6f4(PG8_CAT8(Bt[n]), PG8_CAT8(At[m]), acc[ai][bj][m][n], 0, 0, 0, 0, 0, 0); \
        else { _Pragma("unroll") for (int k = 0; k < 2; ++k) acc[ai][bj][m][n] = __builtin_amdgcn_mfma_f32_16x16x32_bf16(Bt[n][k], At[m][k], acc[ai][bj][m][n], 0, 0, 0); } } __builtin_amdgcn_s_setprio(0); } while (0)
#define PG8_MMA0(ai, bj, At, Bt) do { __builtin_amdgcn_s_setprio(1); _Pragma("unroll") for (int m = 0; m < 4; ++m) _Pragma("unroll") for (int n = 0; n < 2; ++n) { const f32x4 z4_ = (f32x4){0.f, 0.f, 0.f, 0.f}; \
        if constexpr (F8) acc[ai][bj][m][n] = __builtin_amdgcn_mfma_scale_f32_16x16x128_f8f6f4(PG8_CAT8(Bt[n]), PG8_CAT8(At[m]), z4_, 0, 0, 0, 0, 0, 0); \
        else { acc[ai][bj][m][n] = __builtin_amdgcn_mfma_f32_16x16x32_bf16(Bt[n][0], At[m][0], z4_, 0, 0, 0); acc[ai][bj][m][n] = __builtin_amdgcn_mfma_f32_16x16x32_bf16(Bt[n][1], At[m][1], acc[ai][bj][m][n], 0, 0, 0); } } __builtin_amdgcn_s_setprio(0); } while (0)
#define PG8_WAIT_V(n) asm volatile("s_waitcnt vmcnt(" #n ")" ::: "memory")
#define PG8_WAIT_L(n) asm volatile("s_waitcnt lgkmcnt(" #n ")" ::: "memory")
#define PG8_BAR __builtin_amdgcn_s_barrier()
#define PG8_SCHED __builtin_amdgcn_sched_barrier(0)
    Unit cur, nxt; int ui = 0;
    if (!S.next(0, cur)) return;
    static_assert(SP2, "the accumulators are only started from C = 0 in the two-super-phase loop");
    f32x4 acc[2][2][4][2];
    bf16x8 At[4][2], B0[2][2], B1[2][2];
    const char* cA = S.aptr(cur); const char* cB = S.bptr(cur);
    if constexpr (BG) { PG8_BOFF(vB[0], cur, 0); PG8_BOFF(vB[1], cur, 1); }
    if constexpr (GA) { PG8_TOKDMA(cur, 0); asm volatile("s_waitcnt vmcnt(0)" ::: "memory"); __builtin_amdgcn_s_barrier(); PG8_TOKREAD(vA, 0); }
    if constexpr (SP2) {
        PG8_STAGE(PG8_SB(0, 0), cB, vB[0]); PG8_STAGE(PG8_SB(0, 1), cB + hstepBv, vB[1]); PG8_STAGE(PG8_SA(0, 0), cA, vA[0]); PG8_STAGE(PG8_SA(0, 1), cA + hstepA, vA[1]);
        if (wr == 1) PG8_BAR;
        PG8_WAIT_V(2); PG8_BAR;
        PG8_STAGE(PG8_SB(1, 0), cB + kstep, vB[0]); PG8_STAGE(PG8_SA(1, 0), cA + kstep, vA[0]); PG8_STAGE(PG8_SB(1, 1), cB + hstepBv + kstep, vB[1]);
        PG8_WAIT_V(6); PG8_BAR;
    } else {
        PG8_STAGE(PG8_SB(0, 0), cB, voffB); PG8_STAGE(PG8_SA(0, 0), cA, voffA); PG8_STAGE(PG8_SB(0, 1), cB + hstep, voffB); PG8_STAGE(PG8_SA(0, 1), cA + hstep, voffA);
        if (wr == 1) PG8_BAR;
        PG8_WAIT_V(4); PG8_BAR;
        PG8_STAGE(PG8_SB(1, 0), cB + kstep, voffB); PG8_STAGE(PG8_SA(1, 0), cA + kstep, voffA); PG8_STAGE(PG8_SB(1, 1), cB + hstep + kstep, voffB);
        PG8_WAIT_V(6); PG8_BAR;
    }
    for (;;) {
        const bool has_next = S.next(ui + 1, nxt);
        const char* nA = has_next ? S.aptr(nxt) : cA; const char* nB = has_next ? S.bptr(nxt) : cB;
        if constexpr (GA) { if (has_next) PG8_TOKDMA(nxt, (ui + 1) & 1); }
#pragma clang loop unroll(disable)
        for (int t = 0; t < nt; t += 2) {
            const bool last = (t == nt - 2);
            const char* a1 = cA + (size_t)(t + 1) * kstep;
            const char* a2 = last ? nA : cA + (size_t)(t + 2) * kstep; const char* b2 = last ? nB : cB + (size_t)(t + 2) * kstep;
            const char* a3 = a2 + kstep; const char* b3 = b2 + kstep;
            if constexpr (SP2) {
            PG8_LDB(B0, 0, 0); PG8_LDB(B1, 0, 1); PG8_SCHED; PG8_LDA(At, 0, 0); PG8_STAGE(PG8_SA(1, 1), a1 + hstepA, vA[1]);
            PG8_WAIT_V(8); PG8_WAIT_L(0); PG8_BAR; if (t == 0) { PG8_MMA0(0, 0, At, B0); PG8_MMA0(0, 1, At, B1); } else { PG8_MMA(0, 0, At, B0); PG8_MMA(0, 1, At, B1); } PG8_BAR; PG8_SCHED;
            PG8_LDA(At, 0, 1); PG8_STAGE_BN(PG8_SB(0, 0), b2, 0); PG8_STAGE_BN(PG8_SB(0, 1), b2, 1); PG8_STAGE_AN(PG8_SA(0, 0), a2, 0);
            PG8_WAIT_V(8); PG8_WAIT_L(0); PG8_BAR; if (t == 0) { PG8_MMA0(1, 0, At, B0); PG8_MMA0(1, 1, At, B1); } else { PG8_MMA(1, 0, At, B0); PG8_MMA(1, 1, At, B1); } PG8_BAR; PG8_SCHED;
            PG8_LDB(B0, 1, 0); PG8_LDB(B1, 1, 1); PG8_SCHED; PG8_LDA(At, 1, 0); PG8_STAGE_AN(PG8_SA(0, 1), a2, 1);
            PG8_WAIT_V(8); PG8_WAIT_L(0); PG8_BAR; PG8_MMA(0, 0, At, B0); PG8_MMA(0, 1, At, B1); PG8_BAR; PG8_SCHED;
            PG8_LDA(At, 1, 1); PG8_STAGE_BN(PG8_SB(1, 0), b3, 0); PG8_STAGE_BN(PG8_SB(1, 1), b3, 1); PG8_STAGE_AN(PG8_SA(1, 0), a3, 0);
            PG8_WAIT_V(8); PG8_WAIT_L(0); PG8_BAR; PG8_MMA(1, 0, At, B0); PG8_MMA(1, 1, At, B1); PG8_BAR; PG8_SCHED;
            } else {
            PG8_LDB(B0, 0, 0); PG8_SCHED; PG8_LDA(At, 0, 0); PG8_STAGE(PG8_SA(1, 1), a1 + hstep, voffA);
            PG8_WAIT_L(8); PG8_BAR; PG8_WAIT_L(0); PG8_MMA(0, 0, At, B0); PG8_BAR; PG8_SCHED;
            PG8_LDB(B1, 0, 1); PG8_STAGE(PG8_SB(0, 0), b2, voffB);
            PG8_BAR; PG8_WAIT_L(0); PG8_MMA(0, 1, At, B1); PG8_BAR;
            PG8_LDA(At, 0, 1); PG8_STAGE(PG8_SA(0, 0), a2, voffA);
            PG8_BAR; PG8_WAIT_L(0); PG8_MMA(1, 0, At, B0); PG8_BAR; PG8_SCHED;
            PG8_STAGE(PG8_SB(0, 1), b2 + hstep, voffB);
            PG8_WAIT_V(6); PG8_BAR; PG8_MMA(1, 1, At, B1); PG8_BAR;
            PG8_LDB(B0, 1, 0); PG8_SCHED; PG8_LDA(At, 1, 0); PG8_STAGE(PG8_SA(0, 1), a2 + hstep, voffA);
            PG8_WAIT_L(8); PG8_BAR; PG8_WAIT_L(0); PG8_MMA(0, 0, At, B0); PG8_BAR; PG8_SCHED;
            PG8_LDB(B1, 1, 1); PG8_STAGE(PG8_SB(1, 0), b3, voffB);
            PG8_BAR; PG8_WAIT_L(0); PG8_MMA(0, 1, At, B1); PG8_BAR;
            PG8_LDA(At, 1, 1); PG8_STAGE(PG8_SA(1, 0), a3, voffA);
            PG8_BAR; PG8_WAIT_L(0); PG8_MMA(1, 0, At, B0); PG8_BAR; PG8_SCHED;
            PG8_STAGE(PG8_SB(1, 1), b3 + hstep, voffB);
            PG8_WAIT_V(6); PG8_BAR; PG8_MMA(1, 1, At, B1); PG8_BAR;
            }
        }
        if constexpr (ALIGN_EPI) { if (wr == 0) PG8_BAR; }
        if constexpr (!Epi::AFTER_DRAIN) { unsigned z2_ = 0u; asm volatile("" : "+s"(z2_)); const int l2_ = (int)__builtin_amdgcn_mbcnt_hi(~0u, __builtin_amdgcn_mbcnt_lo(~0u, z2_)); const int fr_ = l2_ & 15, fq_ = l2_ >> 4;     E(acc, cur, wr, wc, fr_, fq_); }
        if (!has_next) break;
        cur = nxt; cA = nA; cB = nB; ++ui;
        if constexpr (GA) PG8_TOKREAD(vA, ui & 1);
        if constexpr (BG) { PG8_BOFF(vB[0], cur, 0); PG8_BOFF(vB[1], cur, 1); }
        if constexpr (ALIGN_EPI) { if (wr == 1) PG8_BAR; }
    }
    PG8_WAIT_V(0);
    if constexpr (!ALIGN_EPI) { if (wr == 0) PG8_BAR; }
    PG8_BAR;
    if constexpr (Epi::AFTER_DRAIN) { E.fused(acc, cur, wr, wc, fr, fq, lds, wid, lane); }
#undef PG8_SA
#undef PG8_SB
#undef PG8_STAGE
#undef PG8_TOKDMA
#undef PG8_TOKREAD
#undef PG8_BOFF
#undef PG8_STAGE_BN
#undef PG8_TOKREADH
#undef PG8_STAGE_AN
#undef PG8_LDA
#undef PG8_LDB
#undef PG8_MMA
#undef PG8_MMA0
#undef PG8_CAT8
#undef PG8_WAIT_V
#undef PG8_WAIT_L
#undef PG8_BAR
#undef PG8_SCHED
}
}

#include <hip/hip_bf16.h>
#include <cmath>
namespace attn_body {
using bf16=__hip_bfloat16;
using bf16x8=__attribute__((ext_vector_type(8)))short;
using s16x4=__attribute__((ext_vector_type(4)))short;
using f32x16=__attribute__((ext_vector_type(16)))float;
using u32x4=__attribute__((ext_vector_type(4)))unsigned;
constexpr int D=64,QP=512,KP=128;
constexpr int NW=8,QBLK=32,QB=QBLK*NW,KVBLK=64;
__device__ __forceinline__ int crow(int r,int hi){return (r&3)+8*(r>>2)+4*hi;}
#define SBAR() __builtin_amdgcn_sched_barrier(0)
__device__ __forceinline__ void cmask(f32x16&p0,f32x16&p1,int jb,int qrel,int hi){
  const float NEG=-INFINITY; int kb=64*jb+4*hi;
  #pragma unroll
  for(int r=0;r<16;++r){int kv=kb+(r&3)+8*(r>>2); if(kv>qrel)p0[r]=NEG; if(kv+32>qrel)p1[r]=NEG;}
}

constexpr int NSLOT=3, SLOTB=8192;
constexpr int LDS_K=0, LDS_V=NSLOT*SLOTB, LDS_WS=2*NSLOT*SLOTB, LDS_OST=LDS_WS+NW*64*4, LDS_BYTES=LDS_OST+NW*4096;
constexpr float C2=0.125f*1.4426950408889634f;
__device__ __forceinline__ void glds16(const void*gsrc,unsigned lds_dst){unsigned keep;
  asm volatile("s_mov_b32 %0, m0\n\ts_mov_b32 m0, %2\n\ts_nop 0\n\tglobal_load_lds_dwordx4 %1, off\n\ts_mov_b32 m0, %0":"=&s"(keep):"v"(gsrc),"s"(lds_dst):"memory");}
__device__ __forceinline__ float max3f(float a,float b,float c){float r;asm("v_max3_f32 %0, %1, %2, %3":"=v"(r):"v"(a),"v"(b),"v"(c));return r;}
__device__ __forceinline__ float max2f(float a,float b){float r;asm("v_max_f32_e32 %0, %1, %2":"=v"(r):"v"(a),"v"(b));return r;}
__device__ __forceinline__ float fadd_s(float a,float b){float r;asm("v_add_f32_e32 %0, %1, %2":"=v"(r):"v"(a),"v"(b));return r;}
__device__ __forceinline__ float fsub_s(float a,float b){float r;asm("v_sub_f32_e32 %0, %1, %2":"=v"(r):"v"(a),"v"(b));return r;}
typedef float f32x2_t __attribute__((ext_vector_type(2))); typedef __bf16 bf16x2_t __attribute__((ext_vector_type(2)));
__device__ __forceinline__ unsigned cvtpk_s(float lo,float hi){f32x2_t v={lo,hi};bf16x2_t b=__builtin_convertvector(v,bf16x2_t);return __builtin_bit_cast(unsigned,b);}
#define WAIT_BAR(N) asm volatile("s_waitcnt vmcnt(" #N ") lgkmcnt(0)\n\ts_barrier":::"memory")

__device__ __forceinline__ void qkt(f32x16&p0,f32x16&p1,const char*Kslot,const bf16x8*qr,const f32x16&negm,int r32,int hi){
  const char*kb=Kslot+hi*1024+r32*16;
  #pragma unroll
  for(int d0=0;d0<4;++d0){
    const bf16x8 b0=*reinterpret_cast<const bf16x8*>(kb+d0*2048);
    const bf16x8 b1=*reinterpret_cast<const bf16x8*>(kb+d0*2048+512);
    if(d0==0){p0=__builtin_amdgcn_mfma_f32_32x32x16_bf16(b0,qr[0],negm,0,0,0);p1=__builtin_amdgcn_mfma_f32_32x32x16_bf16(b1,qr[0],negm,0,0,0);}
    else{p0=__builtin_amdgcn_mfma_f32_32x32x16_bf16(b0,qr[d0],p0,0,0,0);p1=__builtin_amdgcn_mfma_f32_32x32x16_bf16(b1,qr[d0],p1,0,0,0);}}
}
typedef __attribute__((address_space(3))) const char* lds_cptr;
typedef short v4i16_t __attribute__((ext_vector_type(4)));
__device__ __forceinline__ void kload8(bf16x8*kf,lds_cptr kp){
  kf[0]=*(const __attribute__((address_space(3))) bf16x8*)(kp);      kf[1]=*(const __attribute__((address_space(3))) bf16x8*)(kp+512);
  kf[2]=*(const __attribute__((address_space(3))) bf16x8*)(kp+2048); kf[3]=*(const __attribute__((address_space(3))) bf16x8*)(kp+2560);
  kf[4]=*(const __attribute__((address_space(3))) bf16x8*)(kp+4096); kf[5]=*(const __attribute__((address_space(3))) bf16x8*)(kp+4608);
  kf[6]=*(const __attribute__((address_space(3))) bf16x8*)(kp+6144); kf[7]=*(const __attribute__((address_space(3))) bf16x8*)(kp+6656);
}
__device__ __forceinline__ void kload2(bf16x8*kf,lds_cptr kp,int j){ kf[2*j]=*(const __attribute__((address_space(3))) bf16x8*)(kp+j*2048); kf[2*j+1]=*(const __attribute__((address_space(3))) bf16x8*)(kp+j*2048+512); }
__device__ __forceinline__ s16x4 vtr(lds_cptr p){ return __builtin_bit_cast(s16x4,__builtin_amdgcn_ds_read_tr16_b64_v4i16((__attribute__((address_space(3))) v4i16_t*)p)); }
__device__ __forceinline__ float rowmax(const f32x16&p0,const f32x16&p1){
  float a=max3f(p0[0],p0[1],p1[0]),b=max3f(p0[2],p0[3],p1[1]);a=max3f(a,p1[2],p1[3]);
  #pragma unroll
  for(int r=4;r<16;r+=4){a=max3f(a,p0[r],p0[r+1]);b=max3f(b,p0[r+2],p0[r+3]);a=max3f(a,p1[r],p1[r+1]);b=max3f(b,p1[r+2],p1[r+3]);}
  const float m=max2f(a,b);
  auto rr=__builtin_amdgcn_permlane32_swap(__float_as_uint(m),__float_as_uint(m),false,false);
  return max2f(__uint_as_float(rr[0]),__uint_as_float(rr[1]));
}
__device__ __forceinline__ void pv(f32x16*o,int vb,bf16x8 pa0,bf16x8 pa1,bf16x8 pa2,bf16x8 pa3){
  #pragma unroll
  for(int d0=0;d0<2;++d0){s16x4 lo[4],hi[4];
    #pragma unroll
    for(int ks=0;ks<4;++ks){
      asm volatile("ds_read_b64_tr_b16 %0,%1 offset:%c2":"=&v"(lo[ks]):"v"(vb),"i"(d0*4096+ks*1024):"memory");
      asm volatile("ds_read_b64_tr_b16 %0,%1 offset:%c2":"=&v"(hi[ks]):"v"(vb),"i"(d0*4096+ks*1024+512):"memory");}
    asm volatile("s_waitcnt lgkmcnt(0)":::"memory");SBAR();
    #define PK(k) (bf16x8){lo[k][0],lo[k][1],lo[k][2],lo[k][3],hi[k][0],hi[k][1],hi[k][2],hi[k][3]}
    o[d0]=__builtin_amdgcn_mfma_f32_32x32x16_bf16(pa0,PK(0),o[d0],0,0,0);
    o[d0]=__builtin_amdgcn_mfma_f32_32x32x16_bf16(pa1,PK(1),o[d0],0,0,0);
    o[d0]=__builtin_amdgcn_mfma_f32_32x32x16_bf16(pa2,PK(2),o[d0],0,0,0);
    o[d0]=__builtin_amdgcn_mfma_f32_32x32x16_bf16(pa3,PK(3),o[d0],0,0,0);
    #undef PK
  }
}

#ifndef ATTN_STORE16
#define ATTN_STORE16(p,v) (*(u32x4*)(p)=(v))
#endif
template<int THRL> __device__ __forceinline__ void attn_unit(long qrow0,long kvrow0,int h,int NT,const bf16*Q,const bf16*__restrict__ K,const bf16*__restrict__ V,bf16*O,char*shm,const int wid_in){
  unsigned zero_=0u; asm volatile("":"+s"(zero_)); const int lane_=(int)__builtin_amdgcn_mbcnt_hi(~0u,__builtin_amdgcn_mbcnt_lo(~0u,zero_));
  const int lane=lane_,r32=lane&31,hi=lane>>5; const int wid=wid_in;
  const bf16*Qw=Q+(qrow0+wid*QBLK)*QP+h*D;
  const bf16*Kh=K+kvrow0*KP+(h>>2)*D,*Vh=V+kvrow0*KP+(h>>2)*D;
  const unsigned lds0=(unsigned)(uintptr_t)shm;
  float*wsf=(float*)(shm+LDS_WS)+wid*64;
  const bf16*ksrc=Kh+(long)lane*KP+wid*8;
  const bf16*vsrc=Vh+(long)(16*(wid&3)+(lane>>2))*KP+(wid>>2)*32+(lane&3)*8;
  const unsigned kdst=lds0+LDS_K+wid*1024, vdst=lds0+LDS_V+wid*1024;
  #define DMA_K(t,slot) glds16(ksrc+(long)(t)*KVBLK*KP,(unsigned)__builtin_amdgcn_readfirstlane(kdst+(slot)))
  #define DMA_V(t,slot) glds16(vsrc+(long)(t)*KVBLK*KP,(unsigned)__builtin_amdgcn_readfirstlane(vdst+(slot)))
  const int vb0=(int)(lds0+LDS_V)+((lane>>4)&1)*32+(lane&3)*8+(4*hi+((lane&15)>>2))*64;
  const char*Kbase=shm+LDS_K; bf16x8 kf[8];
  const lds_cptr shm3=(lds_cptr)shm; const lds_cptr kp0=shm3+LDS_K+hi*1024+r32*16; const lds_cptr vp0=shm3+LDS_V+((lane>>4)&1)*32+(lane&3)*8+(4*hi+((lane&15)>>2))*64;
  DMA_K(0,0);DMA_V(0,0);DMA_K(1,SLOTB);
  bf16x8 qr[4];
  #pragma unroll
  for(int d0=0;d0<4;++d0)qr[d0]=*reinterpret_cast<const bf16x8*>(&Qw[(long)r32*QP+d0*16+hi*8]);
  float mhat=0.f,l_reg=0.f;f32x16 o[2];o[0]=f32x16{};o[1]=f32x16{};f32x16 negm=f32x16{};asm volatile("":"+v"(negm));
  #define CMASK(P0,P1,t) do{}while(0)
  bool resc=false;
  #define START(P0,P1) do{ const float rm=rowmax(P0,P1); resc=false; \
    { const float dl=rm; mhat=fadd_s(mhat,dl); \
      _Pragma("unroll") for(int r=0;r<16;++r){P0[r]=fsub_s(P0[r],dl);P1[r]=fsub_s(P1[r],dl);} \
      _Pragma("unroll") for(int r=0;r<16;++r)negm[r]=-mhat; asm volatile("":"+v"(negm)); } \
    _Pragma("unroll") for(int r=0;r<16;++r)P0[r]=__builtin_amdgcn_exp2f(P0[r]); }while(0)
  #define RESC() do{ if(resc){ asm volatile("s_waitcnt lgkmcnt(0)":::"memory"); \
      _Pragma("unroll") for(int d_=0;d_<2;++d_) _Pragma("unroll") for(int r=0;r<16;++r)o[d_][r]*=wsf[crow(r,hi)]; } }while(0)
  f32x16 pA0,pA1,pB0,pB1;
  int sl_prev=0,sl_cur=0,sl_next=SLOTB;
  #define ROT() do{sl_prev=sl_cur;sl_cur=sl_next;sl_next=(sl_next==(NSLOT-1)*SLOTB)?0:sl_next+SLOTB;}while(0)
  DMA_K(2,2*SLOTB);
  WAIT_BAR(3);
  qkt(pA0,pA1,Kbase,qr,negm,r32,hi);asm volatile("s_nop 15\n\ts_nop 7":"+v"(pA0),"+v"(pA1));CMASK(pA0,pA1,0);
  START(pA0,pA1);
  _Pragma("unroll") for(int r=0;r<16;++r)pA1[r]=__builtin_amdgcn_exp2f(pA1[r]);
  WAIT_BAR(0);
  DMA_K(3,0);DMA_V(1,SLOTB);
  ROT();
  kload8(kf,kp0+sl_cur);
  WAIT_BAR(2);
  s16x4 vlo[8],vhi[8]; u32x4 pw0,pw1,pw2,pw3;
  #define PKW(P,B) cvtpk_s(P[B],P[B+1])
  #define PAF(k) __builtin_bit_cast(bf16x8,pw##k)
  #define VFR(i) (bf16x8){vlo[i][0],vlo[i][1],vlo[i][2],vlo[i][3],vhi[i][0],vhi[i][1],vhi[i][2],vhi[i][3]}
  #define PIN(x) asm volatile("":"+v"(x))
  #define MX3(a,b,c) __builtin_fmaxf(__builtin_fmaxf((a),(b)),(c))
  #define GAPA(MF,A0,A1,A2,A3,W0,W1,PW) do{ MF; sacc+=A0; sacc+=A1; sacc+=A2; sacc+=A3; PIN(sacc); W0; W1; PIN(PW); SBAR(); }while(0)
  #define EX(v) __builtin_amdgcn_exp2f(v)
  #define GAPB(MF,X,B) do{ MF; X[B]=EX(X[B]); X[B+1]=EX(X[B+1]); X[B+2]=EX(X[B+2]); X[B+3]=EX(X[B+3]); PIN(X); SBAR(); }while(0)
  #define VRD(i) do{ vlo[i]=vtr(vp_+(((i)>>2)*4096+((i)&3)*1024)); vhi[i]=vtr(vp_+(((i)>>2)*4096+((i)&3)*1024+512)); }while(0)
  #define KRD(G,j) do{ if(G){ kload2(kf,kp0+sl_next,j); SBAR(); } }while(0)
  #define STEP(C0,C1,P0,P1,t,GK,GV,GL) do{ SBAR(); \
    const lds_cptr vp_=vp0+sl_prev; \
    VRD(0); SBAR(); float sacc=(P0[0]+P0[1]); \
    GAPA(C0=__builtin_amdgcn_mfma_f32_32x32x16_bf16(kf[0],qr[0],negm,0,0,0), P0[2],P0[3],P0[4],P0[5],     pw0[0]=PKW(P0,0), pw0[1]=PKW(P0,2), pw0); \
    VRD(4); SBAR(); GAPA(C1=__builtin_amdgcn_mfma_f32_32x32x16_bf16(kf[1],qr[0],negm,0,0,0), P0[6],P0[7],P0[8],P0[9],     pw0[2]=PKW(P0,4), pw0[3]=PKW(P0,6), pw0); \
    VRD(1); SBAR(); GAPA(C0=__builtin_amdgcn_mfma_f32_32x32x16_bf16(kf[2],qr[1],C0,0,0,0),   P0[10],P0[11],P0[12],P0[13], pw1[0]=PKW(P0,8), pw1[1]=PKW(P0,10), pw1); \
    VRD(5); SBAR(); GAPA(C1=__builtin_amdgcn_mfma_f32_32x32x16_bf16(kf[3],qr[1],C1,0,0,0),   P0[14],P0[15],P1[0],P1[1],   pw1[2]=PKW(P0,12),pw1[3]=PKW(P0,14), pw1); \
    VRD(2); SBAR(); GAPA(C0=__builtin_amdgcn_mfma_f32_32x32x16_bf16(kf[4],qr[2],C0,0,0,0),   P1[2],P1[3],P1[4],P1[5],     pw2[0]=PKW(P1,0), pw2[1]=PKW(P1,2), pw2); \
    VRD(6); SBAR(); GAPA(C1=__builtin_amdgcn_mfma_f32_32x32x16_bf16(kf[5],qr[2],C1,0,0,0),   P1[6],P1[7],P1[8],P1[9],     pw2[2]=PKW(P1,4), pw2[3]=PKW(P1,6), pw2); \
    VRD(3); SBAR(); GAPA(C0=__builtin_amdgcn_mfma_f32_32x32x16_bf16(kf[6],qr[3],C0,0,0,0),   P1[10],P1[11],P1[12],P1[13], pw3[0]=PKW(P1,8), pw3[1]=PKW(P1,10), pw3); \
    VRD(7); SBAR(); GAPA(C1=__builtin_amdgcn_mfma_f32_32x32x16_bf16(kf[7],qr[3],C1,0,0,0),   P1[14],P1[15],0.f,0.f,       pw3[2]=PKW(P1,12),pw3[3]=PKW(P1,14), pw3); \
    l_reg+=sacc; \
    if(GK){DMA_K((t)+3,sl_cur);} if(GV){DMA_V((t)+1,sl_next);} \
    CMASK(C0,C1,t); \
    { float a=MX3(C0[0],C0[1],C1[0]),b=MX3(C0[2],C0[3],C1[1]); a=MX3(a,C1[2],C1[3]); \
      _Pragma("unroll") for(int r=4;r<16;r+=4){a=MX3(a,C0[r],C0[r+1]);b=MX3(b,C0[r+2],C0[r+3]);a=MX3(a,C1[r],C1[r+1]);b=MX3(b,C1[r+2],C1[r+3]);} \
      float rm=__builtin_fmaxf(a,b); { auto rr=__builtin_amdgcn_permlane32_swap(__float_as_uint(rm),__float_as_uint(rm),false,false); rm=__builtin_fmaxf(__uint_as_float(rr[0]),__uint_as_float(rr[1])); } \
      resc=false; \
      if(__builtin_expect(__any(rm>(float)THRL),0)){ const float dl=__builtin_fmaxf(rm,0.f); mhat+=dl; \
        _Pragma("unroll") for(int r=0;r<16;++r){C0[r]-=dl;C1[r]-=dl;} \
        _Pragma("unroll") for(int r=0;r<16;++r)negm[r]=-mhat; asm volatile("":"+v"(negm)); \
        const float f=__builtin_amdgcn_exp2f(-dl); l_reg*=f; if(hi==0)wsf[r32]=f; resc=true; } } \
    SBAR(); \
    GAPB(o[0]=__builtin_amdgcn_mfma_f32_32x32x16_bf16(PAF(0),VFR(0),o[0],0,0,0), C0,0); \
    GAPB(o[1]=__builtin_amdgcn_mfma_f32_32x32x16_bf16(PAF(0),VFR(4),o[1],0,0,0), C0,4); \
    KRD(GL,0); GAPB(o[0]=__builtin_amdgcn_mfma_f32_32x32x16_bf16(PAF(1),VFR(1),o[0],0,0,0), C0,8); \
    KRD(GL,1); GAPB(o[1]=__builtin_amdgcn_mfma_f32_32x32x16_bf16(PAF(1),VFR(5),o[1],0,0,0), C0,12); \
    KRD(GL,2); GAPB(o[0]=__builtin_amdgcn_mfma_f32_32x32x16_bf16(PAF(2),VFR(2),o[0],0,0,0), C1,0); \
    KRD(GL,3); GAPB(o[1]=__builtin_amdgcn_mfma_f32_32x32x16_bf16(PAF(2),VFR(6),o[1],0,0,0), C1,4); \
    GAPB(o[0]=__builtin_amdgcn_mfma_f32_32x32x16_bf16(PAF(3),VFR(3),o[0],0,0,0), C1,8); \
    GAPB(o[1]=__builtin_amdgcn_mfma_f32_32x32x16_bf16(PAF(3),VFR(7),o[1],0,0,0), C1,12); \
    }while(0)
  int t=1;
  for(;t+5<NT;t+=2){
    STEP(pB0,pB1,pA0,pA1,t,true,true,true);     WAIT_BAR(2); RESC(); ROT();
    STEP(pA0,pA1,pB0,pB1,t+1,true,true,true);   WAIT_BAR(2); RESC(); ROT();
  }
  #define ENDW(tt) do{ if((tt)+3<NT){WAIT_BAR(2);} else if((tt)+2<NT){WAIT_BAR(1);} else {WAIT_BAR(0);} }while(0)
  for(;t+1<NT;t+=2){
    STEP(pB0,pB1,pA0,pA1,t,(t+3<NT),(t+1<NT),(t+1<NT));       ENDW(t);   RESC(); ROT();
    STEP(pA0,pA1,pB0,pB1,t+1,(t+4<NT),(t+2<NT),(t+2<NT));     ENDW(t+1); RESC(); ROT();
  }
  STEP(pB0,pB1,pA0,pA1,NT-1,false,false,false); RESC();
  { float sacc=pB0[0]+pB0[1]; _Pragma("unroll") for(int r=2;r<16;++r)sacc+=pB0[r]; _Pragma("unroll") for(int r=0;r<16;++r)sacc+=pB1[r]; l_reg+=sacc;
    pw0=(u32x4){PKW(pB0,0),PKW(pB0,2),PKW(pB0,4),PKW(pB0,6)};pw1=(u32x4){PKW(pB0,8),PKW(pB0,10),PKW(pB0,12),PKW(pB0,14)};pw2=(u32x4){PKW(pB1,0),PKW(pB1,2),PKW(pB1,4),PKW(pB1,6)};pw3=(u32x4){PKW(pB1,8),PKW(pB1,10),PKW(pB1,12),PKW(pB1,14)};
    SBAR(); pv(o,vb0+sl_cur,PAF(0),PAF(1),PAF(2),PAF(3)); }
  #undef PKW
  #undef PAF
  #undef VFR
  #undef PIN
  #undef MX3
  #undef GAPA
  #undef GAPB
  #undef EX
  #undef VRD
  #undef KRD
  #undef STEP
  #undef ENDW
  {auto rr=__builtin_amdgcn_permlane32_swap(__float_as_uint(l_reg),__float_as_uint(l_reg),false,false);l_reg=__uint_as_float(rr[0])+__uint_as_float(rr[1]);}
  if(hi==0)wsf[32+r32]=l_reg;asm volatile("s_waitcnt lgkmcnt(0)":::"memory");
  float rli[16];
  #pragma unroll
  for(int r=0;r<16;++r)rli[r]=__builtin_amdgcn_rcpf(wsf[32+crow(r,hi)]);
  bf16*Ow=O+(qrow0+wid*QBLK)*QP+h*D;
  { bf16*stg=(bf16*)(shm+LDS_OST)+wid*2048;
    #pragma unroll
    for(int r=0;r<16;++r){const int orow=crow(r,hi);
      #pragma unroll
      for(int d0=0;d0<2;++d0)stg[orow*64+d0*32+r32]=__float2bfloat16(o[d0][r]*rli[r]);}
    asm volatile("s_waitcnt lgkmcnt(0)":::"memory");
    #pragma unroll
    for(int i=0;i<4;++i){const int row=i*8+(lane>>3),ch=lane&7; const u32x4 v=*(const u32x4*)(stg+row*64+ch*8); ATTN_STORE16(Ow+(long)row*QP+ch*8,v);} }
  asm volatile("s_waitcnt lgkmcnt(0)\n\ts_barrier":::"memory");
  #undef DMA_K
  #undef DMA_V
  #undef CMASK
  #undef START
  #undef RESC
  #undef ROT
}
constexpr int ATTN_LDS_BYTES=LDS_BYTES;
#undef SBAR
#undef WAIT_BAR
}

constexpr int DM = 1024, NB = 16, SEQ = 2048, CTXL = 256, NLAT = NB * SEQ, NCTX = NB * CTXL, NTOK = NLAT + NCTX, NKV = SEQ + CTXL;
constexpr int INW = 1792, PAW = 1536, WINR = 2048, NMOD = 6;
constexpr int NE = 32, DFF = 1024, MAXT = 608, RBLK = 512, MAXRB = NTOK / RBLK;
constexpr float EPS = 1e-6f;
constexpr int NWAVES = 8;
#define PROBE_MASK 0ull
#ifndef MK_PER_PHASE
#define MK_PER_PHASE 0
#endif
constexpr int NPHASE = 2 + 13 * 2;

constexpr size_t MiB = 1u << 20;
constexpr size_t WS_CTL = 0, CTL_ZERO_BYTES = 1 * MiB;
constexpr size_t WS_WIN = 1 * MiB;
constexpr size_t WS_WOUT = WS_WIN + 8 * MiB;
constexpr size_t WS_WR = WS_WOUT + 4 * MiB;
constexpr size_t WS_WGU = WS_WR + 1 * MiB;
constexpr size_t WS_WDN = WS_WGU + 256 * MiB;
constexpr size_t WS_WF = WS_WDN + 128 * MiB;
constexpr size_t WS_DFT = WS_WF + 4 * MiB;
constexpr size_t WS_DFTC = WS_DFT + 16 * MiB;
constexpr size_t WS_MOD = WS_DFTC + 1 * MiB;
constexpr size_t WS_ROPE = WS_MOD + 1 * MiB;
constexpr size_t WS_XCTX = WS_ROPE + 1 * MiB;
constexpr size_t WS_H = WS_XCTX + 16 * MiB;
constexpr size_t WS_F = WS_H + 72 * MiB;
constexpr size_t WS_PA = WS_F + 72 * MiB;
constexpr size_t WS_FT = WS_PA + 108 * MiB;
constexpr size_t WS_FTC = WS_FT + 32 * MiB;
constexpr size_t WS_Q = WS_FTC + 4 * MiB;
constexpr size_t WS_K = WS_Q + 36 * MiB;
constexpr size_t WS_V = WS_K + 9 * MiB;
constexpr size_t WS_CONV = WS_V + 9 * MiB;
constexpr size_t WS_O = WS_CONV + 18 * MiB;
constexpr size_t WS_YF = WS_O + 36 * MiB;
constexpr size_t WS_MERGED = WS_YF + 36 * MiB;
constexpr size_t WS_MIX = WS_MERGED + 72 * MiB;
constexpr size_t WS_LOG = WS_MIX + 72 * MiB;
constexpr size_t WS_EID = WS_LOG + 9 * MiB;
constexpr size_t WS_WT = WS_EID + 1 * MiB;
constexpr size_t WS_POS = WS_WT + 1 * MiB;
constexpr size_t WS_SLOT = WS_POS + 1 * MiB;
constexpr size_t WS_BCNT = WS_SLOT + 1 * MiB;
constexpr size_t WS_XS = WS_BCNT + 1 * MiB;
constexpr size_t WS_G = WS_XS + 304 * MiB;
constexpr size_t WS_Y = WS_G + 304 * MiB;
constexpr size_t WS_XB = WS_Y + 304 * MiB;
constexpr size_t WS_FTU = WS_XB + 72 * MiB;
constexpr size_t WS_FTUC = WS_FTU + 16 * MiB;
constexpr size_t WS_END = WS_FTUC + 2 * MiB;
constexpr int CW_BAR = 4096;

constexpr int RING_OFF = 0, RING_BYTES = 131072;
constexpr int SCR_BYTES = 8 * 16640;
constexpr int TAB_OFF = 135168;
constexpr int MISC_OFF = 147456;
constexpr int LDS_BYTES = 151552;
static_assert(SCR_BYTES <= TAB_OFF && TAB_OFF + 4096 <= MISC_OFF && MISC_OFF + 256 <= LDS_BYTES, "LDS map");

#define GAS __attribute__((address_space(1)))
#define LAS __attribute__((address_space(3)))
typedef unsigned short bf16;
typedef unsigned v4u __attribute__((ext_vector_type(4)));
typedef unsigned v2u __attribute__((ext_vector_type(2)));
typedef float f32x4 __attribute__((ext_vector_type(4)));
#define LDS_WAIT() asm volatile("s_waitcnt lgkmcnt(0)" ::: "memory")
#define VM_WAIT() asm volatile("s_waitcnt vmcnt(0)" ::: "memory")
__device__ __forceinline__ unsigned pk2(float lo, float hi) { return pg8::cvt_pk_bf16(lo, hi); }
__device__ __forceinline__ unsigned pk4_fp8(float a, float b, float c, float d) { int w = __builtin_amdgcn_cvt_pk_fp8_f32(a, b, __float_as_int(a), false); w = __builtin_amdgcn_cvt_pk_fp8_f32(c, d, w, true); return (unsigned)w; }
constexpr float S_W = 256.0f, S_G = 4.0f, S_Y = 4.0f;
__device__ __forceinline__ float bflo(unsigned u) { return __uint_as_float(u << 16); }
__device__ __forceinline__ float bfhi(unsigned u) { return __uint_as_float(u & 0xffff0000u); }
__device__ __forceinline__ float shx(float v, int m, int lane) { return __int_as_float(__builtin_amdgcn_ds_bpermute((lane ^ m) << 2, __float_as_int(v))); }
__device__ __forceinline__ float wave_sum(float v, int lane) {
#pragma unroll
    for (int o = 1; o < 64; o <<= 1) v += shx(v, o, lane);
    return v;
}
__device__ __forceinline__ float rsq(float x) { return __builtin_amdgcn_rsqf(x); }
__device__ __forceinline__ float sin_rev(float x) { return __builtin_amdgcn_sinf(__builtin_amdgcn_fractf(x)); }
__device__ __forceinline__ float cos_rev(float x) { return __builtin_amdgcn_cosf(__builtin_amdgcn_fractf(x)); }

#define XB_TMO      128
#define XB_XCNT(j)  (256  + 64 * (j))
#define XB_XSUB(j)  (1280 + 64 * (j))
#define XB_XGEN(j)  (2304 + 64 * (j))
#define XB_TOP      3328
#define XB_TOPGEN   3392
#define XCD_BAR_WORDS 3456
#define XB_SPIN_CAP (1u << 18)

__device__ __forceinline__ unsigned xb_ld(unsigned* p)              { return __hip_atomic_load(p, __ATOMIC_RELAXED, __HIP_MEMORY_SCOPE_AGENT); }
__device__ __forceinline__ unsigned xb_add(unsigned* p, unsigned v) { return __hip_atomic_fetch_add(p, v, __ATOMIC_RELAXED, __HIP_MEMORY_SCOPE_AGENT); }
__device__ __forceinline__ unsigned xb_xcc_id() { return (unsigned)__builtin_amdgcn_s_getreg((3 << 11) | 20) & 0xFu; }
#define XB_SPIN(cond, bar) do { unsigned _sp = 0; while (cond) { __builtin_amdgcn_s_sleep(1); \
    if ((++_sp & 255u) == 0u) { if (xb_ld(&(bar)[XB_TMO])) break; if (_sp > XB_SPIN_CAP) { atomicAdd(&(bar)[XB_TMO], 1u); break; } } } } while (0)

struct XcdBarrier {
    unsigned* bar; unsigned x;
    volatile LAS unsigned* st;
};

__device__ __forceinline__ XcdBarrier xcd_barrier_post(unsigned* bar, volatile LAS unsigned* st) {
    XcdBarrier b; b.bar = bar; b.x = xb_xcc_id(); b.st = st;
    if (threadIdx.x == 0) (void)xb_add(&bar[XB_XCNT(b.x)], 1u);
    return b;
}
__device__ __forceinline__ void xcd_barrier_complete(unsigned* bar, unsigned x, unsigned& nloc, unsigned& nx) {
    const unsigned G = gridDim.x * gridDim.y * gridDim.z;
    unsigned sum, cnt, mine, sp = 0u;
    for (;;) {
        sum = 0u; cnt = 0u; mine = 0u;
#pragma unroll
        for (unsigned j = 0; j < 16; ++j) { const unsigned c = xb_ld(&bar[XB_XCNT(j)]); sum += c; cnt += (c > 0u) ? 1u : 0u; mine = (j == x) ? c : mine; }
        if (sum == G) break;
        __builtin_amdgcn_s_sleep(1);
        if ((++sp & 255u) == 0u) { if (xb_ld(&bar[XB_TMO])) break; if (sp > XB_SPIN_CAP) { atomicAdd(&bar[XB_TMO], 1u); break; } }
    }
    nloc = mine > 0u ? mine : 1u; nx = cnt > 0u ? cnt : 1u;
}

__device__ __forceinline__ void xcd_barrier(const XcdBarrier& b) {
    asm volatile("s_waitcnt vmcnt(0)" ::: "memory");
    __syncthreads();
    if (threadIdx.x == 0) {
        unsigned* bar = b.bar;
        __builtin_amdgcn_s_waitcnt(0);
        unsigned nloc = b.st[0], nx = b.st[1];
        if (nloc == 0u) { xcd_barrier_complete(bar, b.x, nloc, nx); b.st[0] = nloc; b.st[1] = nx; }
        const unsigned old = xb_add(&bar[XB_XSUB(b.x)], 1u);
        const unsigned gen = old / nloc;
        if (old + 1u == (gen + 1u) * nloc) {
            asm volatile("buffer_inv sc1" ::: "memory");
            __builtin_amdgcn_fence(__ATOMIC_RELEASE, "agent");
            asm volatile("s_waitcnt vmcnt(0)" ::: "memory");
            const unsigned og = xb_add(&bar[XB_TOP], 1u);
            const unsigned tg = og / nx;
            if (og + 1u == (tg + 1u) * nx) xb_add(&bar[XB_TOPGEN], 1u);
            else XB_SPIN(xb_ld(&bar[XB_TOPGEN]) == tg, bar);
            __builtin_amdgcn_fence(__ATOMIC_ACQUIRE, "workgroup");
            xb_add(&bar[XB_XGEN(b.x)], 1u);
            asm volatile("s_waitcnt vmcnt(0)" ::: "memory");
        } else {
            asm volatile("buffer_inv sc1" ::: "memory");
            XB_SPIN(xb_ld(&bar[XB_XGEN(b.x)]) == gen, bar);
            __builtin_amdgcn_fence(__ATOMIC_ACQUIRE, "workgroup");
            asm volatile("s_waitcnt vmcnt(0)" ::: "memory");
        }
    }
    __syncthreads();
}


struct RowF { f32x4 v[4]; };
__device__ __forceinline__ void ld_row_f32(RowF& r, const float* p, int lane) { const f32x4* q = (const f32x4*)p + lane;
#pragma unroll
    for (int j = 0; j < 4; ++j) r.v[j] = q[64 * j]; }
__device__ __forceinline__ void st_row_f32(float* p, int lane, const RowF& r) { f32x4* q = (f32x4*)p + lane;
#pragma unroll
    for (int j = 0; j < 4; ++j) q[64 * j] = r.v[j]; }
__device__ __forceinline__ void ld_row_bf16(RowF& r, const bf16* p, int lane) { const v2u* q = (const v2u*)p + lane;
#pragma unroll
    for (int j = 0; j < 4; ++j) { const v2u w = q[64 * j]; r.v[j] = (f32x4){bflo(w.x), bfhi(w.x), bflo(w.y), bfhi(w.y)}; } }
__device__ __forceinline__ void st_row_bf16(bf16* p, int lane, const RowF& r) { v2u* q = (v2u*)p + lane;
#pragma unroll
    for (int j = 0; j < 4; ++j) { v2u w; w.x = pk2(r.v[j][0], r.v[j][1]); w.y = pk2(r.v[j][2], r.v[j][3]); q[64 * j] = w; } }
__device__ __forceinline__ float row_ss(const RowF& r, int lane) { float s = 0.f;
#pragma unroll
    for (int j = 0; j < 4; ++j) s += (r.v[j][0] * r.v[j][0] + r.v[j][1] * r.v[j][1]) + (r.v[j][2] * r.v[j][2] + r.v[j][3] * r.v[j][3]);
    return wave_sum(s, lane); }
__device__ __forceinline__ void modulate_store8(const RowF& x, const float* g, const float* sh, const float* sc, unsigned char* dst, int lane) {
    const float rstd = rsq(row_ss(x, lane) * (1.0f / DM) + EPS);
    RowF gg, s1, s2; ld_row_f32(gg, g, lane); ld_row_f32(s1, sc, lane); ld_row_f32(s2, sh, lane);
    unsigned* q = (unsigned*)dst + lane;
#pragma unroll
    for (int j = 0; j < 4; ++j) { const f32x4 o = x.v[j] * rstd * gg.v[j] * (s1.v[j] + 1.0f) + s2.v[j]; q[64 * j] = pk4_fp8(o[0], o[1], o[2], o[3]); }
}
__device__ __forceinline__ void modulate_store(const RowF& x, const float* g, const float* sh, const float* sc, bf16* dst, int lane) {
    const float rstd = rsq(row_ss(x, lane) * (1.0f / DM) + EPS);
    RowF gg, s1, s2; ld_row_f32(gg, g, lane); ld_row_f32(s1, sc, lane); ld_row_f32(s2, sh, lane);
    RowF o;
#pragma unroll
    for (int j = 0; j < 4; ++j) o.v[j] = x.v[j] * rstd * gg.v[j] * (s1.v[j] + 1.0f) + s2.v[j];
    st_row_bf16(dst, lane, o);
}

struct Params {
    const float *x, *c, *ctx, *c_ctx, *w_mod, *b_mod, *g_pre_mix, *g_post_mix, *g_pre_ffn, *g_post_ffn, *w_in, *g_q, *g_k, *conv_w, *g_branch, *w_out,
                *w_router, *b_router, *w_gu, *b_gu, *w_dn, *b_dn;
    float* out; unsigned char* ws; int ph_lo, ph_hi, li, pad;
};

__device__ __forceinline__ void tr_item(const float* W, size_t ldw, int k0, int n0, bf16* WT, size_t ldt, int drow0, LAS float* scr, int lane) {
    const int lr = lane >> 4, lc = (lane & 15) * 4;
    f32x4 v[16];
#pragma unroll
    for (int i = 0; i < 16; ++i) v[i] = *(const f32x4*)(W + (size_t)(k0 + 4 * i + lr) * ldw + n0 + lc);
#pragma unroll
    for (int i = 0; i < 16; ++i) { LAS float* s = scr + (4 * i + lr) * 65 + lc; s[0] = v[i][0]; s[1] = v[i][1]; s[2] = v[i][2]; s[3] = v[i][3]; }
    LDS_WAIT(); asm volatile("" ::: "memory");
    const int c = lane & 7;
    const LAS float* s0 = scr + (8 * c) * 65 + (lane >> 3);
    float t[8][8];
#pragma unroll
    for (int j = 0; j < 8; ++j)
#pragma unroll
        for (int q = 0; q < 8; ++q) t[j][q] = s0[q * 65 + 8 * j];
    LDS_WAIT(); asm volatile("" ::: "memory");
#pragma unroll
    for (int j = 0; j < 8; ++j) { const int n = (lane >> 3) + 8 * j;
        v4u o; o.x = pk2(t[j][0], t[j][1]); o.y = pk2(t[j][2], t[j][3]); o.z = pk2(t[j][4], t[j][5]); o.w = pk2(t[j][6], t[j][7]);
        *(v4u*)(WT + (size_t)(drow0 + n) * ldt + k0 + 8 * c) = o; }
}

__device__ __forceinline__ void tr_item2(const float* W, size_t ldw, int k0, int n0, bf16* WT, size_t ldt, int drowA, int drowB, LAS float* scr, int lane) {
    const int lr = lane >> 4, lc = (lane & 15) * 4;
    f32x4 v[16];
#pragma unroll
    for (int i = 0; i < 16; ++i) v[i] = *(const f32x4*)(W + (size_t)(k0 + 4 * i + lr) * ldw + n0 + lc);
#pragma unroll
    for (int i = 0; i < 16; ++i) { LAS float* s = scr + (4 * i + lr) * 65 + lc; s[0] = v[i][0]; s[1] = v[i][1]; s[2] = v[i][2]; s[3] = v[i][3]; }
    LDS_WAIT(); asm volatile("" ::: "memory");
    const int c = lane & 7;
    const LAS float* s0 = scr + (8 * c) * 65 + (lane >> 3);
    float t[8][8];
#pragma unroll
    for (int j = 0; j < 8; ++j)
#pragma unroll
        for (int q = 0; q < 8; ++q) t[j][q] = s0[q * 65 + 8 * j];
    LDS_WAIT(); asm volatile("" ::: "memory");
#pragma unroll
    for (int j = 0; j < 8; ++j) { const int n = (lane >> 3) + 8 * j; const int row = (j < 4) ? drowA + n : drowB + n - 32;
        v4u o; o.x = pk2(t[j][0], t[j][1]); o.y = pk2(t[j][2], t[j][3]); o.z = pk2(t[j][4], t[j][5]); o.w = pk2(t[j][6], t[j][7]);
        *(v4u*)(WT + (size_t)row * ldt + k0 + 8 * c) = o; }
}

__device__ __forceinline__ void tr_item2_8(const float* W, size_t ldw, int k0, int n0, unsigned char* WT8, size_t ldt, int drowA, int drowB, float sc, LAS float* scr, int lane) {
    const int lr = lane >> 4, lc = (lane & 15) * 4;
    f32x4 v[16];
#pragma unroll
    for (int i = 0; i < 16; ++i) v[i] = *(const f32x4*)(W + (size_t)(k0 + 4 * i + lr) * ldw + n0 + lc);
#pragma unroll
    for (int i = 0; i < 16; ++i) { LAS float* s = scr + (4 * i + lr) * 65 + lc; s[0] = v[i][0] * sc; s[1] = v[i][1] * sc; s[2] = v[i][2] * sc; s[3] = v[i][3] * sc; }
    LDS_WAIT(); asm volatile("" ::: "memory");
    const int c = lane & 7;
    const LAS float* s0 = scr + (8 * c) * 65 + (lane >> 3);
    float t[8][8];
#pragma unroll
    for (int j = 0; j < 8; ++j)
#pragma unroll
        for (int q = 0; q < 8; ++q) t[j][q] = s0[q * 65 + 8 * j];
    LDS_WAIT(); asm volatile("" ::: "memory");
#pragma unroll
    for (int j = 0; j < 8; ++j) { const int n = (lane >> 3) + 8 * j; const int row = (j < 4) ? drowA + n : drowB + n - 32;
        v2u o; o.x = pk4_fp8(t[j][0], t[j][1], t[j][2], t[j][3]); o.y = pk4_fp8(t[j][4], t[j][5], t[j][6], t[j][7]);
        *(v2u*)(WT8 + (size_t)row * ldt + k0 + 8 * c) = o; }
}

__device__ __forceinline__ void tr_item8(const float* W, size_t ldw, int k0, int n0, unsigned char* WT8, size_t ldt, int drow0, float sc, LAS float* scr, int lane) {
    const int lr = lane >> 4, lc = (lane & 15) * 4;
    f32x4 v[16];
#pragma unroll
    for (int i = 0; i < 16; ++i) v[i] = *(const f32x4*)(W + (size_t)(k0 + 4 * i + lr) * ldw + n0 + lc);
#pragma unroll
    for (int i = 0; i < 16; ++i) { LAS float* s = scr + (4 * i + lr) * 65 + lc; s[0] = v[i][0] * sc; s[1] = v[i][1] * sc; s[2] = v[i][2] * sc; s[3] = v[i][3] * sc; }
    LDS_WAIT(); asm volatile("" ::: "memory");
    const int c = lane & 7;
    const LAS float* s0 = scr + (8 * c) * 65 + (lane >> 3);
    float t[8][8];
#pragma unroll
    for (int j = 0; j < 8; ++j)
#pragma unroll
        for (int q = 0; q < 8; ++q) t[j][q] = s0[q * 65 + 8 * j];
    LDS_WAIT(); asm volatile("" ::: "memory");
#pragma unroll
    for (int j = 0; j < 8; ++j) { const int n = (lane >> 3) + 8 * j;
        v2u o; o.x = pk4_fp8(t[j][0], t[j][1], t[j][2], t[j][3]); o.y = pk4_fp8(t[j][4], t[j][5], t[j][6], t[j][7]);
        *(v2u*)(WT8 + (size_t)(drow0 + n) * ldt + k0 + 8 * c) = o; }
}

using pg8::Unit; using pg8::bf16_t;
typedef const pg8::f32x4 (&AccRef)[2][2][4][2];
constexpr size_t TILE1K = (size_t)256 * 1024 * 2;
constexpr size_t TILE8 = (size_t)256 * 1024;

struct InprojSched {
    static constexpr bool GATHER = false, BGATHER = false;
    int G, c, layer, n0, n1, nwg; const char* H; const char* W; size_t tb;
    __device__ __forceinline__ void init(int G_, int c_, int layer_, const void* H_, const void* W_) { G = G_; c = c_; layer = layer_; H = (const char*)H_; W = (const char*)W_; tb = (layer_ == 0) ? TILE1K : TILE8;
        n0 = (layer == 0) ? 144 * 6 : 128 * 6; n1 = (layer == 0) ? 0 : 16; nwg = n0 + n1 + ((layer == 0) ? 144 : 128); }
    __device__ __forceinline__ bool next(int i, Unit& u) const { int w; if (!pg8::list_index(i, G, c, nwg, w)) return false;
        if (w < n0) { u.pm = w / 6; u.pn = w % 6; u.kind = 0; } else if (w < n0 + n1) { u.pm = 128 + (w - n0); u.pn = 2; u.kind = 0; } else { u.pm = 0; u.pn = w - n0 - n1; u.kind = 1; }
        return true; }
    __device__ __forceinline__ const char* aptr(const Unit& u) const { return u.kind == 0 ? H + (size_t)u.pm * tb : W + (size_t)(6 + u.pm) * tb; }
    __device__ __forceinline__ const char* bptr(const Unit& u) const { return u.kind == 0 ? W + (size_t)u.pn * tb : H + (size_t)u.pn * tb; }
};
struct InprojEpi {
    static constexpr bool PERM = true, AFTER_DRAIN = false, BADJ = true;
    bf16_t *PA, *FT, *FTC, *QB, *KB, *VB; const LAS float* tab; float sc;
    __device__ __forceinline__ void heads(AccRef acc, const Unit& u, int wr, int wc, int fr, int fq) const {
        const int lane = fq * 16 + fr; const bool isq = u.pn < 2, isv = (!isq) && wc >= 2, isc = u.pm >= NLAT / 256;
        const LAS float* gp = tab + 2048 + (isq ? 0 : 64) + fq * 8;
        const int tb = (fq & 1) * 8; const bool hi = (fq >> 1) != 0;
        const f32x4 gA0 = *(const LAS f32x4*)(gp), gA1 = *(const LAS f32x4*)(gp + 4), gB0 = *(const LAS f32x4*)(gp + 32), gB1 = *(const LAS f32x4*)(gp + 36);
#pragma unroll
        for (int ai = 0; ai < 2; ++ai)
#pragma unroll
            for (int m = 0; m < 4; ++m) { const int row = u.pm * 256 + ai * 128 + wr * 64 + m * 16 + fr;
                int bb, t; if (!isc) { bb = row >> 11; t = row & 2047; } else { const int r2 = row - NLAT; bb = r2 >> 8; t = r2 & 255; }
                const size_t kvrow = (size_t)bb * NKV + (isc ? SEQ + t : t);
                float x[2][8];
#pragma unroll
                for (int bj = 0; bj < 2; ++bj)
#pragma unroll
                    for (int n = 0; n < 2; ++n)
#pragma unroll
                        for (int i = 0; i < 4; ++i) x[bj][n * 4 + i] = acc[ai][bj][m][n][i] * sc;
                if (isv) {
#pragma unroll
                    for (int bj = 0; bj < 2; ++bj) { v4u ow; ow.x = pk2(x[bj][0], x[bj][1]); ow.y = pk2(x[bj][2], x[bj][3]); ow.z = pk2(x[bj][4], x[bj][5]); ow.w = pk2(x[bj][6], x[bj][7]);
                        *(v4u*)(VB + kvrow * 128 + (wc - 2) * 64 + bj * 32 + fq * 8) = ow; }
                } else {
                    float ss = 0.f;
#pragma unroll
                    for (int bj = 0; bj < 2; ++bj)
#pragma unroll
                        for (int c = 0; c < 8; ++c) ss += x[bj][c] * x[bj][c];
                    ss += shx(ss, 16, lane); ss += shx(ss, 32, lane);
                    const float rstd = rsq(ss * (1.0f / 64.0f) + EPS) * (isq ? attn_body::C2 : 1.0f);
#pragma unroll
                    for (int bj = 0; bj < 2; ++bj) { const int pos = bj ? (t & 63) : (t >> 6);
                        f32x4 c0 = *(const LAS f32x4*)(tab + pos * 16 + tb), c1 = *(const LAS f32x4*)(tab + pos * 16 + tb + 4), s0 = *(const LAS f32x4*)(tab + 1024 + pos * 16 + tb), s1 = *(const LAS f32x4*)(tab + 1024 + pos * 16 + tb + 4);
                        if (isc) { c0 = (f32x4){1.f, 1.f, 1.f, 1.f}; c1 = c0; s0 = (f32x4){0.f, 0.f, 0.f, 0.f}; s1 = s0; }
                        const f32x4 g0 = bj ? gB0 : gA0, g1 = bj ? gB1 : gA1;
                        float o[8];
#pragma unroll
                        for (int c = 0; c < 8; ++c) { const float xn = x[bj][c] * rstd * (c < 4 ? g0[c & 3] : g1[c & 3]); const float xp = shx(xn, 32, lane);
                            const float cs = c < 4 ? c0[c & 3] : c1[c & 3], sn = c < 4 ? s0[c & 3] : s1[c & 3]; o[c] = hi ? xn * cs + xp * sn : xn * cs - xp * sn; }
                        v4u ow; ow.x = pk2(o[0], o[1]); ow.y = pk2(o[2], o[3]); ow.z = pk2(o[4], o[5]); ow.w = pk2(o[6], o[7]);
                        if (isq) *(v4u*)(QB + (size_t)row * 512 + (u.pn * 4 + wc) * 64 + bj * 32 + fq * 8) = ow;
                        else *(v4u*)(KB + kvrow * 128 + wc * 64 + bj * 32 + fq * 8) = ow; }
                } }
    }
    __device__ __forceinline__ void operator()(AccRef acc, const Unit& u, int wr, int wc, int fr, int fq) const {
        if (u.kind == 0 && u.pn <= 2) { heads(acc, u, wr, wc, fr, fq); return; }
        if (u.kind == 0 && u.pn >= 4) {
            bf16_t* b0 = PA + (size_t)(u.pm * 256 + wr * 64 + fr) * PAW + 1024 + (u.pn - 4) * 128 + wc * 32 + 8 * fq;
#pragma unroll
            for (int ai = 0; ai < 2; ++ai)
#pragma unroll
                for (int m = 0; m < 4; ++m) { const pg8::f32x4 p0 = (acc[ai][0][m][0] * sc) * (acc[ai][1][m][0] * sc), p1 = (acc[ai][0][m][1] * sc) * (acc[ai][1][m][1] * sc);
                    v4u w; w.x = pk2(p0[0], p0[1]); w.y = pk2(p0[2], p0[3]); w.z = pk2(p1[0], p1[1]); w.w = pk2(p1[2], p1[3]);
                    *(v4u*)(b0 + (size_t)(ai * 128 + m * 16) * PAW) = w; }
            return; }
        bf16_t* base; size_t ldc;
        if (u.kind == 0) { base = PA + (size_t)u.pm * 256 * PAW + u.pn * 256; ldc = PAW; }
        else if (u.pn < 128) { const int b = u.pn >> 3, nn = (u.pn & 7) * 256; base = FT + (size_t)b * 256 * 2048 + nn; ldc = 2048; }
        else { const int b = u.pn - 128; base = FTC + (size_t)b * 256 * 256; ldc = 256; }
        pg8::store_tile_bf16_adj_sc(acc, base, ldc, wr, wc, fr, fq, sc);
    }
};
constexpr size_t YF_CTX = (size_t)4 * NB * 1024 * 256;
template <bool CTX> struct FourierSchedT {
    static constexpr bool GATHER = false, BGATHER = !CTX;
    int G, c, nwg; const char* A; const char* B; size_t tileb;
    __device__ __forceinline__ bool next(int i, Unit& u) const { int w; if (!pg8::list_index(i, G, c, nwg, w)) return false;
        if (CTX) { u.pm = 0; u.pn = w; u.kind = 4; } else { u.kind = w & 3; u.pm = (w >> 2) & 3; u.pn = w >> 4; } return true; }
    __device__ __forceinline__ const char* aptr(const Unit& u) const { return CTX ? A : A + ((size_t)(1 + 256 * u.pm) * 4096 + (size_t)u.kind * 1024) * 2; }
    __device__ __forceinline__ const char* bptr(const Unit& u) const { return CTX ? B + (size_t)u.pn * tileb : B + (size_t)u.pn * tileb + (size_t)(u.kind & 1) * 1024 * 2; }
    __device__ __forceinline__ unsigned boff(const Unit& u, int ch) const { const int g = ch >> 6, k2 = ch & 63;
        const int uu = (u.kind & 2) ? (((k2 & 31) == 0) ? g * 64 : g * 64 + 32 + (k2 < 32 ? k2 : 64 - k2)) : g * 64 + (k2 <= 32 ? k2 : 64 - k2);
        return (unsigned)uu * 4096u; }
};
struct FourierEpi {
    static constexpr bool PERM = true, AFTER_DRAIN = false, BADJ = false;
    bf16_t* YF;
    __device__ __forceinline__ void operator()(AccRef acc, const Unit& u, int wr, int wc, int fr, int fq) const {
        bf16_t* base = (u.kind == 4) ? YF + YF_CTX + (size_t)u.pn * 256 * 256 : YF + (((size_t)u.kind * NB + u.pn) * 1024 + u.pm * 256) * 256;
        pg8::store_tile_bf16(acc, base, 256, wr, wc, fr, fq);
    }
};
struct PlainSched {
    static constexpr bool GATHER = false, BGATHER = false;
    int G, c, nN, nwg; const char* A; const char* B;
    __device__ __forceinline__ bool next(int i, Unit& u) const { int w; if (!pg8::list_index(i, G, c, nwg, w)) return false; u.pm = w >> 2; u.pn = w & 3; u.kind = 0; return true; }
    __device__ __forceinline__ const char* aptr(const Unit& u) const { return A + (size_t)u.pm * TILE1K; }
    __device__ __forceinline__ const char* bptr(const Unit& u) const { return B + (size_t)u.pn * TILE1K; }
};
struct OutEpi {
    static constexpr bool PERM = true, AFTER_DRAIN = false, BADJ = false;
    bf16_t* MIX;
    __device__ __forceinline__ void operator()(AccRef acc, const Unit& u, int wr, int wc, int fr, int fq) const { pg8::store_tile_bf16(acc, MIX + (size_t)u.pm * 256 * DM + u.pn * 256, DM, wr, wc, fr, fq); }
};
struct CtxKSched {
    static constexpr bool GATHER = false, BGATHER = false;
    int G, c, nwg; const char* A; const char* B;
    __device__ __forceinline__ bool next(int i, Unit& u) const { int w; if (!pg8::list_index(i, G, c, nwg, w)) return false; u.kind = w & 3; u.pn = (w >> 2) & 3; u.pm = w >> 4; return true; }
    __device__ __forceinline__ const char* aptr(const Unit& u) const { return A + (size_t)u.pm * TILE1K + (size_t)u.kind * 256 * 2; }
    __device__ __forceinline__ const char* bptr(const Unit& u) const { return B + (size_t)u.pn * TILE1K + (size_t)u.kind * 256 * 2; }
};
struct CtxKEpi {
    static constexpr bool PERM = true, AFTER_DRAIN = false, BADJ = false;
    bf16_t* MIXC;
    __device__ __forceinline__ void operator()(AccRef acc, const Unit& u, int wr, int wc, int fr, int fq) const { pg8::store_tile_bf16(acc, MIXC + ((size_t)u.kind * NCTX + (size_t)u.pm * 256) * DM + u.pn * 256, DM, wr, wc, fr, fq); }
};
struct RouterEpi {
    static constexpr bool PERM = false, AFTER_DRAIN = false, BADJ = false;
    float* LOG;
    __device__ __forceinline__ void operator()(AccRef acc, const Unit& u, int wr, int wc, int fr, int fq) const {
        if (wc >= 2) return;
#pragma unroll
        for (int ai = 0; ai < 2; ++ai)
#pragma unroll
            for (int m = 0; m < 4; ++m) { float* rowp = LOG + (size_t)(u.pm * 256 + ai * 128 + wr * 64 + m * 16 + fr) * 64 + wc * 32 + 4 * fq;
#pragma unroll
                for (int n = 0; n < 2; ++n) *(pg8::f32x4*)(rowp + 16 * n) = acc[ai][0][m][n]; }
    }
};
template <bool GATHER_> struct MoeSchedT {
    static constexpr bool GATHER = GATHER_, BGATHER = false;
    int G, c, ncol, nwg; const LAS int* tile_e; const char* A; const char* W; size_t wstride; const int* rowtok;
    __device__ __forceinline__ bool next(int i, Unit& u) const { int w; if (!pg8::list_index(i, G, c, nwg, w)) return false; u.pm = (ncol == 8) ? (w >> 3) : (w >> 2); u.pn = w & (ncol - 1); u.kind = __builtin_amdgcn_readfirstlane(tile_e[u.pm]); return true; }
    __device__ __forceinline__ const char* aptr(const Unit& u) const { return GATHER_ ? A : A + (size_t)u.pm * TILE8; }
    __device__ __forceinline__ const char* bptr(const Unit& u) const { return W + (size_t)u.kind * wstride + (size_t)u.pn * TILE8; }
    __device__ __forceinline__ const int* tokptr(const Unit& u) const { return rowtok + (size_t)u.pm * 256; }
};
__device__ __forceinline__ pg8::u32x4 widen16(unsigned m0d0, unsigned m0d1, unsigned m1d0, unsigned m1d1) {
    const auto r0 = __builtin_amdgcn_permlane16_swap(m0d0, m1d0, false, false); const auto r1 = __builtin_amdgcn_permlane16_swap(m0d1, m1d1, false, false);
    return (pg8::u32x4){r0[0], r1[0], r0[1], r1[1]};
}
struct PlainSched8 {
    static constexpr bool GATHER = false, BGATHER = false;
    int G, c, nN, nwg; const char* A; const char* B;
    __device__ __forceinline__ bool next(int i, Unit& u) const { int w; if (!pg8::list_index(i, G, c, nwg, w)) return false; u.pm = w >> 2; u.pn = w & 3; u.kind = 0; return true; }
    __device__ __forceinline__ const char* aptr(const Unit& u) const { return A + (size_t)u.pm * TILE8; }
    __device__ __forceinline__ const char* bptr(const Unit& u) const { return B + (size_t)u.pn * TILE8; }
};
constexpr float S_M = 4.0f;
struct OutEpi8 {
    static constexpr bool PERM = true, AFTER_DRAIN = false, BADJ = false;
    unsigned char* MIX8;
    __device__ __forceinline__ void operator()(AccRef acc, const Unit& u, int wr, int wc, int fr, int fq) const {
        unsigned char* b0 = MIX8 + (size_t)(u.pm * 256 + wr * 64 + (fq & 1) * 16 + fr) * DM + u.pn * 256 + wc * 32 + 16 * (fq >> 1);
#pragma unroll
        for (int bj = 0; bj < 2; ++bj)
#pragma unroll
            for (int ai = 0; ai < 2; ++ai)
#pragma unroll
                for (int mp = 0; mp < 2; ++mp) { unsigned w[2][2];
#pragma unroll
                    for (int mm = 0; mm < 2; ++mm) { const int m = 2 * mp + mm;
                        const pg8::f32x4 v0 = acc[ai][bj][m][0] * (S_M / S_W), v1 = acc[ai][bj][m][1] * (S_M / S_W);
                        w[mm][0] = pk4_fp8(v0[0], v0[1], v0[2], v0[3]); w[mm][1] = pk4_fp8(v1[0], v1[1], v1[2], v1[3]); }
                    *(pg8::u32x4*)(b0 + (size_t)(ai * 128 + mp * 32) * DM + bj * 128) = widen16(w[0][0], w[0][1], w[1][0], w[1][1]); }
    }
};
struct SwigluEpi {
    static constexpr bool PERM = true, AFTER_DRAIN = false, BADJ = false;
    unsigned char* Gb; const float* bgu;
    __device__ __forceinline__ void operator()(AccRef acc, const Unit& u, int wr, int wc, int fr, int fq) const {
        const int cc = u.pn * 128 + wc * 32 + 8 * fq; const float* bp = bgu + (size_t)u.kind * 2048 + cc;
        float cT = -1.702f * 1.4426950408889634f / S_W, cU = S_G / (S_W * S_W); asm volatile("" : "+v"(cT), "+v"(cU));
        const pg8::f32x4 bg0 = *(const pg8::f32x4*)bp * S_W, bg1 = *(const pg8::f32x4*)(bp + 4) * S_W, bu0 = (*(const pg8::f32x4*)(bp + 1024) + 1.0f) * (S_G / S_W), bu1 = (*(const pg8::f32x4*)(bp + 1028) + 1.0f) * (S_G / S_W);
        unsigned char* b0 = Gb + (size_t)(u.pm * 256 + wr * 64 + (fq & 1) * 16 + fr) * DFF + u.pn * 128 + wc * 32 + 16 * (fq >> 1);
#pragma unroll
        for (int ai = 0; ai < 2; ++ai)
#pragma unroll
            for (int mp = 0; mp < 2; ++mp) { unsigned w[2][2];
#pragma unroll
                for (int mm = 0; mm < 2; ++mm) { const int m = 2 * mp + mm; float o[8];
#pragma unroll
                    for (int n = 0; n < 2; ++n) {
                        const pg8::f32x4 g4 = acc[ai][0][m][n] + (n ? bg1 : bg0), u4 = acc[ai][1][m][n] * cU + (n ? bu1 : bu0);
                        pg8::f32x4 a4, l4, e4, r4;
#pragma unroll
                        for (int i = 0; i < 4; ++i) { a4[i] = fminf(g4[i], 7.0f * S_W); l4[i] = __builtin_amdgcn_fmed3f(u4[i], -6.0f * S_G / S_W, 8.0f * S_G / S_W); }
                        const pg8::f32x4 t4 = a4 * cT;
#pragma unroll
                        for (int i = 0; i < 4; ++i) e4[i] = __builtin_amdgcn_exp2f(t4[i]);
                        const pg8::f32x4 d4 = e4 + 1.0f;
#pragma unroll
                        for (int i = 0; i < 4; ++i) r4[i] = __builtin_amdgcn_rcpf(d4[i]);
                        const pg8::f32x4 o4 = (a4 * r4) * l4;
#pragma unroll
                        for (int i = 0; i < 4; ++i) o[n * 4 + i] = o4[i]; }
                    w[mm][0] = pk4_fp8(o[0], o[1], o[2], o[3]); w[mm][1] = pk4_fp8(o[4], o[5], o[6], o[7]); }
                *(pg8::u32x4*)(b0 + (size_t)(ai * 128 + mp * 32) * DFF) = widen16(w[0][0], w[0][1], w[1][0], w[1][1]);
 }
    }
};
struct DownEpi {
    static constexpr bool PERM = true, AFTER_DRAIN = false, BADJ = false;
    unsigned char* Y; const float* bdn;
    __device__ __forceinline__ void operator()(AccRef acc, const Unit& u, int wr, int wc, int fr, int fq) const {
        const int cc = u.pn * 256 + wc * 32 + 8 * fq; const float* bp = bdn + (size_t)u.kind * DM + cc;
        unsigned char* b0 = Y + (size_t)(u.pm * 256 + wr * 64 + (fq & 1) * 16 + fr) * DM + u.pn * 256 + wc * 32 + 16 * (fq >> 1);
#pragma unroll
        for (int bj = 0; bj < 2; ++bj) { const pg8::f32x4 bv0 = *(const pg8::f32x4*)(bp + bj * 128) * S_Y, bv1 = *(const pg8::f32x4*)(bp + bj * 128 + 4) * S_Y;
#pragma unroll
            for (int ai = 0; ai < 2; ++ai)
#pragma unroll
                for (int mp = 0; mp < 2; ++mp) { unsigned w[2][2];
#pragma unroll
                    for (int mm = 0; mm < 2; ++mm) { const int m = 2 * mp + mm;
                        const pg8::f32x4 v0 = acc[ai][bj][m][0] * (S_Y / (S_W * S_G)) + bv0, v1 = acc[ai][bj][m][1] * (S_Y / (S_W * S_G)) + bv1;
                        w[mm][0] = pk4_fp8(v0[0], v0[1], v0[2], v0[3]); w[mm][1] = pk4_fp8(v1[0], v1[1], v1[2], v1[3]); }
                    *(pg8::u32x4*)(b0 + (size_t)(ai * 128 + mp * 32) * DM + bj * 128) = widen16(w[0][0], w[0][1], w[1][0], w[1][1]); } }
    }
};

__device__ __forceinline__ void build_moe_tables(LAS unsigned char* lds, const int* BCNT, int nrb  , bool want_bb, int tid) {
    LAS int* tile_e = (LAS int*)(lds + TAB_OFF); LAS int* misc = tile_e + MAXT;
    LAS int* bb = (LAS int*)(lds + RING_OFF); LAS int* seg = bb + 256 * NE;
    __syncthreads();
    for (int idx = tid; idx < nrb * NE; idx += NWAVES * 64) bb[idx] = BCNT[idx];
    __syncthreads();
    const int s16 = tid >> 5, e = tid & 31, per = nrb >> 4;
    { int run = 0; for (int q = 0; q < per; ++q) { const int bidx = (s16 * per + q) * NE + e; const int cc = bb[bidx]; bb[bidx] = run; run += cc; } seg[s16 * NE + e] = run; }
    __syncthreads();
    if (tid < NE) { int run = 0; for (int q = 0; q < 16; ++q) { const int t = seg[q * NE + tid]; seg[q * NE + tid] = run; run += t; } misc[8 + tid] = run; }
    __syncthreads();
    if (want_bb) { const int add = seg[s16 * NE + e]; for (int q = 0; q < per; ++q) bb[(s16 * per + q) * NE + e] += add; }
    if (tid == 0) { int off = 0; for (int e = 0; e < NE; ++e) { misc[40 + e] = off; off += ((misc[8 + e] + 255) >> 8) * 256; } misc[0] = off >> 8; }
    __syncthreads();
    for (int t = tid; t < MAXT; t += NWAVES * 64) { int ee = 0;
#pragma unroll 8
        for (int q = 1; q < NE; ++q) ee += ((misc[40 + q] >> 8) <= t) ? 1 : 0;
        tile_e[t] = ee; }
    __syncthreads();
}
struct AttnUnit { long qrow, kvrow; int h, nt; };
__device__ __forceinline__ bool attn_next(int i, int G, int vcu, bool l0, AttnUnit& u) {
    const int U = i * G + vcu, NU = 1024 + (l0 ? 128 : 0);
    if (U >= NU) return false;
    if (U < 1024) { const int bk = U >> 5, b = bk >> 1, kvh = bk & 1, hq = (U & 31) >> 3, qb = U & 7; u.h = kvh * 4 + hq; u.qrow = (long)b * SEQ + qb * 256; u.kvrow = (long)b * NKV; u.nt = NKV / 64; }
    else { const int q = U - 1024, b = q >> 3; u.h = q & 7; u.qrow = (long)NLAT + b * 256; u.kvrow = (long)b * NKV + SEQ; u.nt = CTXL / 64; }
    return true;
}

__global__ void __launch_bounds__(NWAVES * 64, 2) mk_fwd(Params Pk) {
    extern __shared__ __attribute__((aligned(16))) unsigned char lds_raw[];
    LAS unsigned char* lds0 = (LAS unsigned char*)lds_raw;
    volatile LAS unsigned* MISC = (volatile LAS unsigned*)(lds0 + MISC_OFF);
    const int tid0 = threadIdx.x; const int wave0 = __builtin_amdgcn_readfirstlane(tid0 >> 6);
    const int G0 = gridDim.x; const int bx0 = blockIdx.x;
    for (int u = tid0; u < 64; u += NWAVES * 64) MISC[u] = 0u;
    __syncthreads();
    XcdBarrier bar; bar.bar = (unsigned*)(Pk.ws + WS_CTL) + CW_BAR + Pk.li * XCD_BAR_WORDS; bar.x = 0; bar.st = nullptr;
    if (!MK_PER_PHASE) bar = xcd_barrier_post((unsigned*)(Pk.ws + WS_CTL) + CW_BAR + Pk.li * XCD_BAR_WORDS, MISC + 8);
    const int lo = Pk.ph_lo, hi = Pk.ph_hi;
#define IN(k) (lo <= (k) && (k) < hi)
#ifndef PROBE_MASK
#define PROBE_MASK 0ull
#endif
#if PROBE_MASK
#define REP(k) for (int rp_ = 0; rp_ < ((((unsigned long long)(PROBE_MASK) >> (k)) & 1ull) ? 2 : 1); ++rp_)
#else
#define REP(k)
#endif
#define SEAM(k) do { if (IN(k) && IN((k) + 1)) { XcdBarrier b2_ = bar; asm volatile("" : "+s"(b2_.bar)); xcd_barrier(b2_); } } while (0)
#define PH_BEGIN \
    const __attribute__((address_space(4))) Params* Pp_ = (const __attribute__((address_space(4))) Params*)__builtin_amdgcn_kernarg_segment_ptr(); asm volatile("" : "+s"(Pp_)); const __attribute__((address_space(4))) Params& P = *Pp_; \
    int wave = wave0; unsigned zero_ = 0u; asm volatile("" : "+s"(wave), "+s"(zero_)); const int lane = (int)__builtin_amdgcn_mbcnt_hi(~0u, __builtin_amdgcn_mbcnt_lo(~0u, zero_)); const int tid = wave * 64 + lane; (void)tid; \
    int G = G0, bx = bx0; asm volatile("" : "+s"(G), "+s"(bx)); const int vcu = (G % 8 == 0) ? (bx % 8) * (G / 8) + bx / 8 : bx; const int gw = vcu * NWAVES + wave, NGW = G * NWAVES; (void)NGW; \
    LAS unsigned char* lds = lds0; asm volatile("" : "+s"(lds)); \
    unsigned char* ws = P.ws; (void)lane; (void)gw; (void)ws; \
    bf16* WIN = (bf16*)(ws + WS_WIN); bf16* WOUT = (bf16*)(ws + WS_WOUT); bf16* WR = (bf16*)(ws + WS_WR); unsigned char* WGU = ws + WS_WGU; unsigned char* WDN = ws + WS_WDN; \
    float* WF = (float*)(ws + WS_WF); bf16* DFT = (bf16*)(ws + WS_DFT); bf16* DFTC = (bf16*)(ws + WS_DFTC); float* MOD = (float*)(ws + WS_MOD); float* ROPE = (float*)(ws + WS_ROPE); \
    float* XCTX = (float*)(ws + WS_XCTX); bf16* H = (bf16*)(ws + WS_H); bf16* F = (bf16*)(ws + WS_F); bf16* PA = (bf16*)(ws + WS_PA); bf16* FT = (bf16*)(ws + WS_FT); bf16* FTC = (bf16*)(ws + WS_FTC); \
    bf16* QB = (bf16*)(ws + WS_Q); bf16* KB = (bf16*)(ws + WS_K); bf16* VB = (bf16*)(ws + WS_V); bf16* CONV = (bf16*)(ws + WS_CONV); bf16* OB = (bf16*)(ws + WS_O); bf16* YF = (bf16*)(ws + WS_YF); \
    bf16* MERGED = (bf16*)(ws + WS_MERGED); bf16* MIX = (bf16*)(ws + WS_MIX); float* LOG = (float*)(ws + WS_LOG); \
    int* EID = (int*)(ws + WS_EID); float* WTS = (float*)(ws + WS_WT); int* POS = (int*)(ws + WS_POS); int* SLOT = (int*)(ws + WS_SLOT); int* BCNT = (int*)(ws + WS_BCNT); \
    bf16* XB = (bf16*)(ws + WS_XB); (void)XB; bf16* FTU = (bf16*)(ws + WS_FTU); bf16* FTUC = (bf16*)(ws + WS_FTUC); (void)FTU; (void)FTUC; int* ROWTOK = (int*)(ws + WS_XS); unsigned char* F8 = (unsigned char*)(ws + WS_F); unsigned char* GB = ws + WS_G; unsigned char* YB = ws + WS_Y; \
    (void)WIN; (void)WOUT; (void)WR; (void)WGU; (void)WDN; (void)WF; (void)DFT; (void)DFTC; (void)MOD; (void)ROPE; (void)XCTX; (void)H; (void)F; (void)PA; (void)FT; (void)FTC; (void)QB; (void)KB; (void)VB; \
    (void)CONV; (void)OB; (void)YF; (void)MERGED; (void)MIX; (void)LOG; (void)EID; (void)WTS; (void)POS; (void)SLOT; (void)BCNT; (void)ROWTOK; (void)F8; (void)F; (void)GB; (void)YB;

    REP(0) if (IN(0)) { PH_BEGIN
        for (int item = bx; item < 2 * 96; item += G) {
            const int l = item / 96, cb = item % 96;
            LAS float* sl = (LAS float*)(lds + RING_OFF); LAS float* part = sl + 17 * 1024;
            __syncthreads();
            for (int idx = tid; idx < 17 * 1024; idx += NWAVES * 64) { const int r = idx >> 10, k = idx & 1023; const float v = r < 16 ? P.c[r * 1024 + k] : P.c_ctx[k]; sl[idx] = v / (1.0f + __expf(-v)); }
            __syncthreads();
            float acc[17];
#pragma unroll
            for (int r = 0; r < 17; ++r) acc[r] = 0.f;
            const float* wp = P.w_mod + ((size_t)l * 1024 + wave * 128) * 6144 + cb * 64 + lane;
#pragma unroll 4
            for (int k = 0; k < 128; ++k) { const float wv = wp[(size_t)k * 6144];
#pragma unroll
                for (int r = 0; r < 17; ++r) acc[r] += sl[r * 1024 + wave * 128 + k] * wv; }
#pragma unroll
            for (int r = 0; r < 17; ++r) part[(wave * 17 + r) * 64 + lane] = acc[r];
            __syncthreads();
            for (int idx = tid; idx < 17 * 64; idx += NWAVES * 64) { const int r = idx >> 6, ln = idx & 63; float s = P.b_mod[l * 6144 + cb * 64 + ln];
#pragma unroll
                for (int w = 0; w < 8; ++w) s += part[(w * 17 + r) * 64 + ln];
                MOD[((size_t)l * 17 + r) * 6144 + cb * 64 + ln] = s; }
            __syncthreads();
        }
        {
            LAS float* tab = (LAS float*)(lds + RING_OFF + 65536);
            __syncthreads();
            if (tid < 64) { tab[tid] = cos_rev((float)tid * (1.0f / 64.0f)); tab[64 + tid] = sin_rev((float)tid * (1.0f / 64.0f)); }
            __syncthreads();
            LAS float* scr = (LAS float*)(lds + RING_OFF) + wave * 256;
            for (int item = gw; item < 2 * 1024; item += NGW) {
                const float* src = P.w_in + (size_t)item * INW + 1536;
                *(LAS f32x4*)(scr + lane * 4) = *(const f32x4*)(src + lane * 4);
                LDS_WAIT(); asm volatile("" ::: "memory");
                const int k2u = lane <= 32 ? lane : lane - 32, tb = lane <= 32 ? 0 : 64;
#pragma unroll
                for (int g = 0; g < 4; ++g) { float s = 0.f;
#pragma unroll 8
                    for (int cidx = 0; cidx < 64; ++cidx) s += scr[g * 64 + cidx] * tab[tb + ((k2u * cidx) & 63)];
                    WF[(size_t)item * 256 + g * 64 + lane] = s; }
                LDS_WAIT(); asm volatile("" ::: "memory");
            }
            __syncthreads();
        }
        {
            LAS float* scr = (LAS float*)(lds + RING_OFF + wave * 16640);
            constexpr int I_IN = 16 * 24, I_OUT = 16 * 16, I_GU = 32 * 16 * 32, I_DN = 32 * 16 * 16, I_L = I_IN + I_OUT + I_GU + I_DN;
            for (int it = gw; it < 2 * I_L; it += NGW) {
                const int l = it / I_L; int r = it % I_L;
                if (r < I_IN) { const int kb = r / 24, nb = r % 24, n0 = nb * 64; unsigned char* WIN8 = (unsigned char*)(WIN + (size_t)WINR * 1024);
                    if (n0 < 1024) { if (l == 0) tr_item(P.w_in, INW, kb * 64, n0, WIN, 1024, n0, scr, lane); else tr_item8(P.w_in + (size_t)1024 * INW, INW, kb * 64, n0, WIN8, 1024, n0, S_W, scr, lane); }
                    else {
                        const bool isc_ = n0 < 1280; const int x0 = n0 - (isc_ ? 1024 : 1280), tl = 4 + (x0 >> 7), w0 = (x0 & 127) >> 5, add = isc_ ? 0 : 32;
                        if (l == 0) tr_item2(P.w_in, INW, kb * 64, n0, WIN, 1024, tl * 256 + w0 * 64 + add, tl * 256 + (w0 + 1) * 64 + add, scr, lane);
                        else tr_item2_8(P.w_in + (size_t)1024 * INW, INW, kb * 64, n0, WIN8, 1024, tl * 256 + w0 * 64 + add, tl * 256 + (w0 + 1) * 64 + add, S_W, scr, lane); }
                    continue; } r -= I_IN;
                if (r < I_OUT) { const int kb = r / 16, nb = r % 16;
                    if (l == 0) tr_item(P.w_out, 1024, kb * 64, nb * 64, WOUT, 1024, nb * 64, scr, lane);
                    else tr_item8(P.w_out + (size_t)1024 * 1024, 1024, kb * 64, nb * 64, (unsigned char*)(WOUT + (size_t)1024 * 1024), 1024, nb * 64, S_W, scr, lane);
                    continue; } r -= I_OUT;
                if (r < I_GU) { const int e = r / 512, q = r % 512, kb = q / 32, nb = q % 32, n0 = nb * 64;
                    const int drow = (n0 < 1024) ? (n0 >> 7) * 256 + (n0 & 127) : ((n0 - 1024) >> 7) * 256 + 128 + ((n0 - 1024) & 127);
                    tr_item8(P.w_gu + ((size_t)l * 32 + e) * 1024 * 2048, 2048, kb * 64, n0, WGU + ((size_t)l * 32 + e) * 2048 * 1024, 1024, drow, S_W, scr, lane); continue; } r -= I_GU;
                { const int e = r / 256, q = r % 256, kb = q / 16, nb = q % 16; tr_item8(P.w_dn + ((size_t)l * 32 + e) * 1024 * 1024, 1024, kb * 64, nb * 64, WDN + ((size_t)l * 32 + e) * 1024 * 1024, 1024, nb * 64, S_W, scr, lane); }
            }
        }
        for (int idx = bx * (NWAVES * 64) + tid; idx < 2 * 256 * 1024; idx += G * NWAVES * 64) {
            const int l = idx >> 18, rr = (idx >> 10) & 255, k = idx & 1023; unsigned short o = 0;
            if (rr < 64) { const float w = P.w_router[((size_t)l * 1024 + k) * 32 + (rr & 31)]; const unsigned h = pk2(w, 0.f) & 0xffffu; o = (unsigned short)h;
                if (rr >= 32) { const float lo_ = w - bflo(h); o = (unsigned short)(pk2(lo_, 0.f) & 0xffffu); } }
            WR[idx] = o;
        }
        {
            LAS float* ct = (LAS float*)(lds + RING_OFF); LAS float* st = ct + 2048;
            __syncthreads();
            for (int j = tid; j < 2048; j += NWAVES * 64) { ct[j] = cos_rev((float)j * (1.0f / 2048.0f)); st[j] = sin_rev((float)j * (1.0f / 2048.0f)); }
            __syncthreads();
            for (int q = bx * (NWAVES * 64) + tid; q < 2048 * 512; q += G * NWAVES * 64) { const int k1 = q >> 9, n8 = (q & 511) * 8; float v[8];
#pragma unroll
                for (int i = 0; i < 8; ++i) { const int n = n8 + i; v[i] = (n < 2048) ? ct[(k1 * n) & 2047] : -st[(k1 * (n - 2048)) & 2047]; }
                v4u o; o.x = pk2(v[0], v[1]); o.y = pk2(v[2], v[3]); o.z = pk2(v[4], v[5]); o.w = pk2(v[6], v[7]); *(v4u*)(DFT + (size_t)q * 8) = o; }
            for (int q = bx * (NWAVES * 64) + tid; q < 256 * 64; q += G * NWAVES * 64) { const int k1 = q >> 6, n8 = (q & 63) * 8; float v[8];
#pragma unroll
                for (int i = 0; i < 8; ++i) { const int n = n8 + i; v[i] = (n < 256) ? ct[((k1 * n) & 255) * 8] : -st[((k1 * (n - 256)) & 255) * 8]; }
                v4u o; o.x = pk2(v[0], v[1]); o.y = pk2(v[2], v[3]); o.z = pk2(v[4], v[5]); o.w = pk2(v[6], v[7]); *(v4u*)(DFTC + (size_t)q * 8) = o; }
            for (int q = bx * (NWAVES * 64) + tid; q < 64 * 16; q += G * NWAVES * 64) { const int pos = q >> 4, f = q & 15;
                const float inv = __builtin_amdgcn_exp2f(-(float)f * (13.287712379549449f / 16.0f)); const float rev = (float)pos * inv * 0.15915494309189535f;
                ROPE[q] = cos_rev(rev); ROPE[1024 + q] = sin_rev(rev); }
            __syncthreads();
        }
    }
    SEAM(0);
    REP(1) if (IN(1)) { PH_BEGIN
        LAS float* scr = (LAS float*)(lds + RING_OFF + wave * 16640);
        for (int it = gw; it < 2 * 64; it += NGW) { const int l = it >> 6, r = it & 63, kb = r >> 2, nb = r & 3;
            if (l == 0) tr_item(WF, 256, kb * 64, nb * 64, WIN, 1024, 1536 + nb * 64, scr, lane);
            else tr_item8(WF + (size_t)1024 * 256, 256, kb * 64, nb * 64, (unsigned char*)(WIN + (size_t)WINR * 1024), 1024, 1536 + nb * 64, S_W, scr, lane); }
        for (int row = gw; row < NTOK; row += NGW) { RowF xr; const int mr = row < NLAT ? (row >> 11) : 16;
            ld_row_f32(xr, row < NLAT ? P.x + (size_t)row * DM : P.ctx + (size_t)(row - NLAT) * DM, lane);
            const float* md = MOD + (size_t)mr * 6144;
            modulate_store(xr, P.g_pre_mix, md + 0 * DM, md + 1 * DM, H + (size_t)row * DM, lane); }
    }
    SEAM(1);

    for (int layer = 0; layer < 2; ++layer) {
        const int pb = 2 + 13 * layer;
        const bool l0 = (layer == 0);
        const int NR = l0 ? NTOK : NLAT;
        REP(pb + 0) if (IN(pb + 0)) { PH_BEGIN
            InprojSched S; S.init(G, bx, layer, H, WIN + (size_t)layer * WINR * 1024);
            LAS float* tab = (LAS float*)(lds + TAB_OFF);
            for (int i = tid; i < 2048; i += NWAVES * 64) tab[i] = ROPE[i];
            if (tid < 64) tab[2048 + tid] = P.g_q[layer * 64 + tid]; else if (tid < 128) tab[2048 + tid] = P.g_k[layer * 64 + tid - 64];
            LDS_WAIT(); __syncthreads();
            InprojEpi E{PA, FTU, FTUC, QB, KB, VB, tab, l0 ? 1.0f : 1.0f / S_W};
            if (l0) pg8::gemm_phase<InprojEpi, InprojSched, true, true>(lds + RING_OFF, 1024, S, E, wave);
            else pg8::gemm_phase<InprojEpi, InprojSched, true, true, true>(lds + RING_OFF, 512, S, E, wave);
        }
        SEAM(pb + 0);
        REP(pb + 2) if (IN(pb + 2)) { PH_BEGIN
            AttnUnit u;
            for (int i = 0; attn_next(i, G, vcu, l0, u); ++i)
                attn_body::attn_unit<8>(u.qrow, u.kvrow, u.h, u.nt, (const attn_body::bf16*)QB, (const attn_body::bf16*)KB, (const attn_body::bf16*)VB, (attn_body::bf16*)OB, (char*)lds_raw + RING_OFF, wave);
        }
        REP(pb + 3) if (IN(pb + 3)) { PH_BEGIN
            { FourierSchedT<false> S{G, bx, 256, (const char*)DFT, (const char*)FTU, (size_t)256 * 2048 * 2}; FourierEpi E{YF};
              pg8::gemm_phase<FourierEpi, FourierSchedT<false>, true, true>(lds + RING_OFF, 1024, S, E, wave, 4096); }
            {
                float* Y0 = (float*)(ws + WS_ROPE + 65536);
                for (int r = gw; r < NB * 256; r += NGW) { const bf16* src = FTU + (size_t)r * 2048; float s = 0.f;
#pragma unroll
                    for (int q = 0; q < 4; ++q) { const v4u w = *(const v4u*)(src + q * 512 + lane * 8); s += (bflo(w.x) + bfhi(w.x)) + (bflo(w.y) + bfhi(w.y)) + (bflo(w.z) + bfhi(w.z)) + (bflo(w.w) + bfhi(w.w)); }
                    s = wave_sum(s, lane); if (lane == 0) Y0[r] = s; } }
            if (l0) { __syncthreads();
              const int cctx = ((bx & 7) >= 4) ? (bx >> 3) * 4 + ((bx & 7) - 4) : G;
              FourierSchedT<true> S{G, cctx, 16, (const char*)DFTC, (const char*)FTC, (size_t)256 * 512 * 2}; FourierEpi E{YF};
              {
                  pg8::Unit u0;
                  for (int i0 = 0; S.next(i0, u0); ++i0) { const int b = u0.pn;
                      for (int it = wave; it < 512; it += NWAVES) { const int part = it & 1, ch = it >> 1, g = ch >> 6, k2 = ch & 63;
                          int u; unsigned flip = 0u; bool zero = false;
                          if (part == 0) u = g * 64 + (k2 <= 32 ? k2 : 64 - k2);
                          else { zero = (k2 == 0) | (k2 == 32); u = g * 64 + 32 + (k2 < 32 ? k2 : 64 - k2); if (k2 > 32) flip = 0x80008000u; if (zero) u = g * 64; }
                          if (lane < 32) { v4u w = *(const v4u*)(FTUC + ((size_t)b * 256 + u) * 256 + lane * 8); { const unsigned keep = zero ? 0u : ~0u; w.x = (w.x ^ flip) & keep; w.y = (w.y ^ flip) & keep; w.z = (w.z ^ flip) & keep; w.w = (w.w ^ flip) & keep; }
                              *(v4u*)(FTC + ((size_t)b * 256 + ch) * 512 + part * 256 + lane * 8) = w; } } }
                  VM_WAIT(); __syncthreads(); }
              pg8::gemm_phase<FourierEpi, FourierSchedT<true>, true, true>(lds + RING_OFF, 512, S, E, wave); }
        }
        SEAM(pb + 3);
        REP(pb + 4) if (IN(pb + 4)) { PH_BEGIN
            const float* gb = P.g_branch + layer * 1024; const float* cw = P.conv_w + layer * 3 * 256;
            struct MR { v4u wa; v2u wb, u0, u1, u2, y0, y1, y2, y3; };
            auto mrow = [](int row, int& t, int& len) { if (row < NLAT) { t = row & 2047; len = SEQ; } else { t = (row - NLAT) & 255; len = CTXL; } };
            auto issue = [=](int row, MR& r) { int t, len; mrow(row, t, len); const int ch = lane * 4;
                r.wa = *(const v4u*)(OB + (size_t)row * 512 + lane * 8);
                const bf16* pa = PA + (size_t)row * PAW; const bf16* pm = (t > 0) ? pa - PAW : pa; const bf16* pp = (t < len - 1) ? pa + PAW : pa;
                r.wb = *(const v2u*)(pa + 768 + ch); r.u1 = *(const v2u*)(pa + 1024 + ch); r.u0 = *(const v2u*)(pm + 1024 + ch); r.u2 = *(const v2u*)(pp + 1024 + ch);
                if (row >= NLAT) { r.y0 = *(const v2u*)(YF + YF_CTX + (size_t)(row - NLAT) * 256 + ch); r.y1 = r.y0; r.y2 = r.y0; r.y3 = r.y0; }
                else { const int bb_ = row >> 11, k1 = row & 2047; const int rr = (k1 == 0) ? 0 : (k1 <= 1024 ? k1 : 2048 - k1) - 1;
                    const bf16* p0 = YF + ((size_t)bb_ * 1024 + rr) * 256 + ch; const size_t pl = (size_t)NB * 1024 * 256;
                    r.y0 = *(const v2u*)p0; r.y1 = *(const v2u*)(p0 + pl); r.y2 = *(const v2u*)(p0 + 2 * pl); r.y3 = *(const v2u*)(p0 + 3 * pl); } };
            int row0 = gw;
            if (row0 < NR) {
                MR A; issue(row0, A);
                for (;;) {
                    const int row1 = row0 + NGW; const bool hB = row1 < NR; MR B = A; if (hB) issue(row1, B);
                    {   const int row = row0; int t, len; mrow(row, t, len); const int ch = lane * 4;
                        const v4u wa = A.wa;
                        float cv[4];
                        { const v2u wb = A.wb, w0 = A.u0, w1 = A.u1, w2 = A.u2;
                          const float m0 = (t > 0) ? 1.f : 0.f, m2 = (t < len - 1) ? 1.f : 0.f;
                          const f32x4 k0 = *(const f32x4*)(cw + ch) * m0, k1c = *(const f32x4*)(cw + 256 + ch), k2c = *(const f32x4*)(cw + 512 + ch) * m2;
                          const float gb2[4] = {bflo(wb.x), bfhi(wb.x), bflo(wb.y), bfhi(wb.y)};
                          const float u0[4] = {bflo(w0.x), bfhi(w0.x), bflo(w0.y), bfhi(w0.y)}, u1[4] = {bflo(w1.x), bfhi(w1.x), bflo(w1.y), bfhi(w1.y)}, u2[4] = {bflo(w2.x), bfhi(w2.x), bflo(w2.y), bfhi(w2.y)};
#pragma unroll
                          for (int i = 0; i < 4; ++i) cv[i] = gb2[i] * (u0[i] * k0[i] + u1[i] * k1c[i] + u2[i] * k2c[i]); }
                        f32x4 fy;
                        if (row >= NLAT) { const v2u w = A.y0; fy = (f32x4){bflo(w.x), bfhi(w.x), bflo(w.y), bfhi(w.y)}; }
                        else { const int bb_ = row >> 11, k1 = row & 2047;
                            if (k1 == 0) { const float* y0 = (const float*)(ws + WS_ROPE + 65536) + bb_ * 256 + (lane >> 4) * 64; const int k2a = (lane & 15) * 4;
#pragma unroll
                                for (int i = 0; i < 4; ++i) { const int kk = k2a + i; fy[i] = y0[kk <= 32 ? kk : 64 - kk]; } }
                            else { const float sg = k1 <= 1024 ? 1.f : -1.f; const v2u w0 = A.y0, w1 = A.y1, w2 = A.y2, w3 = A.y3;
                                const int k2a = (lane & 15) * 4; f32x4 ss;
#pragma unroll
                                for (int i = 0; i < 4; ++i) { const int kk = k2a + i; ss[i] = ((kk & 31) == 0) ? 0.f : (kk > 32 ? -sg : sg); }
                                fy = ((f32x4){bflo(w0.x), bfhi(w0.x), bflo(w0.y), bfhi(w0.y)} + (f32x4){bflo(w1.x), bfhi(w1.x), bflo(w1.y), bfhi(w1.y)}) + ((f32x4){bflo(w2.x), bfhi(w2.x), bflo(w2.y), bfhi(w2.y)} + (f32x4){bflo(w3.x), bfhi(w3.x), bflo(w3.y), bfhi(w3.y)}) * ss; } }
                        float a[8] = {bflo(wa.x), bfhi(wa.x), bflo(wa.y), bfhi(wa.y), bflo(wa.z), bfhi(wa.z), bflo(wa.w), bfhi(wa.w)};
                        float fv[4] = {fy[0], fy[1], fy[2], fy[3]};
                        float sa = 0.f, sc = 0.f, sf = 0.f;
#pragma unroll
                        for (int i = 0; i < 8; ++i) sa += a[i] * a[i];
#pragma unroll
                        for (int i = 0; i < 4; ++i) { sc += cv[i] * cv[i]; sf += fv[i] * fv[i]; }
                        sa = wave_sum(sa, lane); sc = wave_sum(sc, lane); sf = wave_sum(sf, lane);
                        const float ra = rsq(sa * (1.0f / 512.0f) + EPS), rc = rsq(sc * (1.0f / 256.0f) + EPS), rf = rsq(sf * (1.0f / 256.0f) + EPS);
                        const f32x4 g0 = *(const f32x4*)(gb + lane * 8), g1 = *(const f32x4*)(gb + lane * 8 + 4), g2 = *(const f32x4*)(gb + 512 + lane * 4), g3 = *(const f32x4*)(gb + 768 + lane * 4);
                        if (l0) { bf16* mr = MERGED + (size_t)row * DM;
                        v4u oa; oa.x = pk2(a[0] * ra * g0[0], a[1] * ra * g0[1]); oa.y = pk2(a[2] * ra * g0[2], a[3] * ra * g0[3]); oa.z = pk2(a[4] * ra * g1[0], a[5] * ra * g1[1]); oa.w = pk2(a[6] * ra * g1[2], a[7] * ra * g1[3]);
                        *(v4u*)(mr + lane * 8) = oa;
                        v2u oc; oc.x = pk2(cv[0] * rc * g2[0], cv[1] * rc * g2[1]); oc.y = pk2(cv[2] * rc * g2[2], cv[3] * rc * g2[3]); *(v2u*)(mr + 512 + lane * 4) = oc;
                        v2u of; of.x = pk2(fv[0] * rf * g3[0], fv[1] * rf * g3[1]); of.y = pk2(fv[2] * rf * g3[2], fv[3] * rf * g3[3]); *(v2u*)(mr + 768 + lane * 4) = of; }
                        else { unsigned char* mr = (unsigned char*)MERGED + (size_t)row * DM;
                        v2u oa; oa.x = pk4_fp8(a[0] * ra * g0[0], a[1] * ra * g0[1], a[2] * ra * g0[2], a[3] * ra * g0[3]); oa.y = pk4_fp8(a[4] * ra * g1[0], a[5] * ra * g1[1], a[6] * ra * g1[2], a[7] * ra * g1[3]);
                        *(v2u*)(mr + lane * 8) = oa;
                        *(unsigned*)(mr + 512 + lane * 4) = pk4_fp8(cv[0] * rc * g2[0], cv[1] * rc * g2[1], cv[2] * rc * g2[2], cv[3] * rc * g2[3]);
                        *(unsigned*)(mr + 768 + lane * 4) = pk4_fp8(fv[0] * rf * g3[0], fv[1] * rf * g3[1], fv[2] * rf * g3[2], fv[3] * rf * g3[3]); }
                    }
                    if (!hB) break;
                    row0 = row1; A = B;
                }
            }
        }
        SEAM(pb + 4);
        REP(pb + 5) if (IN(pb + 5)) { PH_BEGIN
            if (l0) { CtxKSched S{G, bx, 256, (const char*)(MERGED + (size_t)NLAT * DM), (const char*)(WOUT + (size_t)layer * 1024 * 1024)}; CtxKEpi E{FT};
                pg8::gemm_phase<CtxKEpi, CtxKSched, true, true>(lds + RING_OFF, 256, S, E, wave, 1024); }
            if (l0) { PlainSched S{G, bx, 4, (NLAT / 256) * 4, (const char*)MERGED, (const char*)WOUT}; OutEpi E{MIX};
                pg8::gemm_phase<OutEpi, PlainSched, true, true>(lds + RING_OFF, 1024, S, E, wave); }
            else { PlainSched8 S{G, bx, 4, (NLAT / 256) * 4, (const char*)MERGED, (const char*)(WOUT + (size_t)1024 * 1024)}; OutEpi8 E{(unsigned char*)MIX};
                pg8::gemm_phase<OutEpi8, PlainSched8, true, true, true>(lds + RING_OFF, 512, S, E, wave); }
        }
        SEAM(pb + 5);
        REP(pb + 6) if (IN(pb + 6)) { PH_BEGIN
            typedef short bf16x8v __attribute__((ext_vector_type(8)));
            constexpr int FP = 2064;
            LAS unsigned char* Ft = lds + RING_OFF; LAS float* part = (LAS float*)(lds + RING_OFF + 36864);
            const bf16* wr = WR + (size_t)layer * 256 * 1024;
            bf16x8v Bf[4][4];
#pragma unroll
            for (int s = 0; s < 4; ++s)
#pragma unroll
                for (int nt = 0; nt < 4; ++nt) Bf[s][nt] = *(const bf16x8v*)(wr + (size_t)(16 * nt + (lane & 15)) * 1024 + 128 * wave + 32 * s + 8 * (lane >> 4));
            const float* gpm = P.g_post_mix + layer * DM; const float* gpf = P.g_pre_ffn + layer * DM;
            LAS float* LOGS = (LAS float*)(lds + RING_OFF + 73728);
            int kc = 0;
            for (int ci = bx; ci < NR / 16; ci += G, ++kc) {
#pragma unroll
                for (int rr = 0; rr < 2; ++rr) {
                    const int rl = 2 * wave + rr, row = 16 * ci + rl;
                    const bool isc = row >= NLAT; const float* md = MOD + (size_t)layer * 17 * 6144 + (size_t)(isc ? 16 : (row >> 11)) * 6144;
                    RowF mx, xr, gp, gt;
                    if (l0 && isc) { const bf16* mc = FT + (size_t)(row - NLAT) * DM; RowF t1, t2, t3; ld_row_bf16(mx, mc, lane); ld_row_bf16(t1, mc + (size_t)NCTX * DM, lane); ld_row_bf16(t2, mc + (size_t)2 * NCTX * DM, lane); ld_row_bf16(t3, mc + (size_t)3 * NCTX * DM, lane);
#pragma unroll
                        for (int jj = 0; jj < 4; ++jj) mx.v[jj] = (mx.v[jj] + t1.v[jj]) + (t2.v[jj] + t3.v[jj]); }
                    else if (l0) ld_row_bf16(mx, MIX + (size_t)row * DM, lane);
                    else { const unsigned* qm = (const unsigned*)((const unsigned char*)MIX + (size_t)row * DM) + lane;
#pragma unroll
                        for (int jj = 0; jj < 4; ++jj) { const unsigned w = qm[64 * jj]; const auto lo = __builtin_amdgcn_cvt_pk_f32_fp8((int)w, false), hi = __builtin_amdgcn_cvt_pk_f32_fp8((int)w, true);
                            mx.v[jj] = (f32x4){lo[0], lo[1], hi[0], hi[1]} * (1.0f / S_M); } }
                    if (l0) ld_row_f32(xr, isc ? P.ctx + (size_t)(row - NLAT) * DM : P.x + (size_t)row * DM, lane); else ld_row_bf16(xr, XB + (size_t)row * DM, lane);
                    ld_row_f32(gp, gpm, lane); ld_row_f32(gt, md + 2 * DM, lane);
                    const float rstd = rsq(row_ss(mx, lane) * (1.0f / DM) + EPS);
#pragma unroll
                    for (int jj = 0; jj < 4; ++jj) xr.v[jj] = xr.v[jj] + gt.v[jj] * (mx.v[jj] * rstd * gp.v[jj]);
                    st_row_bf16(XB + (size_t)row * DM, lane, xr);
                    const float rstd2 = rsq(row_ss(xr, lane) * (1.0f / DM) + EPS);
                    RowF gg, s1, s2; ld_row_f32(gg, gpf, lane); ld_row_f32(s1, md + 4 * DM, lane); ld_row_f32(s2, md + 3 * DM, lane);
                    unsigned* qf = (unsigned*)(F8 + (size_t)row * DM) + lane;
#pragma unroll
                    for (int jj = 0; jj < 4; ++jj) { const f32x4 o = xr.v[jj] * rstd2 * gg.v[jj] * (s1.v[jj] + 1.0f) + s2.v[jj];
                        v2u w; w.x = pk2(o[0], o[1]); w.y = pk2(o[2], o[3]); qf[64 * jj] = pk4_fp8(o[0], o[1], o[2], o[3]); *(LAS v2u*)(Ft + rl * FP + 8 * lane + 512 * jj) = w; }
                }
                LDS_WAIT(); __syncthreads();
                f32x4 acc[4];
#pragma unroll
                for (int nt = 0; nt < 4; ++nt) acc[nt] = (f32x4){0.f, 0.f, 0.f, 0.f};
#pragma unroll
                for (int s = 0; s < 4; ++s) { const bf16x8v a = *(const LAS bf16x8v*)(Ft + (lane & 15) * FP + (128 * wave + 32 * s + 8 * (lane >> 4)) * 2);
#pragma unroll
                    for (int nt = 0; nt < 4; ++nt) acc[nt] = __builtin_amdgcn_mfma_f32_16x16x32_bf16(a, Bf[s][nt], acc[nt], 0, 0, 0); }
#pragma unroll
                for (int nt = 0; nt < 4; ++nt)
#pragma unroll
                    for (int r = 0; r < 4; ++r) part[(wave * 16 + 4 * (lane >> 4) + r) * 64 + 16 * nt + (lane & 15)] = acc[nt][r];
                LDS_WAIT(); __syncthreads();
                { const int rowl = tid >> 5, e = tid & 31; float s = 0.f, s2 = 0.f;
#pragma unroll
                    for (int w = 0; w < 8; ++w) { s += part[(w * 16 + rowl) * 64 + e]; s2 += part[(w * 16 + rowl) * 64 + 32 + e]; }
                    LOGS[(kc * 16 + rowl) * 36 + e] = s + s2; }
                __syncthreads();
            }
        }
        REP(pb + 8) if (IN(pb + 8)) { PH_BEGIN
            __syncthreads();
            LAS int* wcnt = (LAS int*)(lds + RING_OFF);
            const float* br = P.b_router + layer * 32;
            {   const int nchunk = NR / 16, nck = (bx < nchunk) ? (nchunk - bx + G - 1) / G : 0;
                const bool valid = (tid >> 4) < nck; const int row = valid ? 16 * (bx + (tid >> 4) * G) + (tid & 15) : 0; const LAS float* Lr = (const LAS float*)(lds + RING_OFF + 73728) + (size_t)tid * 36;
                float lg[32];
#pragma unroll
                for (int q = 0; q < 8; ++q) { const f32x4 a = *(const LAS f32x4*)(Lr + 4 * q), bb = *(const f32x4*)(br + 4 * q);
#pragma unroll
                    for (int i = 0; i < 4; ++i) lg[4 * q + i] = a[i] + bb[i]; }
                int eb = 0; asm volatile("" : "+s"(eb));
                int ev[4]; float tv[4]; unsigned used = 0u;
#pragma unroll
                for (int k = 0; k < 4; ++k) { float best = -INFINITY; int bi = 0;
#pragma unroll
                    for (int e = 0; e < 32; ++e) { const bool free_ = !((used >> (e + eb)) & 1u); if (free_ && (lg[e] > best || (e == 0 && k == 0))) { best = lg[e]; bi = e + eb; } }
                    ev[k] = valid ? bi : -1; tv[k] = best; used |= 1u << bi; }
                float pw[4]; float sum = 0.f;
#pragma unroll
                for (int k = 0; k < 4; ++k) { pw[k] = __expf(tv[k] - tv[0]); sum += pw[k]; }
                const float rs = 1.0f / sum;
                int pos[4] = {0, 0, 0, 0};
                const unsigned long long ltm = (lane == 0) ? 0ull : (~0ull >> (64 - lane));
                __syncthreads();
#pragma clang loop unroll(disable)
                for (int e0_ = 0; e0_ < 32; ++e0_) { const int e = e0_ + eb; const bool sel = (ev[0] == e) | (ev[1] == e) | (ev[2] == e) | (ev[3] == e); const unsigned long long M = __builtin_amdgcn_ballot_w64(sel);
                    const int rk = __popcll(M & ltm);
#pragma unroll
                    for (int k = 0; k < 4; ++k) pos[k] = (ev[k] == e) ? rk : pos[k];
                    if (lane == 0) wcnt[wave * 32 + e] = __popcll(M); }
                __syncthreads();
#pragma unroll
                for (int k = 0; k < 4; ++k) { int add = 0; const int ek = valid ? ev[k] : 0; for (int w = 0; w < wave; ++w) add += wcnt[w * 32 + ek]; pos[k] += add; }
                if (tid < 32) { int s = 0;
#pragma unroll
                    for (int w = 0; w < 8; ++w) s += wcnt[w * 32 + tid];
                    BCNT[bx * 32 + tid] = s; }
                if (valid) { *(int4*)(EID + (size_t)row * 4) = make_int4(ev[0], ev[1], ev[2], ev[3]);
                    *(float4*)(WTS + (size_t)row * 4) = make_float4(pw[0] * rs, pw[1] * rs, pw[2] * rs, pw[3] * rs);
                    *(int4*)(POS + (size_t)row * 4) = make_int4(pos[0], pos[1], pos[2], pos[3]); }
                __syncthreads();
            }
        }
        SEAM(pb + 8);
        REP(pb + 9) if (IN(pb + 9)) { PH_BEGIN const LAS int* tile_e = (const LAS int*)(lds + TAB_OFF); const LAS int* tmisc = tile_e + MAXT;
            build_moe_tables(lds, BCNT, G, true, tid);
            const LAS int* bb = (const LAS int*)(lds + RING_OFF);
            for (int r16 = gw; r16 < NR / 16; r16 += NGW) {
                const int row = r16 * 16 + (lane >> 2); const size_t ix = (size_t)r16 * 64 + lane;
                const int e = EID[ix], pos = POS[ix];
                const int slot = tmisc[40 + e] + bb[(r16 % G) * 32 + e] + pos;
                SLOT[ix] = slot; ROWTOK[slot] = row;
            }
            for (int q = gw * 64 + lane; q < NE * 256; q += NGW * 64) { const int e = q >> 8, i = q & 255, tot = tmisc[8 + e], npad = ((tot + 255) & ~255) - tot;
                if (i < npad) ROWTOK[tmisc[40 + e] + tot + i] = 0; }
            __syncthreads();
        }
        SEAM(pb + 9);
        REP(pb + 10) if (IN(pb + 10)) { PH_BEGIN const LAS int* tile_e = (const LAS int*)(lds + TAB_OFF); const LAS int* tmisc = tile_e + MAXT;
            if (MK_PER_PHASE) build_moe_tables(lds, BCNT, G, false, tid);
            MoeSchedT<true> S{G, bx, 8, tmisc[0] * 8, tile_e, (const char*)F8, (const char*)(WGU + (size_t)layer * 32 * 2048 * 1024), (size_t)2048 * 1024, ROWTOK};
            SwigluEpi E{GB, P.b_gu + (size_t)layer * 32 * 2048};
            pg8::gemm_phase<SwigluEpi, MoeSchedT<true>, true, true, true>(lds + RING_OFF, 512, S, E, wave);
        }
        SEAM(pb + 10);
        REP(pb + 11) if (IN(pb + 11)) { PH_BEGIN const LAS int* tile_e = (const LAS int*)(lds + TAB_OFF); const LAS int* tmisc = tile_e + MAXT;
            if (MK_PER_PHASE) build_moe_tables(lds, BCNT, G, false, tid);
            MoeSchedT<false> S{G, bx, 4, tmisc[0] * 4, tile_e, (const char*)GB, (const char*)(WDN + (size_t)layer * 32 * 1024 * 1024), (size_t)1024 * 1024, ROWTOK};
            DownEpi E{YB, P.b_dn + (size_t)layer * 32 * 1024};
            pg8::gemm_phase<DownEpi, MoeSchedT<false>, true, true, true>(lds + RING_OFF, 512, S, E, wave);
        }
        SEAM(pb + 11);
        REP(pb + 12) if (IN(pb + 12)) { PH_BEGIN
            struct CRaw { unsigned y[4][4]; v2u x[4]; };
            auto issue = [=](int row, int sx, int sy, int sz, int sw, CRaw& r) {
                const unsigned* q0 = (const unsigned*)(YB + (size_t)sx * DM) + lane; const unsigned* q1 = (const unsigned*)(YB + (size_t)sy * DM) + lane;
                const unsigned* q2 = (const unsigned*)(YB + (size_t)sz * DM) + lane; const unsigned* q3 = (const unsigned*)(YB + (size_t)sw * DM) + lane; const v2u* qx = (const v2u*)(XB + (size_t)row * DM) + lane;
#pragma unroll
                for (int jj = 0; jj < 4; ++jj) { r.y[0][jj] = q0[64 * jj]; r.y[1][jj] = q1[64 * jj]; r.y[2][jj] = q2[64 * jj]; r.y[3][jj] = q3[64 * jj]; r.x[jj] = qx[64 * jj]; } };
            int row0 = gw;
            if (row0 < NR) {
                int4 slA = *(const int4*)(SLOT + (size_t)row0 * 4); float4 wtA = *(const float4*)(WTS + (size_t)row0 * 4);
                int row1 = row0 + NGW; int4 slB = slA; float4 wtB = wtA;
                if (row1 < NR) { slB = *(const int4*)(SLOT + (size_t)row1 * 4); wtB = *(const float4*)(WTS + (size_t)row1 * 4); }
                CRaw A; issue(row0, slA.x, slA.y, slA.z, slA.w, A);
                for (;;) {
                    const bool hB = row1 < NR; CRaw B = A; if (hB) issue(row1, slB.x, slB.y, slB.z, slB.w, B);
                    const int row2 = row1 + NGW; int4 slC = slB; float4 wtC = wtB;
                    if (row2 < NR) { slC = *(const int4*)(SLOT + (size_t)row2 * 4); wtC = *(const float4*)(WTS + (size_t)row2 * 4); }
                    {
                        const int row = row0; const bool isc = row >= NLAT; const float* md = MOD + (size_t)layer * 17 * 6144 + (size_t)(isc ? 16 : (row >> 11)) * 6144;
                        RowF y, xr;
#pragma unroll
                        for (int jj = 0; jj < 4; ++jj) { y.v[jj] = (f32x4){0.f, 0.f, 0.f, 0.f};
#pragma unroll
                            for (int kk = 0; kk < 4; ++kk) { const unsigned w = A.y[kk][jj]; const float wk = (kk == 0 ? wtA.x : kk == 1 ? wtA.y : kk == 2 ? wtA.z : wtA.w) * (1.0f / S_Y); const auto lo = __builtin_amdgcn_cvt_pk_f32_fp8((int)w, false), hi = __builtin_amdgcn_cvt_pk_f32_fp8((int)w, true); y.v[jj] += (f32x4){lo[0], lo[1], hi[0], hi[1]} * wk; }
                            const v2u wx = A.x[jj]; xr.v[jj] = (f32x4){bflo(wx.x), bfhi(wx.x), bflo(wx.y), bfhi(wx.y)}; }
                        const float rstd = rsq(row_ss(y, lane) * (1.0f / DM) + EPS);
                        RowF gp, gt; ld_row_f32(gp, P.g_post_ffn + layer * DM, lane); ld_row_f32(gt, md + 5 * DM, lane);
#pragma unroll
                        for (int jj = 0; jj < 4; ++jj) xr.v[jj] = xr.v[jj] + gt.v[jj] * (y.v[jj] * rstd * gp.v[jj]);
                        if (l0) st_row_bf16(XB + (size_t)row * DM, lane, xr); else st_row_f32(P.out + (size_t)row * DM, lane, xr);
                        if (l0) { const float* md1 = MOD + (size_t)(17 + (isc ? 16 : (row >> 11))) * 6144;
                            modulate_store8(xr, P.g_pre_mix + DM, md1 + 0 * DM, md1 + 1 * DM, (unsigned char*)H + (size_t)row * DM, lane); }
                    }
                    if (!hB) break;
                    row0 = row1; A = B; wtA = wtB; row1 = row2; slB = slC; wtB = wtC;
                }
            }
        }
        SEAM(pb + 12);
    }
#undef IN
#undef SEAM
}

extern "C" void kernel_launch(void* const* d_in, const int* in_sizes, int n_in, void* d_out, int out_size, void* d_ws, size_t ws_size, hipStream_t stream) {
    static int grid = 0;
    if (grid == 0) {
        if (n_in != 22 || out_size != NLAT * DM || ws_size < WS_END) { fprintf(stderr, "kernel_launch: unexpected shapes (n_in %d, out %d, ws %zu < %zu)\n", n_in, out_size, ws_size, (size_t)WS_END); grid = -1; return; }
        int dev = 0, cus = 0, per_cu = 0;
        if (hipGetDevice(&dev) != hipSuccess || hipDeviceGetAttribute(&cus, hipDeviceAttributeMultiprocessorCount, dev) != hipSuccess) { grid = -1; return; }
        if (hipFuncSetAttribute((const void*)mk_fwd, hipFuncAttributeMaxDynamicSharedMemorySize, LDS_BYTES) != hipSuccess) { fprintf(stderr, "kernel_launch: hipFuncSetAttribute failed\n"); grid = -1; return; }
        if (hipOccupancyMaxActiveBlocksPerMultiprocessor(&per_cu, (const void*)mk_fwd, NWAVES * 64, LDS_BYTES) != hipSuccess || per_cu < 1)
            fprintf(stderr, "kernel_launch: note: occupancy query reports %d workgroups per CU\n", per_cu);
        (void)hipGetLastError();
        grid = cus >= 256 ? 256 : (cus / 16) * 16;
        if (grid < 128) { fprintf(stderr, "kernel_launch: this kernel wants at least 128 CUs (found %d)\n", cus); grid = -1; return; }
    }
    if (grid < 0) return;
    if (hipMemsetAsync((char*)d_ws + WS_CTL, 0, CTL_ZERO_BYTES, stream) != hipSuccess) return;
    Params p{};
    const float** pp = (const float**)&p;
    for (int i = 0; i < 22; ++i) pp[i] = (const float*)d_in[i];
    p.out = (float*)d_out; p.ws = (unsigned char*)d_ws;
#if MK_PER_PHASE
    for (int ph = 0; ph < NPHASE; ++ph) { p.ph_lo = ph; p.ph_hi = ph + 1; p.li = 0; hipLaunchKernelGGL(mk_fwd, dim3(grid), dim3(NWAVES * 64), LDS_BYTES, stream, p); }
#else
    p.ph_lo = 0; p.ph_hi = NPHASE; p.li = 0;
    hipLaunchKernelGGL(mk_fwd, dim3(grid), dim3(NWAVES * 64), LDS_BYTES, stream, p);
#endif
}
```
